# Optimizing an MI355X kernel written in HIP

```python
import math
import jax, jax.numpy as jnp
from jax import lax
import numpy as np

D_MODEL = 2048
BATCH = 4
SEQ = 2048
DEPTH = 2
DEC_BATCH = 32
DEC_SEQ = 32
PAST_LEN = 4096

CHUNK = 64
N_MIXERS = 2
N_A_LAYERS = (DEPTH + 1) // 2
N_B_LAYERS = DEPTH // 2

GMLP_CHUNK = 128
GMLP_HALF = D_MODEL
GMLP_GROUPS = 8
GMLP_GROUP_DIM = GMLP_HALF // GMLP_GROUPS

RET_HEADS = 8
RET_DK = D_MODEL // RET_HEADS
RET_DV = 2 * RET_DK
RET_QK = RET_HEADS * RET_DK
RET_V = RET_HEADS * RET_DV
ROPE_BASE = 10000.0

FFN_HIDDEN = ((8 * D_MODEL + 3 * 256 - 1) // (3 * 256)) * 256

ALPHA = (2 * DEPTH) ** 0.25
BETA = (8 * DEPTH) ** -0.25
LN_EPS = 1e-5
GN_EPS = 1e-6

kernel_name = "hybrid_gmlp_retention_stream_step"


def layer_norm(x, g, b):
    xf = x.astype(jnp.float32)
    mu = jnp.mean(xf, axis=-1, keepdims=True)
    var = jnp.mean(jnp.square(xf - mu), axis=-1, keepdims=True)
    y = (xf - mu) * lax.rsqrt(var + LN_EPS) * g.astype(jnp.float32) + b.astype(jnp.float32)
    return y.astype(x.dtype)


def gmlp_mix(x, w_in, ln_g, ln_b, w_s, b_s, w_out):
    bsz, t, _ = x.shape
    seg = min(t, GMLP_CHUNK)
    n = t // seg
    z = jax.nn.gelu(x @ w_in, approximate=False)
    u, v = jnp.split(z, 2, axis=-1)
    v = layer_norm(v, ln_g, ln_b)
    mask = jnp.tril(jnp.ones((seg, seg), dtype=bool))
    w = jnp.where(mask[None], w_s[:, :seg, :seg], 0.0).astype(x.dtype)
    vg = v.reshape(bsz, n, seg, GMLP_GROUPS, GMLP_GROUP_DIM)
    bias = jnp.swapaxes(b_s[:, :seg], 0, 1)[None, None, :, :, None].astype(x.dtype)
    mixed = jnp.einsum('gts,bnsgc->bntgc', w, vg) + bias
    s = u * mixed.reshape(bsz, t, GMLP_HALF)
    return s @ w_out, v


def rope(x, pos):
    half = RET_DK // 2
    inv = jnp.power(ROPE_BASE, -jnp.arange(half, dtype=jnp.float32) / half)
    ang = pos.astype(jnp.float32)[:, None] * inv[None, :]
    cos, sin = jnp.cos(ang), jnp.sin(ang)
    x1, x2 = x[..., :half], x[..., half:]
    return jnp.concatenate([x1 * cos - x2 * sin, x1 * sin + x2 * cos], axis=-1)


def retention_block(q, k, v, s0, decay, inner, zeta, blk_decay):
    scores = jnp.einsum('bhqd,bhkd->bhqk', q, k) * decay[None]
    intra = jnp.einsum('bhqk,bhkv->bhqv', scores, v)
    cross = jnp.einsum('bhqd,bhdv->bhqv', q, s0) * inner[None, :, :, None]
    s_new = blk_decay[None, :, None, None] * s0 + jnp.einsum(
        'bhkd,bhkv->bhdv', k * zeta[None, :, :, None], v)
    return intra + cross, s_new


def retention_mix(x, pos, s0, w_in, w_out):
    bsz, t, _ = x.shape
    proj = x @ w_in
    q, k, v, g = jnp.split(proj, [RET_QK, 2 * RET_QK, 2 * RET_QK + RET_V], axis=-1)

    def heads(a, d):
        return a.reshape(bsz, t, RET_HEADS, d).transpose(0, 2, 1, 3).astype(jnp.float32)

    q = rope(heads(q, RET_DK), pos) * (RET_DK ** -0.5)
    k = rope(heads(k, RET_DK), pos)
    v = heads(v, RET_DV)

    blk = min(t, CHUNK)
    n = t // blk
    log_gamma = jnp.log1p(-jnp.power(2.0, -5.0 - jnp.arange(RET_HEADS, dtype=jnp.float32)))
    idx = jnp.arange(blk, dtype=jnp.float32)
    diff = idx[:, None] - idx[None, :]
    decay = jnp.where(diff[None] >= 0,
                      jnp.exp(log_gamma[:, None, None] * jnp.maximum(diff, 0.0)[None]), 0.0)
    inner = jnp.exp(log_gamma[:, None] * (idx + 1.0)[None])
    zeta = jnp.exp(log_gamma[:, None] * (blk - 1.0 - idx)[None])
    blk_decay = jnp.exp(log_gamma * blk)

    def to_blocks(a):
        return a.reshape(bsz, RET_HEADS, n, blk, a.shape[-1]).transpose(2, 0, 1, 3, 4)

    def step(s, qkv):
        o, s = retention_block(qkv[0], qkv[1], qkv[2], s, decay, inner, zeta, blk_decay)
        return s, o

    s_final, o = lax.scan(step, s0.astype(jnp.float32), (to_blocks(q), to_blocks(k), to_blocks(v)))
    o = o.transpose(1, 2, 0, 3, 4).reshape(bsz, RET_HEADS, t, RET_DV)
    mu = jnp.mean(o, axis=-1, keepdims=True)
    var = jnp.mean(jnp.square(o - mu), axis=-1, keepdims=True)
    o = (o - mu) * lax.rsqrt(var + GN_EPS)
    o = o.transpose(0, 2, 1, 3).reshape(bsz, t, RET_V)
    y = (jax.nn.silu(g.astype(jnp.float32)) * o).astype(x.dtype) @ w_out
    return y, s_final.astype(x.dtype)


def swiglu(x, w_in, w_out):
    gate, up = jnp.split(x @ w_in, 2, axis=-1)
    return (jax.nn.silu(gate) * up) @ w_out


def trunk(x, pos, states, w_a_in, a_ln_g, a_ln_b, a_ws, a_bs, w_a_out, w_b_in, w_b_out,
          w_ffn_in, w_ffn_out, ln_mix_g, ln_mix_b, ln_ffn_g, ln_ffn_b):
    new_states, v_rows = [], []
    for i in range(DEPTH):
        j = i // N_MIXERS
        if i % N_MIXERS == 0:
            h, v = gmlp_mix(x, w_a_in[j], a_ln_g[j], a_ln_b[j], a_ws[j], a_bs[j], w_a_out[j])
            v_rows.append(v)
        else:
            h, s = retention_mix(x, pos, states[j], w_b_in[j], w_b_out[j])
            new_states.append(s)
        x = layer_norm(ALPHA * x + h, ln_mix_g[i], ln_mix_b[i])
        x = layer_norm(ALPHA * x + swiglu(x, w_ffn_in[i], w_ffn_out[i]), ln_ffn_g[i], ln_ffn_b[i])
    return x, jnp.stack(new_states), jnp.stack(v_rows)


def setup_inputs(seed: int = 0) -> dict:
    key = jax.random.key(seed)
    ks = jax.random.split(key, 20)
    f32 = jnp.float32
    nrm = lambda k, shape, scale: jax.random.normal(k, shape, f32) * scale
    return {
        "x_prompt": nrm(ks[0], (BATCH, SEQ, D_MODEL), 1.0),
        "x_sample": nrm(ks[1], (DEC_BATCH, DEC_SEQ, D_MODEL), 1.0),
        "state_ret": nrm(ks[2], (N_B_LAYERS, DEC_BATCH, RET_HEADS, RET_DK, RET_DV), 1.0),
        "w_a_in": nrm(ks[3], (N_A_LAYERS, D_MODEL, 2 * GMLP_HALF), D_MODEL ** -0.5),
        "a_ln_g": 1.0 + nrm(ks[4], (N_A_LAYERS, GMLP_HALF), 0.02),
        "a_ln_b": nrm(ks[5], (N_A_LAYERS, GMLP_HALF), 0.02),
        "a_ws": nrm(ks[6], (N_A_LAYERS, GMLP_GROUPS, GMLP_CHUNK, GMLP_CHUNK), GMLP_CHUNK ** -0.5),
        "a_bs": 1.0 + nrm(ks[7], (N_A_LAYERS, GMLP_GROUPS, GMLP_CHUNK), 0.1),
        "w_a_out": nrm(ks[8], (N_A_LAYERS, GMLP_HALF, D_MODEL), BETA * GMLP_HALF ** -0.5),
        "w_b_in": nrm(ks[9], (N_B_LAYERS, D_MODEL, 2 * RET_QK + 2 * RET_V), D_MODEL ** -0.5),
        "w_b_out": nrm(ks[10], (N_B_LAYERS, RET_V, D_MODEL), BETA * RET_V ** -0.5),
        "w_ffn_in": nrm(ks[11], (DEPTH, D_MODEL, 2 * FFN_HIDDEN), D_MODEL ** -0.5),
        "w_ffn_out": nrm(ks[12], (DEPTH, FFN_HIDDEN, D_MODEL), BETA * FFN_HIDDEN ** -0.5),
        "ln_mix_g": 1.0 + nrm(ks[13], (DEPTH, D_MODEL), 0.02),
        "ln_mix_b": nrm(ks[14], (DEPTH, D_MODEL), 0.02),
        "ln_ffn_g": 1.0 + nrm(ks[15], (DEPTH, D_MODEL), 0.02),
        "ln_ffn_b": nrm(ks[16], (DEPTH, D_MODEL), 0.02),
    }


def reference(x_prompt, x_sample, state_ret, w_a_in, a_ln_g, a_ln_b, a_ws, a_bs, w_a_out,
              w_b_in, w_b_out, w_ffn_in, w_ffn_out, ln_mix_g, ln_mix_b, ln_ffn_g, ln_ffn_b):
    pos_prompt = jnp.arange(x_prompt.shape[1], dtype=jnp.int32)
    pos_sample = PAST_LEN + jnp.arange(x_sample.shape[1], dtype=jnp.int32)
    zero_state = jnp.zeros((N_B_LAYERS, x_prompt.shape[0], RET_HEADS, RET_DK, RET_DV), x_prompt.dtype)
    y_prompt, ret_state_prompt, _ = trunk(
        x_prompt, pos_prompt, zero_state, w_a_in, a_ln_g, a_ln_b, a_ws, a_bs, w_a_out,
        w_b_in, w_b_out, w_ffn_in, w_ffn_out, ln_mix_g, ln_mix_b, ln_ffn_g, ln_ffn_b)
    y_sample, ret_state_sample, gmlp_v_sample = trunk(
        x_sample, pos_sample, state_ret, w_a_in, a_ln_g, a_ln_b, a_ws, a_bs, w_a_out,
        w_b_in, w_b_out, w_ffn_in, w_ffn_out, ln_mix_g, ln_mix_b, ln_ffn_g, ln_ffn_b)
    return (y_prompt, y_sample, ret_state_prompt, ret_state_sample, gmlp_v_sample)
```

```cpp
#include <hip/hip_runtime.h>
#include <hip/hip_cooperative_groups.h>
#include <cstdio>
#include <cstdint>
namespace cg = cooperative_groups;

constexpr int DM = 2048, MP = 8192, MS = 1024, MT = MP + MS, FF = 5632, NQKVG = 12288, RV = 4096;
constexpr float ALPHA = 1.41421356237309515f;
constexpr float LN_EPS = 1e-5f, GN_EPS = 1e-6f;

namespace pg8 {
#define PG8_LAS __attribute__((address_space(3)))
typedef unsigned short bf16_t;
typedef short bf16x8 __attribute__((ext_vector_type(8)));
typedef float f32x4 __attribute__((ext_vector_type(4)));
typedef unsigned u32x4 __attribute__((ext_vector_type(4)));
constexpr int BM = 256, BK = 64, HALF = 128, HTB = HALF * BK * 2  , STAGE_BYTES = 8 * HTB, NXCD = 8, WGM = 8;

__host__ __device__ __forceinline__ int lds_byte(int r, int c) { const int st = (r >> 4) * 2 + (c >> 5), rr = r & 15, cc = c & 31, ob = rr * 64 + cc * 2; return st * 1024 + (ob ^ (((ob >> 9) & 1) << 5)); }
__host__ __device__ __forceinline__ void stage_rc(int b, int& R, int& C) { const int st = b / 1024, sb = b % 1024, swz = sb ^ (((sb >> 9) & 1) << 5); R = (st >> 1) * 16 + swz / 64; C = (st & 1) * 32 + (swz % 64) / 2; }
__host__ __device__ __forceinline__ int perm32(int rho) { const int n = rho >> 4, i = rho & 15; return 8 * (i >> 2) + 4 * n + (i & 3); }

struct Unit { int pm, pn, k0, nt, ks; };
struct Gemm { const bf16_t* A; const bf16_t* Bt; int ld; };

struct StaticOrder {
    int nM, nN, nwg, G, c;
    __host__ __device__ void init(int M, int N, int G_, int c_) { nM = M / BM; nN = N / BM; nwg = nM * nN; G = G_; c = c_; }
    __host__ __device__ __forceinline__ void tile(int L, int& pm_, int& pn_) const {
        int wgid = L; { const int q = nwg / NXCD, r = nwg % NXCD, xcd = wgid % NXCD, off = wgid / NXCD; wgid = (xcd < r ? xcd * (q + 1) : r * (q + 1) + (xcd - r) * q) + off; }
        const int nig = WGM * nN, gid = wgid / nig, fm = gid * WGM, gsz = (nM - fm) < WGM ? (nM - fm) : WGM;
        pm_ = fm + ((wgid % nig) % gsz); pn_ = (wgid % nig) / gsz;
    }
    __device__ __forceinline__ void a_ready(const Unit&) const {}
    __device__ __forceinline__ void done(const Unit&) const {}
};

typedef float f32x2_cv __attribute__((ext_vector_type(2))); typedef __bf16 bf16x2_cv __attribute__((ext_vector_type(2)));
__device__ __forceinline__ unsigned cvt_pk_bf16(float lo, float hi) { const f32x2_cv v = {lo, hi}; const bf16x2_cv b = __builtin_convertvector(v, bf16x2_cv); return __builtin_bit_cast(unsigned, b); }
typedef float f32x2 __attribute__((ext_vector_type(2)));
__device__ __forceinline__ f32x2 gelu_pk(f32x2 v) {
    const f32x2 av = __builtin_elementwise_abs(v), d = av * 0.2316418882f + 1.0f;
    f32x2 t; t.x = __builtin_amdgcn_rcpf(d.x); t.y = __builtin_amdgcn_rcpf(d.y);
    f32x2 q = t * 0.5307027145f + (-0.7265760135f); q = q * t + 0.7107068705f; q = q * t + (-0.142248368f); q = q * t + 0.127414796f; q = q * t;
    const f32x2 s = (v * v) * (-0.72134752044f);
    f32x2 e; e.x = __builtin_amdgcn_exp2f(s.x); e.y = __builtin_amdgcn_exp2f(s.y);
    const f32x2 m = v * (q * e), r = v - m;
    f32x2 o; o.x = v.x < 0.f ? m.x : r.x; o.y = v.y < 0.f ? m.y : r.y; return o;
}
struct Order {
    StaticOrder so; int G, c, n1c, ntk, split;
    __device__ __forceinline__ void init(int M1, int N, int K, int split_, int G_, int c_) { so.init(M1, N, G_, c_); G = G_; c = c_; ntk = K / BK; split = split_; n1c = (c < so.nwg) ? (so.nwg - c + G - 1) / G : 0; }
    __device__ __forceinline__ bool next(int i, Unit& u) const {
        const bool p1 = i < n1c; int pm1, pn1; so.tile(p1 ? i * G + c : 0, pm1, pn1);
        const int j = (i - n1c) * G + c; const bool p2 = !p1 && split != 0 && j < 256;
        const int ks = j & 7, jj = (j >> 3) & 31, b = (ntk >> 3) & ~1, rem2 = (ntk - 8 * b) >> 1;
        Unit r; r.pm = p1 ? pm1 : so.nM + (jj & 3); r.pn = p1 ? pn1 : (jj >> 2); r.k0 = p1 ? 0 : (ks * b + 2 * (ks < rem2 ? ks : rem2)) * BK; r.nt = p1 ? ntk : b + (ks < rem2 ? 2 : 0); r.ks = p1 ? -1 : ks;
        u = r; return p1 || p2;
    }
    __device__ __forceinline__ void a_ready(const Unit&) const {}
    __device__ __forceinline__ void done(const Unit&) const {}
};

__device__ __forceinline__ float silu_f(float x) { return x * __builtin_amdgcn_rcpf(1.0f + __builtin_amdgcn_exp2f(-1.4426950408889634f * x)); }

struct EpiPart {
    static constexpr bool PERM = false, AFTER_DRAIN = false;
    float* Y;
    __device__ __forceinline__ void operator()(const f32x4 (&acc)[2][2][4][2], const Unit& u, int wr, int wc, int fr, int fq) const {
        const int row0 = u.pm * BM + wr * 64 + fr + (u.ks > 0 ? u.ks * 1024 : 0), col0 = u.pn * BM + wc * 32 + 4 * fq;
#pragma unroll
        for (int ai = 0; ai < 2; ++ai)
#pragma unroll
            for (int m = 0; m < 4; ++m) { float* rowp = Y + (size_t)(row0 + ai * HALF + m * 16) * 2048 + col0;
#pragma unroll
                for (int bj = 0; bj < 2; ++bj)
#pragma unroll
                    for (int n = 0; n < 2; ++n) *(f32x4*)(rowp + bj * HALF + n * 16) = acc[ai][bj][m][n]; }
    }
};
struct EpiGeluUV {
    static constexpr bool PERM = true, AFTER_DRAIN = false;
    bf16_t* U; bf16_t* V; f32x2* stat;
    __device__ __forceinline__ void operator()(const f32x4 (&acc)[2][2][4][2], const Unit& u, int wr, int wc, int fr, int fq) const {
        const bool isv = u.pn >= 8; bf16_t* O = isv ? V : U;
        const int row0 = u.pm * BM + wr * 64 + fr, col0 = (u.pn & 7) * BM + wc * 32 + 8 * fq;
#pragma unroll
        for (int ai = 0; ai < 2; ++ai)
#pragma unroll
            for (int m = 0; m < 4; ++m) { const int row = row0 + ai * HALF + m * 16; bf16_t* rowp = O + (size_t)row * 2048 + col0; float s = 0.f, q = 0.f;
#pragma unroll
                for (int bj = 0; bj < 2; ++bj) { const f32x4 v0 = acc[ai][bj][m][0], v1 = acc[ai][bj][m][1];
                    const f32x2 a = gelu_pk((f32x2){v0[0], v0[1]}), b = gelu_pk((f32x2){v0[2], v0[3]}), c = gelu_pk((f32x2){v1[0], v1[1]}), d = gelu_pk((f32x2){v1[2], v1[3]});
                    s += ((a.x + a.y) + (b.x + b.y)) + ((c.x + c.y) + (d.x + d.y));
                    q += ((a.x * a.x + a.y * a.y) + (b.x * b.x + b.y * b.y)) + ((c.x * c.x + c.y * c.y) + (d.x * d.x + d.y * d.y));
                    u32x4 w; w.x = cvt_pk_bf16(a.x, a.y); w.y = cvt_pk_bf16(b.x, b.y); w.z = cvt_pk_bf16(c.x, c.y); w.w = cvt_pk_bf16(d.x, d.y);
                    *(u32x4*)(rowp + bj * HALF) = w; }
                if (isv) { s += __shfl_xor(s, 16); s += __shfl_xor(s, 32); q += __shfl_xor(q, 16); q += __shfl_xor(q, 32);
                    if (fq == 0) stat[(size_t)row * 32 + (u.pn - 8) * 4 + wc] = (f32x2){s, q}; } }
    }
};
struct EpiSwiglu {
    static constexpr bool PERM = true, AFTER_DRAIN = false;
    bf16_t* H;
    __device__ __forceinline__ void operator()(const f32x4 (&acc)[2][2][4][2], const Unit& u, int wr, int wc, int fr, int fq) const {
        const int row0 = u.pm * BM + wr * 64 + fr, col0 = u.pn * HALF + wc * 32 + 8 * fq;
#pragma unroll
        for (int ai = 0; ai < 2; ++ai)
#pragma unroll
            for (int m = 0; m < 4; ++m) { bf16_t* rowp = H + (size_t)(row0 + ai * HALF + m * 16) * 5632 + col0;
                const f32x4 g0 = acc[ai][0][m][0], g1 = acc[ai][0][m][1], u0 = acc[ai][1][m][0], u1 = acc[ai][1][m][1];
                u32x4 w; w.x = cvt_pk_bf16(silu_f(g0[0]) * u0[0], silu_f(g0[1]) * u0[1]); w.y = cvt_pk_bf16(silu_f(g0[2]) * u0[2], silu_f(g0[3]) * u0[3]);
                w.z = cvt_pk_bf16(silu_f(g1[0]) * u1[0], silu_f(g1[1]) * u1[1]); w.w = cvt_pk_bf16(silu_f(g1[2]) * u1[2], silu_f(g1[3]) * u1[3]);
                *(u32x4*)rowp = w; }
    }
};
__device__ __forceinline__ float lg2gamma(int h) {
    const double x = 1.0 / (double)(32 << h); double p = x, s = 0.0;
    const double inv[8] = {1.0, 0.5, 1.0 / 3.0, 0.25, 0.2, 1.0 / 6.0, 1.0 / 7.0, 0.125};
#pragma unroll
    for (int k = 0; k < 8; ++k) { s -= p * inv[k]; p *= x; }
    return (float)(s * 1.4426950408889634);
}
struct EpiQKVG {
    static constexpr bool PERM = true, AFTER_DRAIN = false;
    bf16_t *QH, *KH, *VB, *GS; const float* ropec; const float* ropes;
    __device__ __forceinline__ void operator()(const f32x4 (&acc)[2][2][4][2], const Unit& u, int wr, int wc, int fr, int fq) const {
        const int row0 = u.pm * BM + wr * 64 + fr, cw = wc * 32 + 8 * fq;
        if (u.pn < 16) {
            const bool isq = u.pn < 8; const int head = u.pn & 7; bf16_t* O = (isq ? QH : KH) + head * 256 + cw;
            const float lg = lg2gamma(head) * (isq ? 1.f : -1.f), sc0 = isq ? 0.0625f : 1.f;
#pragma unroll
            for (int ai = 0; ai < 2; ++ai)
#pragma unroll
                for (int m = 0; m < 4; ++m) { const int row = row0 + ai * HALF + m * 16;
                    const int pidx = row < MP ? (row & 2047) : 2048 + ((row - MP) & 31), ib = row < MP ? (row & 63) : ((row - MP) & 31);
                    const float sc = sc0 * __builtin_amdgcn_exp2f(lg * (float)ib);
                    const f32x4 c0 = *(const f32x4*)(ropec + pidx * 128 + cw), c1 = *(const f32x4*)(ropec + pidx * 128 + cw + 4);
                    const f32x4 s0 = *(const f32x4*)(ropes + pidx * 128 + cw), s1 = *(const f32x4*)(ropes + pidx * 128 + cw + 4);
                    const f32x4 a0 = acc[ai][0][m][0], a1 = acc[ai][0][m][1], b0 = acc[ai][1][m][0], b1 = acc[ai][1][m][1];
                    const f32x4 o0 = (a0 * c0 - b0 * s0) * sc, o1 = (a1 * c1 - b1 * s1) * sc, p0 = (a0 * s0 + b0 * c0) * sc, p1 = (a1 * s1 + b1 * c1) * sc;
                    u32x4 w; w.x = cvt_pk_bf16(o0[0], o0[1]); w.y = cvt_pk_bf16(o0[2], o0[3]); w.z = cvt_pk_bf16(o1[0], o1[1]); w.w = cvt_pk_bf16(o1[2], o1[3]);
                    *(u32x4*)(O + (size_t)row * 2048) = w;
                    w.x = cvt_pk_bf16(p0[0], p0[1]); w.y = cvt_pk_bf16(p0[2], p0[3]); w.z = cvt_pk_bf16(p1[0], p1[1]); w.w = cvt_pk_bf16(p1[2], p1[3]);
                    *(u32x4*)(O + (size_t)row * 2048 + HALF) = w; }
        } else {
            const bool isg = u.pn >= 32; bf16_t* O = (isg ? GS : VB) + ((u.pn - 16) & 15) * BM + cw;
#pragma unroll
            for (int ai = 0; ai < 2; ++ai)
#pragma unroll
                for (int m = 0; m < 4; ++m) { bf16_t* rowp = O + (size_t)(row0 + ai * HALF + m * 16) * 4096;
#pragma unroll
                    for (int bj = 0; bj < 2; ++bj) { f32x4 v0 = acc[ai][bj][m][0], v1 = acc[ai][bj][m][1];
                        if (isg) { v0 = (f32x4){silu_f(v0[0]), silu_f(v0[1]), silu_f(v0[2]), silu_f(v0[3])}; v1 = (f32x4){silu_f(v1[0]), silu_f(v1[1]), silu_f(v1[2]), silu_f(v1[3])}; }
                        u32x4 w; w.x = cvt_pk_bf16(v0[0], v0[1]); w.y = cvt_pk_bf16(v0[2], v0[3]); w.z = cvt_pk_bf16(v1[0], v1[1]); w.w = cvt_pk_bf16(v1[2], v1[3]);
                        *(u32x4*)(rowp + bj * HALF) = w; } }
        }
    }
};
template <class Epi, class Sched, bool ALIGN_EPI = false, bool SP2 = false>
__device__ __forceinline__ void gemm_phase(PG8_LAS unsigned char* lds, const Gemm g, const Sched& S, const Epi& E) {
    int tid_ = threadIdx.x; asm volatile("" : "+v"(tid_));
    const int tid = tid_, wid = __builtin_amdgcn_readfirstlane(tid >> 6), lane = tid & 63, wr = wid >> 2, wc = wid & 3, fr = lane & 15, fq = lane >> 4;
    const int K = g.ld;
    unsigned voffA[2], voffB[2];
#pragma unroll
    for (int i = 0; i < 2; ++i) { int R, C; stage_rc(tid * 16 + i * 8192, R, C); const int Rb = Epi::PERM ? ((R & ~31) + perm32(R & 31)) : R;
        voffA[i] = (unsigned)(R * K + C) * 2u; voffB[i] = (unsigned)(Rb * K + C) * 2u; }
    const size_t kstep = (size_t)(BK * 2);
    const size_t hstep = (size_t)HALF * K * 2;
    const size_t tstep = 2 * hstep;
    const unsigned ldsw = (unsigned)wid * 1024u;
    const int aoff = lds_byte(wr * 64 + fr, fq * 8), boff = lds_byte(wc * 32 + fr, fq * 8);
#define PG8_SA(b, h) (((b) * 2 + (h)) * HTB)
#define PG8_SB(b, h) ((4 + (b) * 2 + (h)) * HTB)
#define PG8_STAGE(bufoff, gbase, voff) do { _Pragma("unroll") for (int _i = 0; _i < 2; ++_i) \
        __builtin_amdgcn_global_load_lds((const unsigned*)((const char*)(gbase) + (voff)[_i]), (PG8_LAS unsigned*)(lds + (bufoff) + ldsw + _i * 8192), 16, 0, 0); } while (0)
#define PG8_LDA(dst, b, h) do { _Pragma("unroll") for (int m = 0; m < 4; ++m) _Pragma("unroll") for (int k = 0; k < 2; ++k) dst[m][k] = *(const PG8_LAS bf16x8*)(lds + PG8_SA(b, h) + aoff + m * 2048 + k * 1024); } while (0)
#define PG8_LDB(dst, b, h) do { _Pragma("unroll") for (int n = 0; n < 2; ++n) _Pragma("unroll") for (int k = 0; k < 2; ++k) dst[n][k] = *(const PG8_LAS bf16x8*)(lds + PG8_SB(b, h) + boff + n * 2048 + k * 1024); } while (0)
#define PG8_MMA(ai, bj, At, Bt) do { __builtin_amdgcn_s_setprio(1); _Pragma("unroll") for (int m = 0; m < 4; ++m) _Pragma("unroll") for (int n = 0; n < 2; ++n) _Pragma("unroll") for (int k = 0; k < 2; ++k) \
        acc[ai][bj][m][n] = __builtin_amdgcn_mfma_f32_16x16x32_bf16(Bt[n][k], At[m][k], acc[ai][bj][m][n], 0, 0, 0); __builtin_amdgcn_s_setprio(0); } while (0)
#define PG8_WAIT_V(n) asm volatile("s_waitcnt vmcnt(" #n ")" ::: "memory")
#define PG8_WAIT_L(n) asm volatile("s_waitcnt lgkmcnt(" #n ")" ::: "memory")
#define PG8_BAR __builtin_amdgcn_s_barrier()
#define PG8_SCHED __builtin_amdgcn_sched_barrier(0)
    Unit cur, nxt; int ui = 0;
    if (!S.next(0, cur)) return;
    f32x4 acc[2][2][4][2];
#pragma unroll
    for (int a = 0; a < 2; ++a)
#pragma unroll
        for (int b = 0; b < 2; ++b)
#pragma unroll
            for (int m = 0; m < 4; ++m)
#pragma unroll
                for (int n = 0; n < 2; ++n) acc[a][b][m][n] = (f32x4){0.f, 0.f, 0.f, 0.f};
    bf16x8 At[4][2], B0[2][2], B1[2][2];
    const char* cA = (const char*)g.A + (size_t)cur.pm * tstep + (size_t)cur.k0 * 2; const char* cB = (const char*)g.Bt + (size_t)cur.pn * tstep + (size_t)cur.k0 * 2; int nt = cur.nt;
    S.a_ready(cur);
    if constexpr (SP2) {
        PG8_STAGE(PG8_SB(0, 0), cB, voffB); PG8_STAGE(PG8_SB(0, 1), cB + hstep, voffB); PG8_STAGE(PG8_SA(0, 0), cA, voffA); PG8_STAGE(PG8_SA(0, 1), cA + hstep, voffA);
        if (wr == 1) PG8_BAR;
        PG8_WAIT_V(2); PG8_BAR;
        PG8_STAGE(PG8_SB(1, 0), cB + kstep, voffB); PG8_STAGE(PG8_SA(1, 0), cA + kstep, voffA); PG8_STAGE(PG8_SB(1, 1), cB + hstep + kstep, voffB);
        PG8_WAIT_V(6); PG8_BAR;
    } else {
        PG8_STAGE(PG8_SB(0, 0), cB, voffB); PG8_STAGE(PG8_SA(0, 0), cA, voffA); PG8_STAGE(PG8_SB(0, 1), cB + hstep, voffB); PG8_STAGE(PG8_SA(0, 1), cA + hstep, voffA);
        if (wr == 1) PG8_BAR;
        PG8_WAIT_V(4); PG8_BAR;
        PG8_STAGE(PG8_SB(1, 0), cB + kstep, voffB); PG8_STAGE(PG8_SA(1, 0), cA + kstep, voffA); PG8_STAGE(PG8_SB(1, 1), cB + hstep + kstep, voffB);
        PG8_WAIT_V(6); PG8_BAR;
    }
    for (;;) {
        const bool has_next = S.next(ui + 1, nxt);
        const char* nA = has_next ? (const char*)g.A + (size_t)nxt.pm * tstep + (size_t)nxt.k0 * 2 : cA; const char* nB = has_next ? (const char*)g.Bt + (size_t)nxt.pn * tstep + (size_t)nxt.k0 * 2 : cB;
        for (int t = 0; t < nt; t += 2) {
            const bool last = (t == nt - 2);
            const char* a1 = cA + (size_t)(t + 1) * kstep;
            const char* a2 = last ? nA : cA + (size_t)(t + 2) * kstep; const char* b2 = last ? nB : cB + (size_t)(t + 2) * kstep;
            const char* a3 = a2 + kstep; const char* b3 = b2 + kstep;
            if (last && has_next) S.a_ready(nxt);
            if constexpr (SP2) {
            PG8_LDB(B0, 0, 0); PG8_LDB(B1, 0, 1); PG8_SCHED; PG8_LDA(At, 0, 0); PG8_STAGE(PG8_SA(1, 1), a1 + hstep, voffA);
            PG8_WAIT_V(8); PG8_WAIT_L(0); PG8_BAR; PG8_MMA(0, 0, At, B0); PG8_MMA(0, 1, At, B1); PG8_BAR; PG8_SCHED;
            PG8_LDA(At, 0, 1); PG8_STAGE(PG8_SB(0, 0), b2, voffB); PG8_STAGE(PG8_SB(0, 1), b2 + hstep, voffB); PG8_STAGE(PG8_SA(0, 0), a2, voffA);
            PG8_WAIT_V(8); PG8_WAIT_L(0); PG8_BAR; PG8_MMA(1, 0, At, B0); PG8_MMA(1, 1, At, B1); PG8_BAR; PG8_SCHED;
            PG8_LDB(B0, 1, 0); PG8_LDB(B1, 1, 1); PG8_SCHED; PG8_LDA(At, 1, 0); PG8_STAGE(PG8_SA(0, 1), a2 + hstep, voffA);
            PG8_WAIT_V(8); PG8_WAIT_L(0); PG8_BAR; PG8_MMA(0, 0, At, B0); PG8_MMA(0, 1, At, B1); PG8_BAR; PG8_SCHED;
            PG8_LDA(At, 1, 1); PG8_STAGE(PG8_SB(1, 0), b3, voffB); PG8_STAGE(PG8_SB(1, 1), b3 + hstep, voffB); PG8_STAGE(PG8_SA(1, 0), a3, voffA);
            PG8_WAIT_V(8); PG8_WAIT_L(0); PG8_BAR; PG8_MMA(1, 0, At, B0); PG8_MMA(1, 1, At, B1); PG8_BAR; PG8_SCHED;
            } else {
            PG8_LDB(B0, 0, 0); PG8_SCHED; PG8_LDA(At, 0, 0); PG8_STAGE(PG8_SA(1, 1), a1 + hstep, voffA);
            PG8_WAIT_L(8); PG8_BAR; PG8_WAIT_L(0); PG8_MMA(0, 0, At, B0); PG8_BAR; PG8_SCHED;
            PG8_LDB(B1, 0, 1); PG8_STAGE(PG8_SB(0, 0), b2, voffB);
            PG8_BAR; PG8_WAIT_L(0); PG8_MMA(0, 1, At, B1); PG8_BAR;
            PG8_LDA(At, 0, 1); PG8_STAGE(PG8_SA(0, 0), a2, voffA);
            PG8_BAR; PG8_WAIT_L(0); PG8_MMA(1, 0, At, B0); PG8_BAR; PG8_SCHED;
            PG8_STAGE(PG8_SB(0, 1), b2 + hstep, voffB);
            PG8_WAIT_V(6); PG8_BAR; PG8_MMA(1, 1, At, B1); PG8_BAR;
            PG8_LDB(B0, 1, 0); PG8_SCHED; PG8_LDA(At, 1, 0); PG8_STAGE(PG8_SA(0, 1), a2 + hstep, voffA);
            PG8_WAIT_L(8); PG8_BAR; PG8_WAIT_L(0); PG8_MMA(0, 0, At, B0); PG8_BAR; PG8_SCHED;
            PG8_LDB(B1, 1, 1); PG8_STAGE(PG8_SB(1, 0), b3, voffB);
            PG8_BAR; PG8_WAIT_L(0); PG8_MMA(0, 1, At, B1); PG8_BAR;
            PG8_LDA(At, 1, 1); PG8_STAGE(PG8_SA(1, 0), a3, voffA);
            PG8_BAR; PG8_WAIT_L(0); PG8_MMA(1, 0, At, B0); PG8_BAR; PG8_SCHED;
            PG8_STAGE(PG8_SB(1, 1), b3 + hstep, voffB);
            PG8_WAIT_V(6); PG8_BAR; PG8_MMA(1, 1, At, B1); PG8_BAR;
            }
        }
        if constexpr (ALIGN_EPI) { if (wr == 0) PG8_BAR; }
        if constexpr (!Epi::AFTER_DRAIN) { E(acc, cur, wr, wc, fr, fq); S.done(cur); }
        if (!has_next) break;
#pragma unroll
        for (int a = 0; a < 2; ++a)
#pragma unroll
            for (int b = 0; b < 2; ++b)
#pragma unroll
                for (int m = 0; m < 4; ++m)
#pragma unroll
                    for (int n = 0; n < 2; ++n) acc[a][b][m][n] = (f32x4){0.f, 0.f, 0.f, 0.f};
        cur = nxt; cA = nA; cB = nB; nt = cur.nt; ++ui;
        if constexpr (ALIGN_EPI) { if (wr == 1) PG8_BAR; }
    }
    PG8_WAIT_V(0);
    if constexpr (!ALIGN_EPI) { if (wr == 0) PG8_BAR; }
    PG8_BAR;
    if constexpr (Epi::AFTER_DRAIN) { E.fused(acc, cur, wr, wc, fr, fq, lds, wid, lane); S.done(cur); }
#undef PG8_SA
#undef PG8_SB
#undef PG8_STAGE
#undef PG8_LDA
#undef PG8_LDB
#undef PG8_MMA
#undef PG8_WAIT_V
#undef PG8_WAIT_L
#undef PG8_BAR
#undef PG8_SCHED
}
}
constexpr size_t MiB = 1u << 20;
constexpr size_t WS_WAIN = 0, WS_WAOUT = 16 * MiB, WS_WBIN = 24 * MiB, WS_WBOUT = 72 * MiB, WS_WFIN = 88 * MiB, WS_WFOUT = 176 * MiB;
constexpr size_t WS_XB = 220 * MiB;
constexpr size_t WS_STAT = 256 * MiB;
constexpr size_t WS_ROPE = 259 * MiB;
constexpr size_t WS_YP = 262 * MiB;
constexpr size_t WS_XF = 390 * MiB;
constexpr size_t WS_R1 = 462 * MiB;
constexpr size_t WS_END = 678 * MiB;
constexpr int LDS_BYTES = 147456;
constexpr int NW = 8;

#define LAS __attribute__((address_space(3)))
typedef unsigned short bf16;
typedef unsigned u32x4 __attribute__((ext_vector_type(4)));
typedef unsigned u32x2 __attribute__((ext_vector_type(2)));
typedef float f32x4 __attribute__((ext_vector_type(4)));
typedef float f32x2 __attribute__((ext_vector_type(2)));
typedef short bf16x8 __attribute__((ext_vector_type(8)));
typedef short s16x4 __attribute__((ext_vector_type(4)));
#define LDS_WAIT() asm volatile("s_waitcnt lgkmcnt(0)" ::: "memory")
__device__ __forceinline__ unsigned pk2(float lo, float hi) { return pg8::cvt_pk_bf16(lo, hi); }
__device__ __forceinline__ float bf_lo(unsigned w) { return __uint_as_float(w << 16); }
__device__ __forceinline__ float bf_hi(unsigned w) { return __uint_as_float(w & 0xffff0000u); }
__device__ __forceinline__ float wave_sum(float v) {
#pragma unroll
    for (int o = 1; o < 64; o <<= 1) v += __shfl_xor(v, o);
    return v;
}

struct Args { const float* in[17]; float* out; unsigned char* ws; };

template <int MAPMODE>
__device__ __forceinline__ void p0_transpose_item(const float* W, int K, int N, bf16* WT, LAS float* scr, int item, int lane) {
    const int nblk = N / 32, kb = item / nblk, nb = item % nblk, k0 = 64 * kb, n0 = 32 * nb;
#pragma unroll 8
    for (int i = 0; i < 32; ++i) { const int kk = 2 * i + (lane >> 5); scr[kk * 33 + (lane & 31)] = W[(size_t)(k0 + kk) * N + n0 + (lane & 31)]; }
    LDS_WAIT(); asm volatile("" ::: "memory");
    int r0 = n0;
    if (MAPMODE == 1) { const int up = n0 >= FF ? 1 : 0, c = n0 - up * FF; r0 = 256 * (c >> 7) + (c & 127) + 128 * up; }
    const int c8 = lane & 7;
#pragma unroll
    for (int j = 0; j < 4; ++j) { const int n = (lane >> 3) + 8 * j; const LAS float* s = scr + (8 * c8) * 33 + n;
        u32x4 o; o.x = pk2(s[0 * 33], s[1 * 33]); o.y = pk2(s[2 * 33], s[3 * 33]); o.z = pk2(s[4 * 33], s[5 * 33]); o.w = pk2(s[6 * 33], s[7 * 33]);
        *(u32x4*)(WT + (size_t)(r0 + n) * K + k0 + 8 * c8) = o; }
    LDS_WAIT(); asm volatile("" ::: "memory");
}
__device__ __forceinline__ void p0_prologue(const Args& a, LAS unsigned char* lds, int gw, int NGW, int wave, int lane) {
    LAS float* scr = (LAS float*)(lds + wave * 16384);
    unsigned char* ws = a.ws;
    constexpr int I0 = 32 * 128, I1 = 32 * 64, I2 = 32 * 384, I3 = 64 * 64, I4 = 32 * 352, I5 = 88 * 64;
    constexpr int NITEMS = I0 + I1 + I2 + I3 + 2 * I4 + 2 * I5;
    for (int it = gw; it < NITEMS; it += NGW) {
        int r = it;
        if (r < I0) { p0_transpose_item<0>(a.in[3], 2048, 4096, (bf16*)(ws + WS_WAIN), scr, r, lane); continue; } r -= I0;
        if (r < I1) { p0_transpose_item<0>(a.in[8], 2048, 2048, (bf16*)(ws + WS_WAOUT), scr, r, lane); continue; } r -= I1;
        if (r < I2) { p0_transpose_item<0>(a.in[9], 2048, 12288, (bf16*)(ws + WS_WBIN), scr, r, lane); continue; } r -= I2;
        if (r < I3) { p0_transpose_item<0>(a.in[10], 4096, 2048, (bf16*)(ws + WS_WBOUT), scr, r, lane); continue; } r -= I3;
        if (r < 2 * I4) { const int l = r >= I4; r -= l * I4; p0_transpose_item<1>(a.in[11] + (size_t)l * 2048 * 11264, 2048, 11264, (bf16*)(ws + WS_WFIN + l * 44 * MiB), scr, r, lane); continue; } r -= 2 * I4;
        { const int l = r >= I5; r -= l * I5; p0_transpose_item<0>(a.in[12] + (size_t)l * 5632 * 2048, 5632, 2048, (bf16*)(ws + WS_WFOUT + l * 22 * MiB), scr, r, lane); }
    }
    bf16* XB = (bf16*)(ws + WS_XB);
    for (int m = gw; m < MT; m += NGW) {
        const f32x4* xr = (const f32x4*)(m < MP ? a.in[0] + (size_t)m * DM : a.in[1] + (size_t)(m - MP) * DM) + lane;
        u32x2* o = (u32x2*)(XB + (size_t)m * DM) + lane;
#pragma unroll
        for (int j = 0; j < 8; ++j) { const f32x4 v = xr[64 * j]; u32x2 w; w.x = pk2(v[0], v[1]); w.y = pk2(v[2], v[3]); o[64 * j] = w; }
    }
    float* rc = (float*)(ws + WS_ROPE); float* rs = rc + 2080 * 128;
    for (int e = gw * 64 + lane; e < 2080 * 128; e += NGW * 64) {
        const int p = e >> 7, d = e & 127; const float pos = (float)(p < 2048 ? p : 4096 + (p - 2048));
        const float inv = __builtin_amdgcn_exp2f(-(float)d * (13.287712379549449f / 128.0f));
        const double rev = (double)(pos * inv) * 0.15915494309189535; const float fr = (float)(rev - __builtin_floor(rev));
        rc[e] = __builtin_amdgcn_cosf(fr); rs[e] = __builtin_amdgcn_sinf(fr);
    }
}

__device__ __forceinline__ void ln_pass(const float* xres_p, const float* xres_s, const float* YP, const float* g, const float* b, float* outf, bf16* outb, int gw, int NGW, int lane) {
    for (int row = gw; row < MT; row += NGW) {
        const f32x4* xr = (const f32x4*)(row < MP ? xres_p + (size_t)row * DM : xres_s + (size_t)(row - MP) * DM) + lane;
        f32x4 v[8];
#pragma unroll
        for (int j = 0; j < 8; ++j) v[j] = xr[64 * j] * ALPHA;
        if (row < MP) { const f32x4* y = (const f32x4*)(YP + (size_t)row * DM) + lane;
#pragma unroll
            for (int j = 0; j < 8; ++j) v[j] += y[64 * j];
        } else {
            for (int ks = 0; ks < 8; ++ks) { const f32x4* y = (const f32x4*)(YP + (size_t)(MP + ks * MS + (row - MP)) * DM) + lane;
#pragma unroll
                for (int j = 0; j < 8; ++j) v[j] += y[64 * j]; }
        }
        float s = 0.f;
#pragma unroll
        for (int j = 0; j < 8; ++j) s += (v[j][0] + v[j][1]) + (v[j][2] + v[j][3]);
        const float mean = wave_sum(s) * (1.f / DM); float q = 0.f;
#pragma unroll
        for (int j = 0; j < 8; ++j) { v[j] = v[j] - mean; q += (v[j][0] * v[j][0] + v[j][1] * v[j][1]) + (v[j][2] * v[j][2] + v[j][3] * v[j][3]); }
        const float rstd = 1.0f / sqrtf(wave_sum(q) * (1.f / DM) + LN_EPS);
        f32x4* of = (f32x4*)(outf + (size_t)row * DM) + lane;
#pragma unroll
        for (int j = 0; j < 8; ++j) { const f32x4 gg = ((const f32x4*)g)[lane + 64 * j], bb = ((const f32x4*)b)[lane + 64 * j]; const f32x4 o = v[j] * rstd * gg + bb; of[64 * j] = o;
            if (outb) { u32x2 w; w.x = pk2(o[0], o[1]); w.y = pk2(o[2], o[3]); ((u32x2*)(outb + (size_t)row * DM) + lane)[64 * j] = w; } }
    }
}

__device__ __forceinline__ bf16x8 frag_plain(const LAS bf16* X, int ld, int r0, int k0, int lane) { return *(const LAS bf16x8*)(X + (r0 + (lane & 15)) * ld + k0 + 8 * (lane >> 4)); }
typedef short v4i16_t __attribute__((ext_vector_type(4)));
__device__ __forceinline__ bf16x8 frag_tr(const LAS bf16* Y, int ld, int kr0, int c0, int lane) {
    const int i = lane & 15, g4 = lane >> 4; const LAS bf16* p = Y + (kr0 + 8 * g4 + (i >> 2)) * ld + c0 + 4 * (i & 3);
    const v4i16_t lo = __builtin_amdgcn_ds_read_tr16_b64_v4i16((LAS v4i16_t*)p), hi = __builtin_amdgcn_ds_read_tr16_b64_v4i16((LAS v4i16_t*)(p + 4 * ld));
    return (bf16x8){lo[0], lo[1], lo[2], lo[3], hi[0], hi[1], hi[2], hi[3]};
}
#define MFMA16(a, b, c) __builtin_amdgcn_mfma_f32_16x16x32_bf16((a), (b), (c), 0, 0, 0)

__device__ __forceinline__ void mix_phase(const Args& a, LAS unsigned char* lds, int wave, int lane) {
    const int tid = threadIdx.x;
    LAS bf16* Wm = (LAS bf16*)lds;
    LAS bf16* vn = (LAS bf16*)(lds + 34816);
    LAS f32x2* mr = (LAS f32x2*)(lds + 34816 + 67584);
    const bf16* U = (const bf16*)(a.ws + WS_R1); const bf16* V = U + (size_t)MT * DM; bf16* SB = (bf16*)(a.ws + WS_R1 + 72 * MiB);
    const f32x2* stat = (const f32x2*)(a.ws + WS_STAT);
    const float* lng = a.in[4]; const float* lnb = a.in[5]; const float* aws = a.in[6]; const float* abs_ = a.in[7];
    float* gv = a.out + (size_t)MT * DM + (size_t)(4 + 32) * 8 * 256 * 512;
    for (int item = blockIdx.x; item < 72 * 8; item += gridDim.x) {
        const int rb = item >> 3, g = item & 7, row0 = rb * 128; const bool smp = rb >= 64;
        if (tid < 128) { const f32x2* sp = stat + (size_t)(row0 + tid) * 32; float s = 0.f, q = 0.f;
#pragma unroll 8
            for (int k = 0; k < 32; ++k) { const f32x2 v = sp[k]; s += v.x; q += v.y; }
            const float mean = s * (1.f / 2048.f), var = q * (1.f / 2048.f) - mean * mean; mr[tid] = (f32x2){mean, 1.0f / sqrtf(var + LN_EPS)}; }
        { const int t = tid >> 2, s0 = (tid & 3) * 32; const int tw = smp ? (t & 31) : t;
#pragma unroll
            for (int k = 0; k < 4; ++k) { const int s = s0 + 8 * k; const int sw = smp ? (s & 31) : s;
                const f32x4 w0 = *(const f32x4*)(aws + ((size_t)g * 128 + tw) * 128 + sw), w1 = *(const f32x4*)(aws + ((size_t)g * 128 + tw) * 128 + sw + 4);
                float w[8] = {w0[0], w0[1], w0[2], w0[3], w1[0], w1[1], w1[2], w1[3]};
#pragma unroll
                for (int e = 0; e < 8; ++e) { const int ss = s + e; const bool ok = smp ? ((ss >> 5) == (t >> 5) && (ss & 31) <= (t & 31)) : (ss <= t); w[e] = ok ? w[e] : 0.f; }
                u32x4 o; o.x = pk2(w[0], w[1]); o.y = pk2(w[2], w[3]); o.z = pk2(w[4], w[5]); o.w = pk2(w[6], w[7]);
                *(LAS u32x4*)(Wm + t * 136 + s) = o; } }
        __syncthreads();
        { const int s = tid >> 2, cb = (tid & 3) * 64; const f32x2 m = mr[s]; const bf16* vp = V + (size_t)(row0 + s) * DM + g * 256 + cb;
#pragma unroll
            for (int k = 0; k < 8; ++k) { const u32x4 w = *(const u32x4*)(vp + 8 * k); const int c = g * 256 + cb + 8 * k;
                const f32x4 g0 = *(const f32x4*)(lng + c), g1 = *(const f32x4*)(lng + c + 4), b0 = *(const f32x4*)(lnb + c), b1 = *(const f32x4*)(lnb + c + 4);
                f32x4 x0 = (f32x4){bf_lo(w.x), bf_hi(w.x), bf_lo(w.y), bf_hi(w.y)}, x1 = (f32x4){bf_lo(w.z), bf_hi(w.z), bf_lo(w.w), bf_hi(w.w)};
                x0 = (x0 - m.x) * m.y * g0 + b0; x1 = (x1 - m.x) * m.y * g1 + b1;
                u32x4 o; o.x = pk2(x0[0], x0[1]); o.y = pk2(x0[2], x0[3]); o.z = pk2(x1[0], x1[1]); o.w = pk2(x1[2], x1[3]);
                *(LAS u32x4*)(vn + s * 264 + cb + 8 * k) = o;
                if (smp) { float* op = gv + (size_t)(row0 + s - MP) * DM + c; *(f32x4*)op = x0; *(f32x4*)(op + 4) = x1; } } }
        __syncthreads();
        {
            const int t0 = 16 * wave, i = lane & 15, g4 = lane >> 4; f32x4 acc[16];
#pragma unroll
            for (int ct = 0; ct < 16; ++ct) acc[ct] = (f32x4){0.f, 0.f, 0.f, 0.f};
            const int kmax = (t0 + 15) >> 5;
            for (int kk = 0; kk <= kmax; ++kk) { const bf16x8 bw = frag_plain(Wm, 136, t0, 32 * kk, lane);
#pragma unroll
                for (int ct = 0; ct < 16; ++ct) { const bf16x8 av = frag_tr(vn, 264, 32 * kk, 16 * ct, lane); acc[ct] = MFMA16(av, bw, acc[ct]); } }
            const int t = t0 + i, row = row0 + t; const float bias = abs_[g * 128 + (smp ? (t & 31) : t)];
#pragma unroll
            for (int ct = 0; ct < 16; ++ct) { const size_t off = (size_t)row * DM + g * 256 + 16 * ct + 4 * g4; const u32x2 uu = *(const u32x2*)(U + off);
                u32x2 o; o.x = pk2(bf_lo(uu.x) * (acc[ct][0] + bias), bf_hi(uu.x) * (acc[ct][1] + bias)); o.y = pk2(bf_lo(uu.y) * (acc[ct][2] + bias), bf_hi(uu.y) * (acc[ct][3] + bias));
                *(u32x2*)(SB + off) = o; }
        }
        __syncthreads();
    }
}
constexpr int R_QS = 0, R_KS = 33792, R_VS = 67584, R_PS = 76800, R_RT = 86016, R_OS = 119808;
template <int L>
__device__ __forceinline__ void ret_run(LAS unsigned char* lds, const bf16* QH, const bf16* KH, const bf16* VB, bf16* OB, int grow0, int nblk, int h, int slice, const float* S0, float* Sout, int wave, int lane) {
    const int tid = threadIdx.x, i = lane & 15, g4 = lane >> 4;
    LAS bf16* qs = (LAS bf16*)(lds + R_QS); LAS bf16* ks = (LAS bf16*)(lds + R_KS); LAS bf16* vs = (LAS bf16*)(lds + R_VS);
    LAS bf16* ps = (LAS bf16*)(lds + R_PS); LAS bf16* rts = (LAS bf16*)(lds + R_RT); LAS bf16* os = (LAS bf16*)(lds + R_OS);
    const float lg = pg8::lg2gamma(h);
    const float gL = __builtin_amdgcn_exp2f(lg * (float)L), gLm1 = __builtin_amdgcn_exp2f(lg * (float)(L - 1)), gLm1i = __builtin_amdgcn_exp2f(-lg * (float)(L - 1));
    constexpr int NQ = L / 16, NT = L / 32, NKK = L / 32;
    const bool vthr = (L == 64) || tid < 256;
    u32x4 pq[NQ], pk[NQ], pv;
#define RET_GLOAD(blk) do { const int r0_ = grow0 + (blk) * L; _Pragma("unroll") for (int k_ = 0; k_ < NQ; ++k_) { const int e_ = tid + 512 * k_, row_ = e_ >> 5, ch_ = e_ & 31; \
        pq[k_] = *(const u32x4*)(QH + (size_t)(r0_ + row_) * 2048 + h * 256 + ch_ * 8); pk[k_] = *(const u32x4*)(KH + (size_t)(r0_ + row_) * 2048 + h * 256 + ch_ * 8); } \
        if (vthr) pv = *(const u32x4*)(VB + (size_t)(r0_ + (tid >> 3)) * 4096 + h * 512 + slice * 64 + (tid & 7) * 8); } while (0)
#define RET_LSTORE() do { _Pragma("unroll") for (int k_ = 0; k_ < NQ; ++k_) { const int e_ = tid + 512 * k_, row_ = e_ >> 5, ch_ = e_ & 31; \
        *(LAS u32x4*)(qs + row_ * 264 + ch_ * 8) = pq[k_]; *(LAS u32x4*)(ks + row_ * 264 + ch_ * 8) = pk[k_]; } \
        if (vthr) *(LAS u32x4*)(vs + (tid >> 3) * 72 + (tid & 7) * 8) = pv; } while (0)
    f32x4 R[2][4];
    RET_GLOAD(0);
#pragma unroll
    for (int a2 = 0; a2 < 2; ++a2)
#pragma unroll
        for (int d = 0; d < 4; ++d) {
            if (S0) {
#pragma unroll
                for (int e = 0; e < 4; ++e) R[a2][d][e] = S0[(size_t)(32 * wave + 16 * a2 + 4 * g4 + e) * 512 + slice * 64 + 16 * d + i] * gLm1i;
            } else R[a2][d] = (f32x4){0.f, 0.f, 0.f, 0.f};
            u32x2 w; w.x = pk2(R[a2][d][0], R[a2][d][1]); w.y = pk2(R[a2][d][2], R[a2][d][3]);
            *(LAS u32x2*)(rts + (16 * d + i) * 264 + 32 * wave + 16 * a2 + 4 * g4) = w; }
    RET_LSTORE();
    __syncthreads();
    const int it = (L == 64) ? (wave >> 1) : (wave >> 2);
    for (int n = 0; n < nblk; ++n) {
        if (n + 1 < nblk) RET_GLOAD(n + 1);
        if (L == 64 || wave < 4) {
#pragma unroll
            for (int tp = 0; tp < NT; ++tp) { const int i0 = 16 * (wave >> 1), j0 = (L == 64) ? 16 * (2 * (wave & 1) + tp) : 16 * (wave & 1);
                f32x4 acc = (f32x4){0.f, 0.f, 0.f, 0.f};
#pragma unroll
                for (int kk = 0; kk < 8; ++kk) acc = MFMA16(frag_plain(ks, 264, j0, 32 * kk, lane), frag_plain(qs, 264, i0, 32 * kk, lane), acc);
#pragma unroll
                for (int e = 0; e < 4; ++e) acc[e] = (j0 + 4 * g4 + e <= i0 + i) ? acc[e] : 0.f;
                u32x2 w; w.x = pk2(acc[0], acc[1]); w.y = pk2(acc[2], acc[3]); *(LAS u32x2*)(ps + (i0 + i) * 72 + j0 + 4 * g4) = w; }
        }
        f32x4 oacc[NT];
#pragma unroll
        for (int tp = 0; tp < NT; ++tp) { const int dv0 = (L == 64) ? 16 * (2 * (wave & 1) + tp) : 16 * (wave & 3);
            f32x4 acc = (f32x4){0.f, 0.f, 0.f, 0.f};
#pragma unroll
            for (int kk = 0; kk < 8; ++kk) acc = MFMA16(frag_plain(rts, 264, dv0, 32 * kk, lane), frag_plain(qs, 264, 16 * it, 32 * kk, lane), acc);
            oacc[tp] = acc * gL; }
        __syncthreads();
#pragma unroll
        for (int tp = 0; tp < NT; ++tp) { const int dv0 = (L == 64) ? 16 * (2 * (wave & 1) + tp) : 16 * (wave & 3);
#pragma unroll
            for (int kk = 0; kk < NKK; ++kk) oacc[tp] = MFMA16(frag_tr(vs, 72, 32 * kk, dv0, lane), frag_plain(ps, 72, 16 * it, 32 * kk, lane), oacc[tp]);
            u32x2 w; w.x = pk2(oacc[tp][0], oacc[tp][1]); w.y = pk2(oacc[tp][2], oacc[tp][3]); *(LAS u32x2*)(os + (16 * it + i) * 72 + dv0 + 4 * g4) = w; }
#pragma unroll
        for (int a2 = 0; a2 < 2; ++a2)
#pragma unroll
            for (int d = 0; d < 4; ++d) R[a2][d] = R[a2][d] * gL;
#pragma unroll
        for (int kk = 0; kk < NKK; ++kk) { bf16x8 bv[4];
#pragma unroll
            for (int d = 0; d < 4; ++d) bv[d] = frag_tr(vs, 72, 32 * kk, 16 * d, lane);
#pragma unroll
            for (int a2 = 0; a2 < 2; ++a2) { const bf16x8 av = frag_tr(ks, 264, 32 * kk, 32 * wave + 16 * a2, lane);
#pragma unroll
                for (int d = 0; d < 4; ++d) R[a2][d] = MFMA16(av, bv[d], R[a2][d]); } }
        __syncthreads();
#pragma unroll
        for (int a2 = 0; a2 < 2; ++a2)
#pragma unroll
            for (int d = 0; d < 4; ++d) { u32x2 w; w.x = pk2(R[a2][d][0], R[a2][d][1]); w.y = pk2(R[a2][d][2], R[a2][d][3]);
                *(LAS u32x2*)(rts + (16 * d + i) * 264 + 32 * wave + 16 * a2 + 4 * g4) = w; }
        if (vthr) *(u32x4*)(OB + (size_t)(grow0 + n * L + (tid >> 3)) * 4096 + h * 512 + slice * 64 + (tid & 7) * 8) = *(const LAS u32x4*)(os + (tid >> 3) * 72 + (tid & 7) * 8);
        if (n + 1 < nblk) RET_LSTORE();
        __syncthreads();
    }
#pragma unroll
    for (int a2 = 0; a2 < 2; ++a2)
#pragma unroll
        for (int d = 0; d < 4; ++d)
#pragma unroll
            for (int e = 0; e < 4; ++e) Sout[(size_t)(32 * wave + 16 * a2 + 4 * g4 + e) * 512 + slice * 64 + 16 * d + i] = R[a2][d][e] * gLm1;
#undef RET_GLOAD
#undef RET_LSTORE
}
__device__ __forceinline__ void ret_phase(const Args& a, LAS unsigned char* lds, int wave, int lane) {
    const bf16* QH = (const bf16*)(a.ws + WS_R1); const bf16* KH = QH + (size_t)MT * DM; const bf16* VB = (const bf16*)(a.ws + WS_R1 + 72 * MiB); bf16* OB = (bf16*)(a.ws + WS_YP);
    float* sp = a.out + (size_t)MT * DM; float* ss = sp + (size_t)4 * 8 * 256 * 512;
    for (int item = blockIdx.x; item < 256; item += gridDim.x) {
        const int x = item & 7, j = item >> 3, bh = x * 4 + (j >> 3), slice = j & 7, b = bh >> 3, h = bh & 7;
        ret_run<64>(lds, QH, KH, VB, OB, b * 2048, 32, h, slice, nullptr, sp + (size_t)bh * 256 * 512, wave, lane);
    }
    for (int pair = blockIdx.x; pair < 256; pair += gridDim.x) {
        const int b = pair >> 3, h = pair & 7;
        for (int slice = 0; slice < 8; ++slice)
            ret_run<32>(lds, QH, KH, VB, OB, MP + b * 32, 1, h, slice, a.in[2] + (size_t)pair * 256 * 512, ss + (size_t)pair * 256 * 512, wave, lane);
    }
}
__device__ __forceinline__ void gn_gate(const Args& a, int gw, int NGW, int lane) {
    const bf16* O = (const bf16*)(a.ws + WS_YP); bf16* GS = (bf16*)(a.ws + WS_R1 + 144 * MiB);
    for (int p = gw; p < MT * 8; p += NGW) {
        const size_t off = (size_t)(p >> 3) * 4096 + (p & 7) * 512 + 8 * lane;
        const u32x4 ow = *(const u32x4*)(O + off), gwv = *(const u32x4*)(GS + off);
        float o[8] = {bf_lo(ow.x), bf_hi(ow.x), bf_lo(ow.y), bf_hi(ow.y), bf_lo(ow.z), bf_hi(ow.z), bf_lo(ow.w), bf_hi(ow.w)};
        const float g[8] = {bf_lo(gwv.x), bf_hi(gwv.x), bf_lo(gwv.y), bf_hi(gwv.y), bf_lo(gwv.z), bf_hi(gwv.z), bf_lo(gwv.w), bf_hi(gwv.w)};
        float s = 0.f;
#pragma unroll
        for (int e = 0; e < 8; ++e) s += o[e];
        const float mean = wave_sum(s) * (1.f / 512.f); float q = 0.f;
#pragma unroll
        for (int e = 0; e < 8; ++e) { o[e] -= mean; q += o[e] * o[e]; }
        const float rstd = 1.0f / sqrtf(wave_sum(q) * (1.f / 512.f) + GN_EPS);
        u32x4 w; w.x = pk2(g[0] * o[0] * rstd, g[1] * o[1] * rstd); w.y = pk2(g[2] * o[2] * rstd, g[3] * o[3] * rstd); w.z = pk2(g[4] * o[4] * rstd, g[5] * o[5] * rstd); w.w = pk2(g[6] * o[6] * rstd, g[7] * o[7] * rstd);
        *(u32x4*)(GS + off) = w;
    }
}


#ifndef DBG_STOP
#define DBG_STOP 0
#endif
__device__ __forceinline__ void dbg_dump(const Args& a, const bf16* src, size_t n_el) {
    const size_t T = (size_t)gridDim.x * 512, t = (size_t)blockIdx.x * 512 + threadIdx.x, total = 58720256;
    for (size_t i = t; i < total; i += T) { float v = 0.f; if (i < n_el / 2) { const unsigned w = ((const unsigned*)src)[i]; v = bf_lo(w) + bf_hi(w); } a.out[i] = v; }
}
__device__ __forceinline__ void dbg_dump_f32(const Args& a, const float* src, size_t n_el) {
    const size_t T = (size_t)gridDim.x * 512, t = (size_t)blockIdx.x * 512 + threadIdx.x, total = 58720256;
    for (size_t i = t; i < total; i += T) a.out[i] = i < n_el ? src[i] : 0.f;
}
__global__ void __launch_bounds__(512, 2) fwd(Args a) {
    extern __shared__ __attribute__((aligned(16))) unsigned char lds_raw[];
    cg::grid_group grid = cg::this_grid();
    LAS unsigned char* lds = (LAS unsigned char*)lds_raw;
    const int tid = threadIdx.x, lane = tid & 63, wave = __builtin_amdgcn_readfirstlane(tid >> 6);
    const int G = gridDim.x, c = blockIdx.x, vcu = (G % 8 == 0) ? (c % 8) * (G / 8) + c / 8 : c, gw = vcu * NW + wave, NGW = G * NW;
    unsigned char* ws = a.ws;
    bf16* XB = (bf16*)(ws + WS_XB); float* YP = (float*)(ws + WS_YP); float* XF = (float*)(ws + WS_XF);
    bf16* R1 = (bf16*)(ws + WS_R1);
#define GEMM(EPI, E, Ap, Bp, LD, M1, N, K, SPLIT) do { pg8::Gemm g_{(const pg8::bf16_t*)(Ap), (const pg8::bf16_t*)(Bp), (LD)}; pg8::Order S_; S_.init((M1), (N), (K), (SPLIT), G, c); \
        pg8::gemm_phase<EPI, pg8::Order, true, true>(lds, g_, S_, E); } while (0)

#define GRID_SYNC() do { asm volatile("s_waitcnt vmcnt(0) lgkmcnt(0)" ::: "memory"); grid.sync(); } while (0)

#define DBG_DUMP_1 dbg_dump(a, XB, (size_t)MT * DM)
#define DBG_DUMP_2 dbg_dump(a, R1, (size_t)2 * MT * DM)
#define DBG_DUMP_3 dbg_dump(a, R1 + (size_t)2 * MT * DM, (size_t)MT * DM)
#define DBG_DUMP_4 dbg_dump_f32(a, YP, (size_t)2 * MP * DM)
#define DBG_DUMP_5 dbg_dump_f32(a, XF, (size_t)MT * DM)
#define DBG_DUMP_6 dbg_dump(a, R1, (size_t)MT * FF)
#define DBG_DUMP_7 dbg_dump_f32(a, YP, (size_t)2 * MP * DM)
#define DBG_DUMP_8 dbg_dump_f32(a, XF, (size_t)MT * DM)
#define DBG_DUMP_9 dbg_dump(a, R1, (size_t)6 * MT * DM)
#define DBG_DUMP_10 dbg_dump(a, (const bf16*)YP, (size_t)2 * MT * DM)
#define DBG_DUMP_11 dbg_dump(a, R1 + (size_t)4 * MT * DM, (size_t)2 * MT * DM)
#define DBG_DUMP_12 dbg_dump_f32(a, YP, (size_t)2 * MP * DM)
#define DBG_DUMP_13 dbg_dump_f32(a, XF, (size_t)MT * DM)
#define DBG_DUMP_14 dbg_dump(a, R1, (size_t)MT * FF)
#define DBG_DUMP_15 dbg_dump_f32(a, YP, (size_t)2 * MP * DM)
    p0_prologue(a, lds, gw, NGW, wave, lane);
    GRID_SYNC();
    if (DBG_STOP == 1) { DBG_DUMP_1; return; }
    { pg8::EpiGeluUV E{R1, R1 + (size_t)MT * DM, (pg8::f32x2*)(ws + WS_STAT)}; GEMM(pg8::EpiGeluUV, E, XB, ws + WS_WAIN, 2048, MT, 4096, 2048, 0); }
    GRID_SYNC();
    if (DBG_STOP == 2) { DBG_DUMP_2; return; }
    mix_phase(a, lds, wave, lane);
    GRID_SYNC();
    if (DBG_STOP == 3) { DBG_DUMP_3; return; }
    { pg8::EpiPart E{YP}; GEMM(pg8::EpiPart, E, ws + WS_R1 + 72 * MiB, ws + WS_WAOUT, 2048, MP, 2048, 2048, 1); }
    GRID_SYNC();
    if (DBG_STOP == 4) { DBG_DUMP_4; return; }
    ln_pass(a.in[0], a.in[1], YP, a.in[13], a.in[14], XF, XB, gw, NGW, lane);
    GRID_SYNC();
    if (DBG_STOP == 5) { DBG_DUMP_5; return; }
    { pg8::EpiSwiglu E{R1}; GEMM(pg8::EpiSwiglu, E, XB, ws + WS_WFIN, 2048, MT, 11264, 2048, 0); }
    GRID_SYNC();
    if (DBG_STOP == 6) { DBG_DUMP_6; return; }
    { pg8::EpiPart E{YP}; GEMM(pg8::EpiPart, E, R1, ws + WS_WFOUT, 5632, MP, 2048, 5632, 1); }
    GRID_SYNC();
    if (DBG_STOP == 7) { DBG_DUMP_7; return; }
    ln_pass(XF, XF + (size_t)MP * DM, YP, a.in[15], a.in[16], XF, XB, gw, NGW, lane);
    GRID_SYNC();
    if (DBG_STOP == 8) { DBG_DUMP_8; return; }
    { pg8::EpiQKVG E{R1, R1 + (size_t)MT * DM, (pg8::bf16_t*)(ws + WS_R1 + 72 * MiB), (pg8::bf16_t*)(ws + WS_R1 + 144 * MiB), (const float*)(ws + WS_ROPE), (const float*)(ws + WS_ROPE) + 2080 * 128};
      GEMM(pg8::EpiQKVG, E, XB, ws + WS_WBIN, 2048, MT, 12288, 2048, 0); }
    GRID_SYNC();
    if (DBG_STOP == 9) { DBG_DUMP_9; return; }
    ret_phase(a, lds, wave, lane);
    GRID_SYNC();
    if (DBG_STOP == 10) { DBG_DUMP_10; return; }
    gn_gate(a, gw, NGW, lane);
    GRID_SYNC();
    if (DBG_STOP == 11) { DBG_DUMP_11; return; }
    { pg8::EpiPart E{YP}; GEMM(pg8::EpiPart, E, ws + WS_R1 + 144 * MiB, ws + WS_WBOUT, 4096, MP, 2048, 4096, 1); }
    GRID_SYNC();
    if (DBG_STOP == 12) { DBG_DUMP_12; return; }
    ln_pass(XF, XF + (size_t)MP * DM, YP, a.in[13] + DM, a.in[14] + DM, XF, XB, gw, NGW, lane);
    GRID_SYNC();
    if (DBG_STOP == 13) { DBG_DUMP_13; return; }
    { pg8::EpiSwiglu E{R1}; GEMM(pg8::EpiSwiglu, E, XB, ws + WS_WFIN + 44 * MiB, 2048, MT, 11264, 2048, 0); }
    GRID_SYNC();
    if (DBG_STOP == 14) { DBG_DUMP_14; return; }
    { pg8::EpiPart E{YP}; GEMM(pg8::EpiPart, E, R1, ws + WS_WFOUT + 22 * MiB, 5632, MP, 2048, 5632, 1); }
    GRID_SYNC();
    if (DBG_STOP == 15) { DBG_DUMP_15; return; }
    ln_pass(XF, XF + (size_t)MP * DM, YP, a.in[15] + DM, a.in[16] + DM, a.out, nullptr, gw, NGW, lane);
#undef GEMM
}

extern "C" void kernel_launch(void* const* d_in, const int* in_sizes, int n_in, void* d_out, int out_size, void* d_ws, size_t ws_size, hipStream_t stream) {
    static int grid = 0;
    if (grid == 0) {
        if (n_in != 17 || ws_size < WS_END) { fprintf(stderr, "kernel_launch: needs 17 inputs and >= %zu bytes of workspace (got %d, %zu)\n", (size_t)WS_END, n_in, ws_size); grid = -1; return; }
        int dev = 0, cus = 0, per_cu = 0;
        if (hipGetDevice(&dev) != hipSuccess || hipDeviceGetAttribute(&cus, hipDeviceAttributeMultiprocessorCount, dev) != hipSuccess) { grid = -1; return; }
        if (hipFuncSetAttribute((const void*)fwd, hipFuncAttributeMaxDynamicSharedMemorySize, LDS_BYTES) != hipSuccess) { fprintf(stderr, "kernel_launch: hipFuncSetAttribute failed\n"); grid = -1; return; }
        if (hipOccupancyMaxActiveBlocksPerMultiprocessor(&per_cu, (const void*)fwd, NW * 64, LDS_BYTES) != hipSuccess || per_cu < 1) { fprintf(stderr, "kernel_launch: occupancy query reports %d workgroups per CU\n", per_cu); grid = -1; return; }
        grid = cus;
    }
    if (grid < 0) return;
    Args a{};
    for (int i = 0; i < 17; ++i) a.in[i] = (const float*)d_in[i];
    a.out = (float*)d_out; a.ws = (unsigned char*)d_ws;
    void* args[] = {&a};
    const hipError_t e = hipLaunchCooperativeKernel((const void*)fwd, dim3(grid), dim3(NW * 64), args, LDS_BYTES, stream);
    if (e != hipSuccess) fprintf(stderr, "kernel_launch: cooperative launch failed: %s (grid %d)\n", hipGetErrorString(e), grid);
}
```

```cpp
#include <hip/hip_runtime.h>
#include <hip/hip_cooperative_groups.h>
#include <cstdio>
#include <cstdint>
namespace cg = cooperative_groups;

constexpr int DM = 2048, MP = 8192, MS = 1024, MT = MP + MS, FF = 5632, NQKVG = 12288, RV = 4096;
constexpr float ALPHA = 1.41421356237309515f;
constexpr float LN_EPS = 1e-5f, GN_EPS = 1e-6f;

namespace pg8 {
#define PG8_LAS __attribute__((address_space(3)))
typedef unsigned short bf16_t;
typedef short bf16x8 __attribute__((ext_vector_type(8)));
typedef float f32x4 __attribute__((ext_vector_type(4)));
typedef unsigned u32x4 __attribute__((ext_vector_type(4)));
constexpr int BM = 256, BK = 64, HALF = 128, HTB = HALF * BK * 2  , STAGE_BYTES = 8 * HTB, NXCD = 8, WGM = 8;

__host__ __device__ __forceinline__ int lds_byte(int r, int c) { const int st = (r >> 4) * 2 + (c >> 5), rr = r & 15, cc = c & 31, ob = rr * 64 + cc * 2; return st * 1024 + (ob ^ (((ob >> 9) & 1) << 5)); }
__host__ __device__ __forceinline__ void stage_rc(int b, int& R, int& C) { const int st = b / 1024, sb = b % 1024, swz = sb ^ (((sb >> 9) & 1) << 5); R = (st >> 1) * 16 + swz / 64; C = (st & 1) * 32 + (swz % 64) / 2; }
__host__ __device__ __forceinline__ int perm32(int rho) { const int n = rho >> 4, i = rho & 15; return 8 * (i >> 2) + 4 * n + (i & 3); }

struct Unit { int pm, pn, k0, nt, ks; };
struct Gemm { const bf16_t* A; const bf16_t* Bt; int ld; };

struct StaticOrder {
    int nM, nN, nwg, G, c;
    __host__ __device__ void init(int M, int N, int G_, int c_) { nM = M / BM; nN = N / BM; nwg = nM * nN; G = G_; c = c_; }
    __host__ __device__ __forceinline__ void tile(int L, int& pm_, int& pn_) const {
        int wgid = L; { const int q = nwg / NXCD, r = nwg % NXCD, xcd = wgid % NXCD, off = wgid / NXCD; wgid = (xcd < r ? xcd * (q + 1) : r * (q + 1) + (xcd - r) * q) + off; }
        const int nig = WGM * nN, gid = wgid / nig, fm = gid * WGM, gsz = (nM - fm) < WGM ? (nM - fm) : WGM;
        pm_ = fm + ((wgid % nig) % gsz); pn_ = (wgid % nig) / gsz;
    }
    __device__ __forceinline__ void a_ready(const Unit&) const {}
    __device__ __forceinline__ void done(const Unit&) const {}
};

typedef float f32x2_cv __attribute__((ext_vector_type(2))); typedef __bf16 bf16x2_cv __attribute__((ext_vector_type(2)));
__device__ __forceinline__ unsigned cvt_pk_bf16(float lo, float hi) { const f32x2_cv v = {lo, hi}; const bf16x2_cv b = __builtin_convertvector(v, bf16x2_cv); return __builtin_bit_cast(unsigned, b); }
typedef float f32x2 __attribute__((ext_vector_type(2)));
__device__ __forceinline__ f32x2 gelu_pk(f32x2 v) {
    const f32x2 av = __builtin_elementwise_abs(v), d = av * 0.2316418882f + 1.0f;
    f32x2 t; t.x = __builtin_amdgcn_rcpf(d.x); t.y = __builtin_amdgcn_rcpf(d.y);
    f32x2 q = t * 0.5307027145f + (-0.7265760135f); q = q * t + 0.7107068705f; q = q * t + (-0.142248368f); q = q * t + 0.127414796f; q = q * t;
    const f32x2 s = (v * v) * (-0.72134752044f);
    f32x2 e; e.x = __builtin_amdgcn_exp2f(s.x); e.y = __builtin_amdgcn_exp2f(s.y);
    const f32x2 m = v * (q * e), r = v - m;
    f32x2 o; o.x = v.x < 0.f ? m.x : r.x; o.y = v.y < 0.f ? m.y : r.y; return o;
}
struct Order {
    StaticOrder so; int G, c, n1c, ntk, split;
    __device__ __forceinline__ void init(int M1, int N, int K, int split_, int G_, int c_) { so.init(M1, N, G_, c_); G = G_; c = c_; ntk = K / BK; split = split_; n1c = (c < so.nwg) ? (so.nwg - c + G - 1) / G : 0; }
    __device__ __forceinline__ bool next(int i, Unit& u) const {
        const bool p1 = i < n1c; int pm1, pn1; so.tile(p1 ? i * G + c : 0, pm1, pn1);
        const int j = (i - n1c) * G + c; const bool p2 = !p1 && split != 0 && j < 256;
        const int ks = j & 7, jj = (j >> 3) & 31, b = (ntk >> 3) & ~1, rem2 = (ntk - 8 * b) >> 1;
        Unit r; r.pm = p1 ? pm1 : so.nM + (jj & 3); r.pn = p1 ? pn1 : (jj >> 2); r.k0 = p1 ? 0 : (ks * b + 2 * (ks < rem2 ? ks : rem2)) * BK; r.nt = p1 ? ntk : b + (ks < rem2 ? 2 : 0); r.ks = p1 ? -1 : ks;
        u = r; return p1 || p2;
    }
    __device__ __forceinline__ void a_ready(const Unit&) const {}
    __device__ __forceinline__ void done(const Unit&) const {}
};

__device__ __forceinline__ float silu_f(float x) { return x * __builtin_amdgcn_rcpf(1.0f + __builtin_amdgcn_exp2f(-1.4426950408889634f * x)); }

struct EpiPart {
    static constexpr bool PERM = false, AFTER_DRAIN = false;
    float* Y;
    __device__ __forceinline__ void operator()(const f32x4 (&acc)[2][2][4][2], const Unit& u, int wr, int wc, int fr, int fq) const {
        const int row0 = u.pm * BM + wr * 64 + fr + (u.ks > 0 ? u.ks * 1024 : 0), col0 = u.pn * BM + wc * 32 + 4 * fq;
#pragma unroll
        for (int ai = 0; ai < 2; ++ai)
#pragma unroll
            for (int m = 0; m < 4; ++m) { float* rowp = Y + (size_t)(row0 + ai * HALF + m * 16) * 2048 + col0;
#pragma unroll
                for (int bj = 0; bj < 2; ++bj)
#pragma unroll
                    for (int n = 0; n < 2; ++n) *(f32x4*)(rowp + bj * HALF + n * 16) = acc[ai][bj][m][n]; }
    }
};
struct EpiGeluUV {
    static constexpr bool PERM = true, AFTER_DRAIN = false;
    bf16_t* U; bf16_t* V; f32x2* stat;
    __device__ __forceinline__ void operator()(const f32x4 (&acc)[2][2][4][2], const Unit& u, int wr, int wc, int fr, int fq) const {
        const bool isv = u.pn >= 8; bf16_t* O = isv ? V : U;
        const int row0 = u.pm * BM + wr * 64 + fr, col0 = (u.pn & 7) * BM + wc * 32 + 8 * fq;
#pragma unroll
        for (int ai = 0; ai < 2; ++ai)
#pragma unroll
            for (int m = 0; m < 4; ++m) { const int row = row0 + ai * HALF + m * 16; bf16_t* rowp = O + (size_t)row * 2048 + col0; float s = 0.f, q = 0.f;
#pragma unroll
                for (int bj = 0; bj < 2; ++bj) { const f32x4 v0 = acc[ai][bj][m][0], v1 = acc[ai][bj][m][1];
                    const f32x2 a = gelu_pk((f32x2){v0[0], v0[1]}), b = gelu_pk((f32x2){v0[2], v0[3]}), c = gelu_pk((f32x2){v1[0], v1[1]}), d = gelu_pk((f32x2){v1[2], v1[3]});
                    s += ((a.x + a.y) + (b.x + b.y)) + ((c.x + c.y) + (d.x + d.y));
                    q += ((a.x * a.x + a.y * a.y) + (b.x * b.x + b.y * b.y)) + ((c.x * c.x + c.y * c.y) + (d.x * d.x + d.y * d.y));
                    u32x4 w; w.x = cvt_pk_bf16(a.x, a.y); w.y = cvt_pk_bf16(b.x, b.y); w.z = cvt_pk_bf16(c.x, c.y); w.w = cvt_pk_bf16(d.x, d.y);
                    *(u32x4*)(rowp + bj * HALF) = w; }
                if (isv) { s += __shfl_xor(s, 16); s += __shfl_xor(s, 32); q += __shfl_xor(q, 16); q += __shfl_xor(q, 32);
                    if (fq == 0) stat[(size_t)row * 32 + (u.pn - 8) * 4 + wc] = (f32x2){s, q}; } }
    }
};
struct EpiSwiglu {
    static constexpr bool PERM = true, AFTER_DRAIN = false;
    bf16_t* H;
    __device__ __forceinline__ void operator()(const f32x4 (&acc)[2][2][4][2], const Unit& u, int wr, int wc, int fr, int fq) const {
        const int row0 = u.pm * BM + wr * 64 + fr, col0 = u.pn * HALF + wc * 32 + 8 * fq;
#pragma unroll
        for (int ai = 0; ai < 2; ++ai)
#pragma unroll
            for (int m = 0; m < 4; ++m) { bf16_t* rowp = H + (size_t)(row0 + ai * HALF + m * 16) * 5632 + col0;
                const f32x4 g0 = acc[ai][0][m][0], g1 = acc[ai][0][m][1], u0 = acc[ai][1][m][0], u1 = acc[ai][1][m][1];
                u32x4 w; w.x = cvt_pk_bf16(silu_f(g0[0]) * u0[0], silu_f(g0[1]) * u0[1]); w.y = cvt_pk_bf16(silu_f(g0[2]) * u0[2], silu_f(g0[3]) * u0[3]);
                w.z = cvt_pk_bf16(silu_f(g1[0]) * u1[0], silu_f(g1[1]) * u1[1]); w.w = cvt_pk_bf16(silu_f(g1[2]) * u1[2], silu_f(g1[3]) * u1[3]);
                *(u32x4*)rowp = w; }
    }
};
__device__ __forceinline__ float lg2gamma(int h) {
    const double x = 1.0 / (double)(32 << h); double p = x, s = 0.0;
    const double inv[8] = {1.0, 0.5, 1.0 / 3.0, 0.25, 0.2, 1.0 / 6.0, 1.0 / 7.0, 0.125};
#pragma unroll
    for (int k = 0; k < 8; ++k) { s -= p * inv[k]; p *= x; }
    return (float)(s * 1.4426950408889634);
}
struct EpiQKVG {
    static constexpr bool PERM = true, AFTER_DRAIN = false;
    bf16_t *QH, *KH, *VB, *GS; const float* ropec; const float* ropes;
    __device__ __forceinline__ void operator()(const f32x4 (&acc)[2][2][4][2], const Unit& u, int wr, int wc, int fr, int fq) const {
        const int row0 = u.pm * BM + wr * 64 + fr, cw = wc * 32 + 8 * fq;
        if (u.pn < 16) {
            const bool isq = u.pn < 8; const int head = u.pn & 7; bf16_t* O = (isq ? QH : KH) + head * 256 + cw;
            const float lg = lg2gamma(head) * (isq ? 1.f : -1.f), sc0 = isq ? 0.0625f : 1.f;
#pragma unroll
            for (int ai = 0; ai < 2; ++ai)
#pragma unroll
                for (int m = 0; m < 4; ++m) { const int row = row0 + ai * HALF + m * 16;
                    const int pidx = row < MP ? (row & 2047) : 2048 + ((row - MP) & 31), ib = row < MP ? (row & 63) : ((row - MP) & 31);
                    const float sc = sc0 * __builtin_amdgcn_exp2f(lg * (float)ib);
                    const f32x4 c0 = *(const f32x4*)(ropec + pidx * 128 + cw), c1 = *(const f32x4*)(ropec + pidx * 128 + cw + 4);
                    const f32x4 s0 = *(const f32x4*)(ropes + pidx * 128 + cw), s1 = *(const f32x4*)(ropes + pidx * 128 + cw + 4);
                    const f32x4 a0 = acc[ai][0][m][0], a1 = acc[ai][0][m][1], b0 = acc[ai][1][m][0], b1 = acc[ai][1][m][1];
                    const f32x4 o0 = (a0 * c0 - b0 * s0) * sc, o1 = (a1 * c1 - b1 * s1) * sc, p0 = (a0 * s0 + b0 * c0) * sc, p1 = (a1 * s1 + b1 * c1) * sc;
                    u32x4 w; w.x = cvt_pk_bf16(o0[0], o0[1]); w.y = cvt_pk_bf16(o0[2], o0[3]); w.z = cvt_pk_bf16(o1[0], o1[1]); w.w = cvt_pk_bf16(o1[2], o1[3]);
                    *(u32x4*)(O + (size_t)row * 2048) = w;
                    w.x = cvt_pk_bf16(p0[0], p0[1]); w.y = cvt_pk_bf16(p0[2], p0[3]); w.z = cvt_pk_bf16(p1[0], p1[1]); w.w = cvt_pk_bf16(p1[2], p1[3]);
                    *(u32x4*)(O + (size_t)row * 2048 + HALF) = w; }
        } else {
            const bool isg = u.pn >= 32; bf16_t* O = (isg ? GS : VB) + ((u.pn - 16) & 15) * BM + cw;
#pragma unroll
            for (int ai = 0; ai < 2; ++ai)
#pragma unroll
                for (int m = 0; m < 4; ++m) { bf16_t* rowp = O + (size_t)(row0 + ai * HALF + m * 16) * 4096;
#pragma unroll
                    for (int bj = 0; bj < 2; ++bj) { f32x4 v0 = acc[ai][bj][m][0], v1 = acc[ai][bj][m][1];
                        if (isg) { v0 = (f32x4){silu_f(v0[0]), silu_f(v0[1]), silu_f(v0[2]), silu_f(v0[3])}; v1 = (f32x4){silu_f(v1[0]), silu_f(v1[1]), silu_f(v1[2]), silu_f(v1[3])}; }
                        u32x4 w; w.x = cvt_pk_bf16(v0[0], v0[1]); w.y = cvt_pk_bf16(v0[2], v0[3]); w.z = cvt_pk_bf16(v1[0], v1[1]); w.w = cvt_pk_bf16(v1[2], v1[3]);
                        *(u32x4*)(rowp + bj * HALF) = w; } }
        }
    }
};
template <class Epi, class Sched, bool ALIGN_EPI = false, bool SP2 = false>
__device__ __forceinline__ void gemm_phase(PG8_LAS unsigned char* lds, const Gemm g, const Sched& S, const Epi& E) {
    int tid_ = threadIdx.x; asm volatile("" : "+v"(tid_));
    const int tid = tid_, wid = __builtin_amdgcn_readfirstlane(tid >> 6), lane = tid & 63, wr = wid >> 2, wc = wid & 3, fr = lane & 15, fq = lane >> 4;
    const int K = g.ld;
    unsigned voffA[2], voffB[2];
#pragma unroll
    for (int i = 0; i < 2; ++i) { int R, C; stage_rc(tid * 16 + i * 8192, R, C); const int Rb = Epi::PERM ? ((R & ~31) + perm32(R & 31)) : R;
        voffA[i] = (unsigned)(R * K + C) * 2u; voffB[i] = (unsigned)(Rb * K + C) * 2u; }
    const size_t kstep = (size_t)(BK * 2);
    const size_t hstep = (size_t)HALF * K * 2;
    const size_t tstep = 2 * hstep;
    const unsigned ldsw = (unsigned)wid * 1024u;
    const int aoff = lds_byte(wr * 64 + fr, fq * 8), boff = lds_byte(wc * 32 + fr, fq * 8);
#define PG8_SA(b, h) (((b) * 2 + (h)) * HTB)
#define PG8_SB(b, h) ((4 + (b) * 2 + (h)) * HTB)
#define PG8_STAGE(bufoff, gbase, voff) do { _Pragma("unroll") for (int _i = 0; _i < 2; ++_i) \
        __builtin_amdgcn_global_load_lds((const unsigned*)((const char*)(gbase) + (voff)[_i]), (PG8_LAS unsigned*)(lds + (bufoff) + ldsw + _i * 8192), 16, 0, 0); } while (0)
#define PG8_LDA(dst, b, h) do { _Pragma("unroll") for (int m = 0; m < 4; ++m) _Pragma("unroll") for (int k = 0; k < 2; ++k) dst[m][k] = *(const PG8_LAS bf16x8*)(lds + PG8_SA(b, h) + aoff + m * 2048 + k * 1024); } while (0)
#define PG8_LDB(dst, b, h) do { _Pragma("unroll") for (int n = 0; n < 2; ++n) _Pragma("unroll") for (int k = 0; k < 2; ++k) dst[n][k] = *(const PG8_LAS bf16x8*)(lds + PG8_SB(b, h) + boff + n * 2048 + k * 1024); } while (0)
#define PG8_MMA(ai, bj, At, Bt) do { __builtin_amdgcn_s_setprio(1); _Pragma("unroll") for (int m = 0; m < 4; ++m) _Pragma("unroll") for (int n = 0; n < 2; ++n) _Pragma("unroll") for (int k = 0; k < 2; ++k) \
        acc[ai][bj][m][n] = __builtin_amdgcn_mfma_f32_16x16x32_bf16(Bt[n][k], At[m][k], acc[ai][bj][m][n], 0, 0, 0); __builtin_amdgcn_s_setprio(0); } while (0)
#define PG8_WAIT_V(n) asm volatile("s_waitcnt vmcnt(" #n ")" ::: "memory")
#define PG8_WAIT_L(n) asm volatile("s_waitcnt lgkmcnt(" #n ")" ::: "memory")
#define PG8_BAR __builtin_amdgcn_s_barrier()
#define PG8_SCHED __builtin_amdgcn_sched_barrier(0)
    Unit cur, nxt; int ui = 0;
    if (!S.next(0, cur)) return;
    f32x4 acc[2][2][4][2];
#pragma unroll
    for (int a = 0; a < 2; ++a)
#pragma unroll
        for (int b = 0; b < 2; ++b)
#pragma unroll
            for (int m = 0; m < 4; ++m)
#pragma unroll
                for (int n = 0; n < 2; ++n) acc[a][b][m][n] = (f32x4){0.f, 0.f, 0.f, 0.f};
    bf16x8 At[4][2], B0[2][2], B1[2][2];
    const char* cA = (const char*)g.A + (size_t)cur.pm * tstep + (size_t)cur.k0 * 2; const char* cB = (const char*)g.Bt + (size_t)cur.pn * tstep + (size_t)cur.k0 * 2; int nt = cur.nt;
    S.a_ready(cur);
    if constexpr (SP2) {
        PG8_STAGE(PG8_SB(0, 0), cB, voffB); PG8_STAGE(PG8_SB(0, 1), cB + hstep, voffB); PG8_STAGE(PG8_SA(0, 0), cA, voffA); PG8_STAGE(PG8_SA(0, 1), cA + hstep, voffA);
        if (wr == 1) PG8_BAR;
        PG8_WAIT_V(2); PG8_BAR;
        PG8_STAGE(PG8_SB(1, 0), cB + kstep, voffB); PG8_STAGE(PG8_SA(1, 0), cA + kstep, voffA); PG8_STAGE(PG8_SB(1, 1), cB + hstep + kstep, voffB);
        PG8_WAIT_V(6); PG8_BAR;
    } else {
        PG8_STAGE(PG8_SB(0, 0), cB, voffB); PG8_STAGE(PG8_SA(0, 0), cA, voffA); PG8_STAGE(PG8_SB(0, 1), cB + hstep, voffB); PG8_STAGE(PG8_SA(0, 1), cA + hstep, voffA);
        if (wr == 1) PG8_BAR;
        PG8_WAIT_V(4); PG8_BAR;
        PG8_STAGE(PG8_SB(1, 0), cB + kstep, voffB); PG8_STAGE(PG8_SA(1, 0), cA + kstep, voffA); PG8_STAGE(PG8_SB(1, 1), cB + hstep + kstep, voffB);
        PG8_WAIT_V(6); PG8_BAR;
    }
    for (;;) {
        const bool has_next = S.next(ui + 1, nxt);
        const char* nA = has_next ? (const char*)g.A + (size_t)nxt.pm * tstep + (size_t)nxt.k0 * 2 : cA; const char* nB = has_next ? (const char*)g.Bt + (size_t)nxt.pn * tstep + (size_t)nxt.k0 * 2 : cB;
        for (int t = 0; t < nt; t += 2) {
            const bool last = (t == nt - 2);
            const char* a1 = cA + (size_t)(t + 1) * kstep;
            const char* a2 = last ? nA : cA + (size_t)(t + 2) * kstep; const char* b2 = last ? nB : cB + (size_t)(t + 2) * kstep;
            const char* a3 = a2 + kstep; const char* b3 = b2 + kstep;
            if (last && has_next) S.a_ready(nxt);
            if constexpr (SP2) {
            PG8_LDB(B0, 0, 0); PG8_LDB(B1, 0, 1); PG8_SCHED; PG8_LDA(At, 0, 0); PG8_STAGE(PG8_SA(1, 1), a1 + hstep, voffA);
            PG8_WAIT_V(8); PG8_WAIT_L(0); PG8_BAR; PG8_MMA(0, 0, At, B0); PG8_MMA(0, 1, At, B1); PG8_BAR; PG8_SCHED;
            PG8_LDA(At, 0, 1); PG8_STAGE(PG8_SB(0, 0), b2, voffB); PG8_STAGE(PG8_SB(0, 1), b2 + hstep, voffB); PG8_STAGE(PG8_SA(0, 0), a2, voffA);
            PG8_WAIT_V(8); PG8_WAIT_L(0); PG8_BAR; PG8_MMA(1, 0, At, B0); PG8_MMA(1, 1, At, B1); PG8_BAR; PG8_SCHED;
            PG8_LDB(B0, 1, 0); PG8_LDB(B1, 1, 1); PG8_SCHED; PG8_LDA(At, 1, 0); PG8_STAGE(PG8_SA(0, 1), a2 + hstep, voffA);
            PG8_WAIT_V(8); PG8_WAIT_L(0); PG8_BAR; PG8_MMA(0, 0, At, B0); PG8_MMA(0, 1, At, B1); PG8_BAR; PG8_SCHED;
            PG8_LDA(At, 1, 1); PG8_STAGE(PG8_SB(1, 0), b3, voffB); PG8_STAGE(PG8_SB(1, 1), b3 + hstep, voffB); PG8_STAGE(PG8_SA(1, 0), a3, voffA);
            PG8_WAIT_V(8); PG8_WAIT_L(0); PG8_BAR; PG8_MMA(1, 0, At, B0); PG8_MMA(1, 1, At, B1); PG8_BAR; PG8_SCHED;
            } else {
            PG8_LDB(B0, 0, 0); PG8_SCHED; PG8_LDA(At, 0, 0); PG8_STAGE(PG8_SA(1, 1), a1 + hstep, voffA);
            PG8_WAIT_L(8); PG8_BAR; PG8_WAIT_L(0); PG8_MMA(0, 0, At, B0); PG8_BAR; PG8_SCHED;
            PG8_LDB(B1, 0, 1); PG8_STAGE(PG8_SB(0, 0), b2, voffB);
            PG8_BAR; PG8_WAIT_L(0); PG8_MMA(0, 1, At, B1); PG8_BAR;
            PG8_LDA(At, 0, 1); PG8_STAGE(PG8_SA(0, 0), a2, voffA);
            PG8_BAR; PG8_WAIT_L(0); PG8_MMA(1, 0, At, B0); PG8_BAR; PG8_SCHED;
            PG8_STAGE(PG8_SB(0, 1), b2 + hstep, voffB);
            PG8_WAIT_V(6); PG8_BAR; PG8_MMA(1, 1, At, B1); PG8_BAR;
            PG8_LDB(B0, 1, 0); PG8_SCHED; PG8_LDA(At, 1, 0); PG8_STAGE(PG8_SA(0, 1), a2 + hstep, voffA);
            PG8_WAIT_L(8); PG8_BAR; PG8_WAIT_L(0); PG8_MMA(0, 0, At, B0); PG8_BAR; PG8_SCHED;
            PG8_LDB(B1, 1, 1); PG8_STAGE(PG8_SB(1, 0), b3, voffB);
            PG8_BAR; PG8_WAIT_L(0); PG8_MMA(0, 1, At, B1); PG8_BAR;
            PG8_LDA(At, 1, 1); PG8_STAGE(PG8_SA(1, 0), a3, voffA);
            PG8_BAR; PG8_WAIT_L(0); PG8_MMA(1, 0, At, B0); PG8_BAR; PG8_SCHED;
            PG8_STAGE(PG8_SB(1, 1), b3 + hstep, voffB);
            PG8_WAIT_V(6); PG8_BAR; PG8_MMA(1, 1, At, B1); PG8_BAR;
            }
        }
        if constexpr (ALIGN_EPI) { if (wr == 0) PG8_BAR; }
        if constexpr (!Epi::AFTER_DRAIN) { E(acc, cur, wr, wc, fr, fq); S.done(cur); }
        if (!has_next) break;
#pragma unroll
        for (int a = 0; a < 2; ++a)
#pragma unroll
            for (int b = 0; b < 2; ++b)
#pragma unroll
                for (int m = 0; m < 4; ++m)
#pragma unroll
                    for (int n = 0; n < 2; ++n) acc[a][b][m][n] = (f32x4){0.f, 0.f, 0.f, 0.f};
        cur = nxt; cA = nA; cB = nB; nt = cur.nt; ++ui;
        if constexpr (ALIGN_EPI) { if (wr == 1) PG8_BAR; }
    }
    PG8_WAIT_V(0);
    if constexpr (!ALIGN_EPI) { if (wr == 0) PG8_BAR; }
    PG8_BAR;
    if constexpr (Epi::AFTER_DRAIN) { E.fused(acc, cur, wr, wc, fr, fq, lds, wid, lane); S.done(cur); }
#undef PG8_SA
#undef PG8_SB
#undef PG8_STAGE
#undef PG8_LDA
#undef PG8_LDB
#undef PG8_MMA
#undef PG8_WAIT_V
#undef PG8_WAIT_L
#undef PG8_BAR
#undef PG8_SCHED
}
}
constexpr size_t MiB = 1u << 20;
constexpr size_t WS_WAIN = 0, WS_WAOUT = 16 * MiB, WS_WBIN = 24 * MiB, WS_WBOUT = 72 * MiB, WS_WFIN = 88 * MiB, WS_WFOUT = 176 * MiB;
constexpr size_t WS_XB = 220 * MiB;
constexpr size_t WS_STAT = 256 * MiB;
constexpr size_t WS_ROPE = 259 * MiB;
constexpr size_t WS_YP = 262 * MiB;
constexpr size_t WS_XF = 390 * MiB;
constexpr size_t WS_R1 = 462 * MiB;
constexpr size_t WS_CTL = 678 * MiB, CTL_BYTES = 16384;
constexpr size_t WS_END = 679 * MiB;
constexpr int MISC_OFF = 131072 + 320;
constexpr int LDS_BYTES = 147456;
constexpr int NW = 8;

#define LAS __attribute__((address_space(3)))
typedef unsigned short bf16;
typedef unsigned u32x4 __attribute__((ext_vector_type(4)));
typedef unsigned u32x2 __attribute__((ext_vector_type(2)));
typedef float f32x4 __attribute__((ext_vector_type(4)));
typedef float f32x2 __attribute__((ext_vector_type(2)));
typedef short bf16x8 __attribute__((ext_vector_type(8)));
typedef short s16x4 __attribute__((ext_vector_type(4)));
#define LDS_WAIT() asm volatile("s_waitcnt lgkmcnt(0)" ::: "memory")
__device__ __forceinline__ unsigned pk2(float lo, float hi) { return pg8::cvt_pk_bf16(lo, hi); }
__device__ __forceinline__ float bf_lo(unsigned w) { return __uint_as_float(w << 16); }
__device__ __forceinline__ float bf_hi(unsigned w) { return __uint_as_float(w & 0xffff0000u); }
__device__ __forceinline__ float wave_sum(float v) {
#pragma unroll
    for (int o = 1; o < 64; o <<= 1) v += __shfl_xor(v, o);
    return v;
}

struct Args { const float* in[17]; float* out; unsigned char* ws; };

template <int MAPMODE>
__device__ __forceinline__ void p0_transpose_item(const float* W, int K, int N, bf16* WT, LAS float* scr, int item, int lane) {
    const int nblk = N / 32, kb = item / nblk, nb = item % nblk, k0 = 64 * kb, n0 = 32 * nb;
#pragma unroll 8
    for (int i = 0; i < 32; ++i) { const int kk = 2 * i + (lane >> 5); scr[kk * 33 + (lane & 31)] = W[(size_t)(k0 + kk) * N + n0 + (lane & 31)]; }
    LDS_WAIT(); asm volatile("" ::: "memory");
    int r0 = n0;
    if (MAPMODE == 1) { const int up = n0 >= FF ? 1 : 0, c = n0 - up * FF; r0 = 256 * (c >> 7) + (c & 127) + 128 * up; }
    const int c8 = lane & 7;
#pragma unroll
    for (int j = 0; j < 4; ++j) { const int n = (lane >> 3) + 8 * j; const LAS float* s = scr + (8 * c8) * 33 + n;
        u32x4 o; o.x = pk2(s[0 * 33], s[1 * 33]); o.y = pk2(s[2 * 33], s[3 * 33]); o.z = pk2(s[4 * 33], s[5 * 33]); o.w = pk2(s[6 * 33], s[7 * 33]);
        *(u32x4*)(WT + (size_t)(r0 + n) * K + k0 + 8 * c8) = o; }
    LDS_WAIT(); asm volatile("" ::: "memory");
}
__device__ __forceinline__ void p0_prologue(const Args& a, LAS unsigned char* lds, int gw, int NGW, int wave, int lane) {
    LAS float* scr = (LAS float*)(lds + wave * 16384);
    unsigned char* ws = a.ws;
    constexpr int I0 = 32 * 128, I1 = 32 * 64, I2 = 32 * 384, I3 = 64 * 64, I4 = 32 * 352, I5 = 88 * 64;
    constexpr int NITEMS = I0 + I1 + I2 + I3 + 2 * I4 + 2 * I5;
    for (int it = gw; it < NITEMS; it += NGW) {
        int r = it;
        if (r < I0) { p0_transpose_item<0>(a.in[3], 2048, 4096, (bf16*)(ws + WS_WAIN), scr, r, lane); continue; } r -= I0;
        if (r < I1) { p0_transpose_item<0>(a.in[8], 2048, 2048, (bf16*)(ws + WS_WAOUT), scr, r, lane); continue; } r -= I1;
        if (r < I2) { p0_transpose_item<0>(a.in[9], 2048, 12288, (bf16*)(ws + WS_WBIN), scr, r, lane); continue; } r -= I2;
        if (r < I3) { p0_transpose_item<0>(a.in[10], 4096, 2048, (bf16*)(ws + WS_WBOUT), scr, r, lane); continue; } r -= I3;
        if (r < 2 * I4) { const int l = r >= I4; r -= l * I4; p0_transpose_item<1>(a.in[11] + (size_t)l * 2048 * 11264, 2048, 11264, (bf16*)(ws + WS_WFIN + l * 44 * MiB), scr, r, lane); continue; } r -= 2 * I4;
        { const int l = r >= I5; r -= l * I5; p0_transpose_item<0>(a.in[12] + (size_t)l * 5632 * 2048, 5632, 2048, (bf16*)(ws + WS_WFOUT + l * 22 * MiB), scr, r, lane); }
    }
    bf16* XB = (bf16*)(ws + WS_XB);
    for (int m = gw; m < MT; m += NGW) {
        const f32x4* xr = (const f32x4*)(m < MP ? a.in[0] + (size_t)m * DM : a.in[1] + (size_t)(m - MP) * DM) + lane;
        u32x2* o = (u32x2*)(XB + (size_t)m * DM) + lane;
#pragma unroll
        for (int j = 0; j < 8; ++j) { const f32x4 v = xr[64 * j]; u32x2 w; w.x = pk2(v[0], v[1]); w.y = pk2(v[2], v[3]); o[64 * j] = w; }
    }
    float* rc = (float*)(ws + WS_ROPE); float* rs = rc + 2080 * 128;
    for (int e = gw * 64 + lane; e < 2080 * 128; e += NGW * 64) {
        const int p = e >> 7, d = e & 127; const float pos = (float)(p < 2048 ? p : 4096 + (p - 2048));
        const float inv = __builtin_amdgcn_exp2f(-(float)d * (13.287712379549449f / 128.0f));
        const double rev = (double)(pos * inv) * 0.15915494309189535; const float fr = (float)(rev - __builtin_floor(rev));
        rc[e] = __builtin_amdgcn_cosf(fr); rs[e] = __builtin_amdgcn_sinf(fr);
    }
}

__device__ __forceinline__ void ln_pass(const float* xres_p, const float* xres_s, const float* YP, const float* g, const float* b, float* outf, bf16* outb, int gw, int NGW, int lane) {
    for (int row = gw; row < MT; row += NGW) {
        const f32x4* xr = (const f32x4*)(row < MP ? xres_p + (size_t)row * DM : xres_s + (size_t)(row - MP) * DM) + lane;
        f32x4 v[8];
#pragma unroll
        for (int j = 0; j < 8; ++j) v[j] = xr[64 * j] * ALPHA;
        if (row < MP) { const f32x4* y = (const f32x4*)(YP + (size_t)row * DM) + lane;
#pragma unroll
            for (int j = 0; j < 8; ++j) v[j] += y[64 * j];
        } else {
            for (int ks = 0; ks < 8; ++ks) { const f32x4* y = (const f32x4*)(YP + (size_t)(MP + ks * MS + (row - MP)) * DM) + lane;
#pragma unroll
                for (int j = 0; j < 8; ++j) v[j] += y[64 * j]; }
        }
        float s = 0.f;
#pragma unroll
        for (int j = 0; j < 8; ++j) s += (v[j][0] + v[j][1]) + (v[j][2] + v[j][3]);
        const float mean = wave_sum(s) * (1.f / DM); float q = 0.f;
#pragma unroll
        for (int j = 0; j < 8; ++j) { v[j] = v[j] - mean; q += (v[j][0] * v[j][0] + v[j][1] * v[j][1]) + (v[j][2] * v[j][2] + v[j][3] * v[j][3]); }
        const float rstd = 1.0f / sqrtf(wave_sum(q) * (1.f / DM) + LN_EPS);
        f32x4* of = (f32x4*)(outf + (size_t)row * DM) + lane;
#pragma unroll
        for (int j = 0; j < 8; ++j) { const f32x4 gg = ((const f32x4*)g)[lane + 64 * j], bb = ((const f32x4*)b)[lane + 64 * j]; const f32x4 o = v[j] * rstd * gg + bb; of[64 * j] = o;
            if (outb) { u32x2 w; w.x = pk2(o[0], o[1]); w.y = pk2(o[2], o[3]); ((u32x2*)(outb + (size_t)row * DM) + lane)[64 * j] = w; } }
    }
}

__device__ __forceinline__ bf16x8 frag_plain(const LAS bf16* X, int ld, int r0, int k0, int lane) { return *(const LAS bf16x8*)(X + (r0 + (lane & 15)) * ld + k0 + 8 * (lane >> 4)); }
typedef short v4i16_t __attribute__((ext_vector_type(4)));
__device__ __forceinline__ bf16x8 frag_tr(const LAS bf16* Y, int ld, int kr0, int c0, int lane) {
    const int i = lane & 15, g4 = lane >> 4; const LAS bf16* p = Y + (kr0 + 8 * g4 + (i >> 2)) * ld + c0 + 4 * (i & 3);
    const v4i16_t lo = __builtin_amdgcn_ds_read_tr16_b64_v4i16((LAS v4i16_t*)p), hi = __builtin_amdgcn_ds_read_tr16_b64_v4i16((LAS v4i16_t*)(p + 4 * ld));
    return (bf16x8){lo[0], lo[1], lo[2], lo[3], hi[0], hi[1], hi[2], hi[3]};
}
#define MFMA16(a, b, c) __builtin_amdgcn_mfma_f32_16x16x32_bf16((a), (b), (c), 0, 0, 0)

__device__ __forceinline__ void mix_phase(const Args& a, LAS unsigned char* lds, int wave, int lane) {
    const int tid = threadIdx.x;
    LAS bf16* Wm = (LAS bf16*)lds;
    LAS bf16* vn = (LAS bf16*)(lds + 34816);
    LAS f32x2* mr = (LAS f32x2*)(lds + 34816 + 67584);
    const bf16* U = (const bf16*)(a.ws + WS_R1); const bf16* V = U + (size_t)MT * DM; bf16* SB = (bf16*)(a.ws + WS_R1 + 72 * MiB);
    const f32x2* stat = (const f32x2*)(a.ws + WS_STAT);
    const float* lng = a.in[4]; const float* lnb = a.in[5]; const float* aws = a.in[6]; const float* abs_ = a.in[7];
    float* gv = a.out + (size_t)MT * DM + (size_t)(4 + 32) * 8 * 256 * 512;
    for (int item = blockIdx.x; item < 72 * 8; item += gridDim.x) {
        const int rb = item >> 3, g = item & 7, row0 = rb * 128; const bool smp = rb >= 64;
        if (tid < 128) { const f32x2* sp = stat + (size_t)(row0 + tid) * 32; float s = 0.f, q = 0.f;
#pragma unroll 8
            for (int k = 0; k < 32; ++k) { const f32x2 v = sp[k]; s += v.x; q += v.y; }
            const float mean = s * (1.f / 2048.f), var = q * (1.f / 2048.f) - mean * mean; mr[tid] = (f32x2){mean, 1.0f / sqrtf(var + LN_EPS)}; }
        { const int t = tid >> 2, s0 = (tid & 3) * 32; const int tw = smp ? (t & 31) : t;
#pragma unroll
            for (int k = 0; k < 4; ++k) { const int s = s0 + 8 * k; const int sw = smp ? (s & 31) : s;
                const f32x4 w0 = *(const f32x4*)(aws + ((size_t)g * 128 + tw) * 128 + sw), w1 = *(const f32x4*)(aws + ((size_t)g * 128 + tw) * 128 + sw + 4);
                float w[8] = {w0[0], w0[1], w0[2], w0[3], w1[0], w1[1], w1[2], w1[3]};
#pragma unroll
                for (int e = 0; e < 8; ++e) { const int ss = s + e; const bool ok = smp ? ((ss >> 5) == (t >> 5) && (ss & 31) <= (t & 31)) : (ss <= t); w[e] = ok ? w[e] : 0.f; }
                u32x4 o; o.x = pk2(w[0], w[1]); o.y = pk2(w[2], w[3]); o.z = pk2(w[4], w[5]); o.w = pk2(w[6], w[7]);
                *(LAS u32x4*)(Wm + t * 136 + s) = o; } }
        __syncthreads();
        { const int s = tid >> 2, cb = (tid & 3) * 64; const f32x2 m = mr[s]; const bf16* vp = V + (size_t)(row0 + s) * DM + g * 256 + cb;
#pragma unroll
            for (int k = 0; k < 8; ++k) { const u32x4 w = *(const u32x4*)(vp + 8 * k); const int c = g * 256 + cb + 8 * k;
                const f32x4 g0 = *(const f32x4*)(lng + c), g1 = *(const f32x4*)(lng + c + 4), b0 = *(const f32x4*)(lnb + c), b1 = *(const f32x4*)(lnb + c + 4);
                f32x4 x0 = (f32x4){bf_lo(w.x), bf_hi(w.x), bf_lo(w.y), bf_hi(w.y)}, x1 = (f32x4){bf_lo(w.z), bf_hi(w.z), bf_lo(w.w), bf_hi(w.w)};
                x0 = (x0 - m.x) * m.y * g0 + b0; x1 = (x1 - m.x) * m.y * g1 + b1;
                u32x4 o; o.x = pk2(x0[0], x0[1]); o.y = pk2(x0[2], x0[3]); o.z = pk2(x1[0], x1[1]); o.w = pk2(x1[2], x1[3]);
                *(LAS u32x4*)(vn + s * 264 + cb + 8 * k) = o;
                if (smp) { float* op = gv + (size_t)(row0 + s - MP) * DM + c; *(f32x4*)op = x0; *(f32x4*)(op + 4) = x1; } } }
        __syncthreads();
        {
            const int t0 = 16 * wave, i = lane & 15, g4 = lane >> 4; f32x4 acc[16];
#pragma unroll
            for (int ct = 0; ct < 16; ++ct) acc[ct] = (f32x4){0.f, 0.f, 0.f, 0.f};
            const int kmax = (t0 + 15) >> 5;
            for (int kk = 0; kk <= kmax; ++kk) { const bf16x8 bw = frag_plain(Wm, 136, t0, 32 * kk, lane);
#pragma unroll
                for (int ct = 0; ct < 16; ++ct) { const bf16x8 av = frag_tr(vn, 264, 32 * kk, 16 * ct, lane); acc[ct] = MFMA16(av, bw, acc[ct]); } }
            const int t = t0 + i, row = row0 + t; const float bias = abs_[g * 128 + (smp ? (t & 31) : t)];
#pragma unroll
            for (int ct = 0; ct < 16; ++ct) { const size_t off = (size_t)row * DM + g * 256 + 16 * ct + 4 * g4; const u32x2 uu = *(const u32x2*)(U + off);
                u32x2 o; o.x = pk2(bf_lo(uu.x) * (acc[ct][0] + bias), bf_hi(uu.x) * (acc[ct][1] + bias)); o.y = pk2(bf_lo(uu.y) * (acc[ct][2] + bias), bf_hi(uu.y) * (acc[ct][3] + bias));
                *(u32x2*)(SB + off) = o; }
        }
        __syncthreads();
    }
}
constexpr int R_QS = 0, R_KS = 33792, R_VS = 67584, R_PS = 76800, R_RT = 86016, R_OS = 119808;
template <int L>
__device__ __forceinline__ void ret_run(LAS unsigned char* lds, const bf16* QH, const bf16* KH, const bf16* VB, bf16* OB, int grow0, int nblk, int h, int slice, const float* S0, float* Sout, int wave, int lane) {
    const int tid = threadIdx.x, i = lane & 15, g4 = lane >> 4;
    LAS bf16* qs = (LAS bf16*)(lds + R_QS); LAS bf16* ks = (LAS bf16*)(lds + R_KS); LAS bf16* vs = (LAS bf16*)(lds + R_VS);
    LAS bf16* ps = (LAS bf16*)(lds + R_PS); LAS bf16* rts = (LAS bf16*)(lds + R_RT); LAS bf16* os = (LAS bf16*)(lds + R_OS);
    const float lg = pg8::lg2gamma(h);
    const float gL = __builtin_amdgcn_exp2f(lg * (float)L), gLm1 = __builtin_amdgcn_exp2f(lg * (float)(L - 1)), gLm1i = __builtin_amdgcn_exp2f(-lg * (float)(L - 1));
    constexpr int NQ = L / 16, NT = L / 32, NKK = L / 32;
    const bool vthr = (L == 64) || tid < 256;
    u32x4 pq[NQ], pk[NQ], pv;
#define RET_GLOAD(blk) do { const int r0_ = grow0 + (blk) * L; _Pragma("unroll") for (int k_ = 0; k_ < NQ; ++k_) { const int e_ = tid + 512 * k_, row_ = e_ >> 5, ch_ = e_ & 31; \
        pq[k_] = *(const u32x4*)(QH + (size_t)(r0_ + row_) * 2048 + h * 256 + ch_ * 8); pk[k_] = *(const u32x4*)(KH + (size_t)(r0_ + row_) * 2048 + h * 256 + ch_ * 8); } \
        if (vthr) pv = *(const u32x4*)(VB + (size_t)(r0_ + (tid >> 3)) * 4096 + h * 512 + slice * 64 + (tid & 7) * 8); } while (0)
#define RET_LSTORE() do { _Pragma("unroll") for (int k_ = 0; k_ < NQ; ++k_) { const int e_ = tid + 512 * k_, row_ = e_ >> 5, ch_ = e_ & 31; \
        *(LAS u32x4*)(qs + row_ * 264 + ch_ * 8) = pq[k_]; *(LAS u32x4*)(ks + row_ * 264 + ch_ * 8) = pk[k_]; } \
        if (vthr) *(LAS u32x4*)(vs + (tid >> 3) * 72 + (tid & 7) * 8) = pv; } while (0)
    f32x4 R[2][4];
    RET_GLOAD(0);
#pragma unroll
    for (int a2 = 0; a2 < 2; ++a2)
#pragma unroll
        for (int d = 0; d < 4; ++d) {
            if (S0) {
#pragma unroll
                for (int e = 0; e < 4; ++e) R[a2][d][e] = S0[(size_t)(32 * wave + 16 * a2 + 4 * g4 + e) * 512 + slice * 64 + 16 * d + i] * gLm1i;
            } else R[a2][d] = (f32x4){0.f, 0.f, 0.f, 0.f};
            u32x2 w; w.x = pk2(R[a2][d][0], R[a2][d][1]); w.y = pk2(R[a2][d][2], R[a2][d][3]);
            *(LAS u32x2*)(rts + (16 * d + i) * 264 + 32 * wave + 16 * a2 + 4 * g4) = w; }
    RET_LSTORE();
    __syncthreads();
    const int it = (L == 64) ? (wave >> 1) : (wave >> 2);
    for (int n = 0; n < nblk; ++n) {
        if (n + 1 < nblk) RET_GLOAD(n + 1);
        if (L == 64 || wave < 4) {
#pragma unroll
            for (int tp = 0; tp < NT; ++tp) { const int i0 = 16 * (wave >> 1), j0 = (L == 64) ? 16 * (2 * (wave & 1) + tp) : 16 * (wave & 1);
                f32x4 acc = (f32x4){0.f, 0.f, 0.f, 0.f};
#pragma unroll
                for (int kk = 0; kk < 8; ++kk) acc = MFMA16(frag_plain(ks, 264, j0, 32 * kk, lane), frag_plain(qs, 264, i0, 32 * kk, lane), acc);
#pragma unroll
                for (int e = 0; e < 4; ++e) acc[e] = (j0 + 4 * g4 + e <= i0 + i) ? acc[e] : 0.f;
                u32x2 w; w.x = pk2(acc[0], acc[1]); w.y = pk2(acc[2], acc[3]); *(LAS u32x2*)(ps + (i0 + i) * 72 + j0 + 4 * g4) = w; }
        }
        f32x4 oacc[NT];
#pragma unroll
        for (int tp = 0; tp < NT; ++tp) { const int dv0 = (L == 64) ? 16 * (2 * (wave & 1) + tp) : 16 * (wave & 3);
            f32x4 acc = (f32x4){0.f, 0.f, 0.f, 0.f};
#pragma unroll
            for (int kk = 0; kk < 8; ++kk) acc = MFMA16(frag_plain(rts, 264, dv0, 32 * kk, lane), frag_plain(qs, 264, 16 * it, 32 * kk, lane), acc);
            oacc[tp] = acc * gL; }
        __syncthreads();
#pragma unroll
        for (int tp = 0; tp < NT; ++tp) { const int dv0 = (L == 64) ? 16 * (2 * (wave & 1) + tp) : 16 * (wave & 3);
#pragma unroll
            for (int kk = 0; kk < NKK; ++kk) oacc[tp] = MFMA16(frag_tr(vs, 72, 32 * kk, dv0, lane), frag_plain(ps, 72, 16 * it, 32 * kk, lane), oacc[tp]);
            u32x2 w; w.x = pk2(oacc[tp][0], oacc[tp][1]); w.y = pk2(oacc[tp][2], oacc[tp][3]); *(LAS u32x2*)(os + (16 * it + i) * 72 + dv0 + 4 * g4) = w; }
#pragma unroll
        for (int a2 = 0; a2 < 2; ++a2)
#pragma unroll
            for (int d = 0; d < 4; ++d) R[a2][d] = R[a2][d] * gL;
#pragma unroll
        for (int kk = 0; kk < NKK; ++kk) { bf16x8 bv[4];
#pragma unroll
            for (int d = 0; d < 4; ++d) bv[d] = frag_tr(vs, 72, 32 * kk, 16 * d, lane);
#pragma unroll
            for (int a2 = 0; a2 < 2; ++a2) { const bf16x8 av = frag_tr(ks, 264, 32 * kk, 32 * wave + 16 * a2, lane);
#pragma unroll
                for (int d = 0; d < 4; ++d) R[a2][d] = MFMA16(av, bv[d], R[a2][d]); } }
        __syncthreads();
#pragma unroll
        for (int a2 = 0; a2 < 2; ++a2)
#pragma unroll
            for (int d = 0; d < 4; ++d) { u32x2 w; w.x = pk2(R[a2][d][0], R[a2][d][1]); w.y = pk2(R[a2][d][2], R[a2][d][3]);
                *(LAS u32x2*)(rts + (16 * d + i) * 264 + 32 * wave + 16 * a2 + 4 * g4) = w; }
        if (vthr) *(u32x4*)(OB + (size_t)(grow0 + n * L + (tid >> 3)) * 4096 + h * 512 + slice * 64 + (tid & 7) * 8) = *(const LAS u32x4*)(os + (tid >> 3) * 72 + (tid & 7) * 8);
        if (n + 1 < nblk) RET_LSTORE();
        __syncthreads();
    }
#pragma unroll
    for (int a2 = 0; a2 < 2; ++a2)
#pragma unroll
        for (int d = 0; d < 4; ++d)
#pragma unroll
            for (int e = 0; e < 4; ++e) Sout[(size_t)(32 * wave + 16 * a2 + 4 * g4 + e) * 512 + slice * 64 + 16 * d + i] = R[a2][d][e] * gLm1;
#undef RET_GLOAD
#undef RET_LSTORE
}
__device__ __forceinline__ void ret_phase(const Args& a, LAS unsigned char* lds, int wave, int lane) {
    const bf16* QH = (const bf16*)(a.ws + WS_R1); const bf16* KH = QH + (size_t)MT * DM; const bf16* VB = (const bf16*)(a.ws + WS_R1 + 72 * MiB); bf16* OB = (bf16*)(a.ws + WS_YP);
    float* sp = a.out + (size_t)MT * DM; float* ss = sp + (size_t)4 * 8 * 256 * 512;
    for (int item = blockIdx.x; item < 256; item += gridDim.x) {
        const int x = item & 7, j = item >> 3, bh = x * 4 + (j >> 3), slice = j & 7, b = bh >> 3, h = bh & 7;
        ret_run<64>(lds, QH, KH, VB, OB, b * 2048, 32, h, slice, nullptr, sp + (size_t)bh * 256 * 512, wave, lane);
    }
    for (int pair = blockIdx.x; pair < 256; pair += gridDim.x) {
        const int b = pair >> 3, h = pair & 7;
        for (int slice = 0; slice < 8; ++slice)
            ret_run<32>(lds, QH, KH, VB, OB, MP + b * 32, 1, h, slice, a.in[2] + (size_t)pair * 256 * 512, ss + (size_t)pair * 256 * 512, wave, lane);
    }
}
__device__ __forceinline__ void gn_gate(const Args& a, int gw, int NGW, int lane) {
    const bf16* O = (const bf16*)(a.ws + WS_YP); bf16* GS = (bf16*)(a.ws + WS_R1 + 144 * MiB);
    for (int p = gw; p < MT * 8; p += NGW) {
        const size_t off = (size_t)(p >> 3) * 4096 + (p & 7) * 512 + 8 * lane;
        const u32x4 ow = *(const u32x4*)(O + off), gwv = *(const u32x4*)(GS + off);
        float o[8] = {bf_lo(ow.x), bf_hi(ow.x), bf_lo(ow.y), bf_hi(ow.y), bf_lo(ow.z), bf_hi(ow.z), bf_lo(ow.w), bf_hi(ow.w)};
        const float g[8] = {bf_lo(gwv.x), bf_hi(gwv.x), bf_lo(gwv.y), bf_hi(gwv.y), bf_lo(gwv.z), bf_hi(gwv.z), bf_lo(gwv.w), bf_hi(gwv.w)};
        float s = 0.f;
#pragma unroll
        for (int e = 0; e < 8; ++e) s += o[e];
        const float mean = wave_sum(s) * (1.f / 512.f); float q = 0.f;
#pragma unroll
        for (int e = 0; e < 8; ++e) { o[e] -= mean; q += o[e] * o[e]; }
        const float rstd = 1.0f / sqrtf(wave_sum(q) * (1.f / 512.f) + GN_EPS);
        u32x4 w; w.x = pk2(g[0] * o[0] * rstd, g[1] * o[1] * rstd); w.y = pk2(g[2] * o[2] * rstd, g[3] * o[3] * rstd); w.z = pk2(g[4] * o[4] * rstd, g[5] * o[5] * rstd); w.w = pk2(g[6] * o[6] * rstd, g[7] * o[7] * rstd);
        *(u32x4*)(GS + off) = w;
    }
}


#ifndef DBG_STOP
#define DBG_STOP 0
#endif
__device__ __forceinline__ void dbg_dump(const Args& a, const bf16* src, size_t n_el) {
    const size_t T = (size_t)gridDim.x * 512, t = (size_t)blockIdx.x * 512 + threadIdx.x, total = 58720256;
    for (size_t i = t; i < total; i += T) { float v = 0.f; if (i < n_el / 2) { const unsigned w = ((const unsigned*)src)[i]; v = bf_lo(w) + bf_hi(w); } a.out[i] = v; }
}
__device__ __forceinline__ void dbg_dump_f32(const Args& a, const float* src, size_t n_el) {
    const size_t T = (size_t)gridDim.x * 512, t = (size_t)blockIdx.x * 512 + threadIdx.x, total = 58720256;
    for (size_t i = t; i < total; i += T) a.out[i] = i < n_el ? src[i] : 0.f;
}
#define XB_TMO      128
#define XB_XCNT(j)  (256  + 64 * (j))
#define XB_XSUB(j)  (1280 + 64 * (j))
#define XB_XGEN(j)  (2304 + 64 * (j))
#define XB_TOP      3328
#define XB_TOPGEN   3392
#define XCD_BAR_WORDS 3456
#define XB_SPIN_CAP (1u << 18)

__device__ __forceinline__ unsigned xb_ld(unsigned* p)              { return __hip_atomic_load(p, __ATOMIC_RELAXED, __HIP_MEMORY_SCOPE_AGENT); }
__device__ __forceinline__ unsigned xb_add(unsigned* p, unsigned v) { return __hip_atomic_fetch_add(p, v, __ATOMIC_RELAXED, __HIP_MEMORY_SCOPE_AGENT); }
__device__ __forceinline__ unsigned xb_xcc_id() { return (unsigned)__builtin_amdgcn_s_getreg((3 << 11) | 20) & 0xFu; }
#define XB_SPIN(cond, bar) do { unsigned _sp = 0; while (cond) { __builtin_amdgcn_s_sleep(1); \
    if ((++_sp & 255u) == 0u) { if (xb_ld(&(bar)[XB_TMO])) break; if (_sp > XB_SPIN_CAP) { atomicAdd(&(bar)[XB_TMO], 1u); break; } } } } while (0)

struct XcdBarrier {
    unsigned* bar; unsigned x;
    volatile LAS unsigned* st;
};

__device__ __forceinline__ XcdBarrier xcd_barrier_post(unsigned* bar, volatile LAS unsigned* st) {
    XcdBarrier b; b.bar = bar; b.x = xb_xcc_id(); b.st = st;
    if (threadIdx.x == 0) (void)xb_add(&bar[XB_XCNT(b.x)], 1u);
    return b;
}
__device__ __forceinline__ void xcd_barrier_complete(unsigned* bar, unsigned x, unsigned& nloc, unsigned& nx) {
    const unsigned G = gridDim.x * gridDim.y * gridDim.z;
    unsigned sum, cnt, mine, sp = 0u;
    for (;;) {
        sum = 0u; cnt = 0u; mine = 0u;
#pragma unroll
        for (unsigned j = 0; j < 16; ++j) { const unsigned c = xb_ld(&bar[XB_XCNT(j)]); sum += c; cnt += (c > 0u) ? 1u : 0u; mine = (j == x) ? c : mine; }
        if (sum == G) break;
        __builtin_amdgcn_s_sleep(1);
        if ((++sp & 255u) == 0u) { if (xb_ld(&bar[XB_TMO])) break; if (sp > XB_SPIN_CAP) { atomicAdd(&bar[XB_TMO], 1u); break; } }
    }
    nloc = mine > 0u ? mine : 1u; nx = cnt > 0u ? cnt : 1u;
}

__device__ __forceinline__ void xcd_barrier(const XcdBarrier& b) {
    asm volatile("s_waitcnt vmcnt(0)" ::: "memory");
    __syncthreads();
    if (threadIdx.x == 0) {
        unsigned* bar = b.bar;
        __builtin_amdgcn_s_waitcnt(0);
        unsigned nloc = b.st[0], nx = b.st[1];
        if (nloc == 0u) { xcd_barrier_complete(bar, b.x, nloc, nx); b.st[0] = nloc; b.st[1] = nx; }
        const unsigned old = xb_add(&bar[XB_XSUB(b.x)], 1u);
        const unsigned gen = old / nloc;
        if (old + 1u == (gen + 1u) * nloc) {
            __builtin_amdgcn_fence(__ATOMIC_RELEASE, "agent");
            asm volatile("s_waitcnt vmcnt(0)" ::: "memory");
            const unsigned og = xb_add(&bar[XB_TOP], 1u);
            const unsigned tg = og / nx;
            if (og + 1u == (tg + 1u) * nx) xb_add(&bar[XB_TOPGEN], 1u);
            else XB_SPIN(xb_ld(&bar[XB_TOPGEN]) == tg, bar);
            __builtin_amdgcn_fence(__ATOMIC_ACQUIRE, "agent");
            xb_add(&bar[XB_XGEN(b.x)], 1u);
            asm volatile("s_waitcnt vmcnt(0)" ::: "memory");
        } else {
            XB_SPIN(xb_ld(&bar[XB_XGEN(b.x)]) == gen, bar);
            __builtin_amdgcn_fence(__ATOMIC_ACQUIRE, "agent");
            asm volatile("s_waitcnt vmcnt(0)" ::: "memory");
        }
    }
    __syncthreads();
}

__global__ void __launch_bounds__(512, 2) fwd(Args a) {
    extern __shared__ __attribute__((aligned(16))) unsigned char lds_raw[];
    cg::grid_group grid = cg::this_grid();
    LAS unsigned char* lds = (LAS unsigned char*)lds_raw;
    const int tid = threadIdx.x, lane = tid & 63, wave = __builtin_amdgcn_readfirstlane(tid >> 6);
    const int G = gridDim.x, c = blockIdx.x, vcu = (G % 8 == 0) ? (c % 8) * (G / 8) + c / 8 : c, gw = vcu * NW + wave, NGW = G * NW;
    unsigned char* ws = a.ws;
    { volatile LAS unsigned* misc = (volatile LAS unsigned*)(lds + MISC_OFF); if (tid < 32) misc[tid] = 0u; }
    __syncthreads();
    XcdBarrier bar = xcd_barrier_post((unsigned*)(ws + WS_CTL), (volatile LAS unsigned*)(lds + MISC_OFF) + 8);
    bf16* XB = (bf16*)(ws + WS_XB); float* YP = (float*)(ws + WS_YP); float* XF = (float*)(ws + WS_XF);
    bf16* R1 = (bf16*)(ws + WS_R1);
#define GEMM(EPI, E, Ap, Bp, LD, M1, N, K, SPLIT) do { pg8::Gemm g_{(const pg8::bf16_t*)(Ap), (const pg8::bf16_t*)(Bp), (LD)}; pg8::Order S_; S_.init((M1), (N), (K), (SPLIT), G, c); \
        pg8::gemm_phase<EPI, pg8::Order, true, true>(lds, g_, S_, E); } while (0)

#define GRID_SYNC() do { asm volatile("s_waitcnt vmcnt(0) lgkmcnt(0)" ::: "memory"); grid.sync(); } while (0)
#define XCD_SYNC() xcd_barrier(bar)

#define DBG_DUMP_1 dbg_dump(a, XB, (size_t)MT * DM)
#define DBG_DUMP_2 dbg_dump(a, R1, (size_t)2 * MT * DM)
#define DBG_DUMP_3 dbg_dump(a, R1 + (size_t)2 * MT * DM, (size_t)MT * DM)
#define DBG_DUMP_4 dbg_dump_f32(a, YP, (size_t)2 * MP * DM)
#define DBG_DUMP_5 dbg_dump_f32(a, XF, (size_t)MT * DM)
#define DBG_DUMP_6 dbg_dump(a, R1, (size_t)MT * FF)
#define DBG_DUMP_7 dbg_dump_f32(a, YP, (size_t)2 * MP * DM)
#define DBG_DUMP_8 dbg_dump_f32(a, XF, (size_t)MT * DM)
#define DBG_DUMP_9 dbg_dump(a, R1, (size_t)6 * MT * DM)
#define DBG_DUMP_10 dbg_dump(a, (const bf16*)YP, (size_t)2 * MT * DM)
#define DBG_DUMP_11 dbg_dump(a, R1 + (size_t)4 * MT * DM, (size_t)2 * MT * DM)
#define DBG_DUMP_12 dbg_dump_f32(a, YP, (size_t)2 * MP * DM)
#define DBG_DUMP_13 dbg_dump_f32(a, XF, (size_t)MT * DM)
#define DBG_DUMP_14 dbg_dump(a, R1, (size_t)MT * FF)
#define DBG_DUMP_15 dbg_dump_f32(a, YP, (size_t)2 * MP * DM)
    p0_prologue(a, lds, gw, NGW, wave, lane);
    GRID_SYNC();
    if (DBG_STOP == 1) { DBG_DUMP_1; return; }
    { pg8::EpiGeluUV E{R1, R1 + (size_t)MT * DM, (pg8::f32x2*)(ws + WS_STAT)}; GEMM(pg8::EpiGeluUV, E, XB, ws + WS_WAIN, 2048, MT, 4096, 2048, 0); }
    XCD_SYNC();
    if (DBG_STOP == 2) { DBG_DUMP_2; return; }
    mix_phase(a, lds, wave, lane);
    XCD_SYNC();
    if (DBG_STOP == 3) { DBG_DUMP_3; return; }
    { pg8::EpiPart E{YP}; GEMM(pg8::EpiPart, E, ws + WS_R1 + 72 * MiB, ws + WS_WAOUT, 2048, MP, 2048, 2048, 1); }
    XCD_SYNC();
    if (DBG_STOP == 4) { DBG_DUMP_4; return; }
    ln_pass(a.in[0], a.in[1], YP, a.in[13], a.in[14], XF, XB, gw, NGW, lane);
    XCD_SYNC();
    if (DBG_STOP == 5) { DBG_DUMP_5; return; }
    { pg8::EpiSwiglu E{R1}; GEMM(pg8::EpiSwiglu, E, XB, ws + WS_WFIN, 2048, MT, 11264, 2048, 0); }
    XCD_SYNC();
    if (DBG_STOP == 6) { DBG_DUMP_6; return; }
    { pg8::EpiPart E{YP}; GEMM(pg8::EpiPart, E, R1, ws + WS_WFOUT, 5632, MP, 2048, 5632, 1); }
    XCD_SYNC();
    if (DBG_STOP == 7) { DBG_DUMP_7; return; }
    ln_pass(XF, XF + (size_t)MP * DM, YP, a.in[15], a.in[16], XF, XB, gw, NGW, lane);
    XCD_SYNC();
    if (DBG_STOP == 8) { DBG_DUMP_8; return; }
    { pg8::EpiQKVG E{R1, R1 + (size_t)MT * DM, (pg8::bf16_t*)(ws + WS_R1 + 72 * MiB), (pg8::bf16_t*)(ws + WS_R1 + 144 * MiB), (const float*)(ws + WS_ROPE), (const float*)(ws + WS_ROPE) + 2080 * 128};
      GEMM(pg8::EpiQKVG, E, XB, ws + WS_WBIN, 2048, MT, 12288, 2048, 0); }
    XCD_SYNC();
    if (DBG_STOP == 9) { DBG_DUMP_9; return; }
    ret_phase(a, lds, wave, lane);
    XCD_SYNC();
    if (DBG_STOP == 10) { DBG_DUMP_10; return; }
    gn_gate(a, gw, NGW, lane);
    XCD_SYNC();
    if (DBG_STOP == 11) { DBG_DUMP_11; return; }
    { pg8::EpiPart E{YP}; GEMM(pg8::EpiPart, E, ws + WS_R1 + 144 * MiB, ws + WS_WBOUT, 4096, MP, 2048, 4096, 1); }
    XCD_SYNC();
    if (DBG_STOP == 12) { DBG_DUMP_12; return; }
    ln_pass(XF, XF + (size_t)MP * DM, YP, a.in[13] + DM, a.in[14] + DM, XF, XB, gw, NGW, lane);
    XCD_SYNC();
    if (DBG_STOP == 13) { DBG_DUMP_13; return; }
    { pg8::EpiSwiglu E{R1}; GEMM(pg8::EpiSwiglu, E, XB, ws + WS_WFIN + 44 * MiB, 2048, MT, 11264, 2048, 0); }
    XCD_SYNC();
    if (DBG_STOP == 14) { DBG_DUMP_14; return; }
    { pg8::EpiPart E{YP}; GEMM(pg8::EpiPart, E, R1, ws + WS_WFOUT + 22 * MiB, 5632, MP, 2048, 5632, 1); }
    XCD_SYNC();
    if (DBG_STOP == 15) { DBG_DUMP_15; return; }
    ln_pass(XF, XF + (size_t)MP * DM, YP, a.in[15] + DM, a.in[16] + DM, a.out, nullptr, gw, NGW, lane);
#undef GEMM
}

extern "C" void kernel_launch(void* const* d_in, const int* in_sizes, int n_in, void* d_out, int out_size, void* d_ws, size_t ws_size, hipStream_t stream) {
    static int grid = 0;
    if (grid == 0) {
        if (n_in != 17 || ws_size < WS_END) { fprintf(stderr, "kernel_launch: needs 17 inputs and >= %zu bytes of workspace (got %d, %zu)\n", (size_t)WS_END, n_in, ws_size); grid = -1; return; }
        int dev = 0, cus = 0, per_cu = 0;
        if (hipGetDevice(&dev) != hipSuccess || hipDeviceGetAttribute(&cus, hipDeviceAttributeMultiprocessorCount, dev) != hipSuccess) { grid = -1; return; }
        if (hipFuncSetAttribute((const void*)fwd, hipFuncAttributeMaxDynamicSharedMemorySize, LDS_BYTES) != hipSuccess) { fprintf(stderr, "kernel_launch: hipFuncSetAttribute failed\n"); grid = -1; return; }
        if (hipOccupancyMaxActiveBlocksPerMultiprocessor(&per_cu, (const void*)fwd, NW * 64, LDS_BYTES) != hipSuccess || per_cu < 1) { fprintf(stderr, "kernel_launch: occupancy query reports %d workgroups per CU\n", per_cu); grid = -1; return; }
        grid = cus;
    }
    if (grid < 0) return;
    if (hipMemsetAsync((char*)d_ws + WS_CTL, 0, CTL_BYTES, stream) != hipSuccess) { fprintf(stderr, "kernel_launch: hipMemsetAsync failed\n"); return; }
    Args a{};
    for (int i = 0; i < 17; ++i) a.in[i] = (const float*)d_in[i];
    a.out = (float*)d_out; a.ws = (unsigned char*)d_ws;
    void* args[] = {&a};
    const hipError_t e = hipLaunchCooperativeKernel((const void*)fwd, dim3(grid), dim3(NW * 64), args, LDS_BYTES, stream);
    if (e != hipSuccess) fprintf(stderr, "kernel_launch: cooperative launch failed: %s (grid %d)\n", hipGetErrorString(e), grid);
}
```

```cpp
#ifndef DBL_GEMM
#define DBL_GEMM 0
#endif
#include <hip/hip_runtime.h>
#include <hip/hip_cooperative_groups.h>
#include <cstdio>
#include <cstdint>
namespace cg = cooperative_groups;

constexpr int DM = 2048, MP = 8192, MS = 1024, MT = MP + MS, FF = 5632, NQKVG = 12288, RV = 4096;
constexpr float ALPHA = 1.41421356237309515f;
constexpr float LN_EPS = 1e-5f, GN_EPS = 1e-6f;

namespace pg8 {
#define PG8_LAS __attribute__((address_space(3)))
typedef unsigned short bf16_t;
typedef short bf16x8 __attribute__((ext_vector_type(8)));
typedef float f32x4 __attribute__((ext_vector_type(4)));
typedef unsigned u32x4 __attribute__((ext_vector_type(4)));
constexpr int BM = 256, BK = 64, HALF = 128, HTB = HALF * BK * 2  , STAGE_BYTES = 8 * HTB, NXCD = 8, WGM = 8;

__host__ __device__ __forceinline__ int lds_byte(int r, int c) { const int st = (r >> 4) * 2 + (c >> 5), rr = r & 15, cc = c & 31, ob = rr * 64 + cc * 2; return st * 1024 + (ob ^ (((ob >> 9) & 1) << 5)); }
__host__ __device__ __forceinline__ void stage_rc(int b, int& R, int& C) { const int st = b / 1024, sb = b % 1024, swz = sb ^ (((sb >> 9) & 1) << 5); R = (st >> 1) * 16 + swz / 64; C = (st & 1) * 32 + (swz % 64) / 2; }
__host__ __device__ __forceinline__ int perm32(int rho) { const int n = rho >> 4, i = rho & 15; return 8 * (i >> 2) + 4 * n + (i & 3); }

struct Unit { int pm, pn, k0, nt, ks; };
struct Gemm { const bf16_t* A; const bf16_t* Bt; int ld; };

struct StaticOrder {
    int nM, nN, nwg, G, c;
    __host__ __device__ void init(int M, int N, int G_, int c_) { nM = M / BM; nN = N / BM; nwg = nM * nN; G = G_; c = c_; }
    __host__ __device__ __forceinline__ void tile(int L, int& pm_, int& pn_) const {
        int wgid = L; { const int q = nwg / NXCD, r = nwg % NXCD, xcd = wgid % NXCD, off = wgid / NXCD; wgid = (xcd < r ? xcd * (q + 1) : r * (q + 1) + (xcd - r) * q) + off; }
        const int nig = WGM * nN, gid = wgid / nig, fm = gid * WGM, gsz = (nM - fm) < WGM ? (nM - fm) : WGM;
        pm_ = fm + ((wgid % nig) % gsz); pn_ = (wgid % nig) / gsz;
    }
    __device__ __forceinline__ void a_ready(const Unit&) const {}
    __device__ __forceinline__ void done(const Unit&) const {}
};

typedef float f32x2_cv __attribute__((ext_vector_type(2))); typedef __bf16 bf16x2_cv __attribute__((ext_vector_type(2)));
__device__ __forceinline__ unsigned cvt_pk_bf16(float lo, float hi) { const f32x2_cv v = {lo, hi}; const bf16x2_cv b = __builtin_convertvector(v, bf16x2_cv); return __builtin_bit_cast(unsigned, b); }
typedef float f32x2 __attribute__((ext_vector_type(2)));
__device__ __forceinline__ f32x2 gelu_pk(f32x2 v) {
    const f32x2 av = __builtin_elementwise_abs(v), d = av * 0.2316418882f + 1.0f;
    f32x2 t; t.x = __builtin_amdgcn_rcpf(d.x); t.y = __builtin_amdgcn_rcpf(d.y);
    f32x2 q = t * 0.5307027145f + (-0.7265760135f); q = q * t + 0.7107068705f; q = q * t + (-0.142248368f); q = q * t + 0.127414796f; q = q * t;
    const f32x2 s = (v * v) * (-0.72134752044f);
    f32x2 e; e.x = __builtin_amdgcn_exp2f(s.x); e.y = __builtin_amdgcn_exp2f(s.y);
    const f32x2 m = v * (q * e), r = v - m;
    f32x2 o; o.x = v.x < 0.f ? m.x : r.x; o.y = v.y < 0.f ? m.y : r.y; return o;
}
struct Order {
    StaticOrder so; int G, c, n1c, ntk, split;
    __device__ __forceinline__ void init(int M1, int N, int K, int split_, int G_, int c_) { so.init(M1, N, G_, c_); G = G_; c = c_; ntk = K / BK; split = split_; n1c = (c < so.nwg) ? (so.nwg - c + G - 1) / G : 0; }
    __device__ __forceinline__ bool next(int i, Unit& u) const {
        const bool p1 = i < n1c; int pm1, pn1; so.tile(p1 ? i * G + c : 0, pm1, pn1);
        const int j = (i - n1c) * G + c; const bool p2 = !p1 && split != 0 && j < 256;
        const int ks = j & 7, jj = (j >> 3) & 31, b = (ntk >> 3) & ~1, rem2 = (ntk - 8 * b) >> 1;
        Unit r; r.pm = p1 ? pm1 : so.nM + (jj & 3); r.pn = p1 ? pn1 : (jj >> 2); r.k0 = p1 ? 0 : (ks * b + 2 * (ks < rem2 ? ks : rem2)) * BK; r.nt = p1 ? ntk : b + (ks < rem2 ? 2 : 0); r.ks = p1 ? -1 : ks;
        u = r; return p1 || p2;
    }
    __device__ __forceinline__ void a_ready(const Unit&) const {}
    __device__ __forceinline__ void done(const Unit&) const {}
};

__device__ __forceinline__ float silu_f(float x) { return x * __builtin_amdgcn_rcpf(1.0f + __builtin_amdgcn_exp2f(-1.4426950408889634f * x)); }

struct EpiPart {
    static constexpr bool PERM = false, AFTER_DRAIN = false;
    float* Y;
    __device__ __forceinline__ void operator()(const f32x4 (&acc)[2][2][4][2], const Unit& u, int wr, int wc, int fr, int fq) const {
        const int row0 = u.pm * BM + wr * 64 + fr + (u.ks > 0 ? u.ks * 1024 : 0), col0 = u.pn * BM + wc * 32 + 4 * fq;
#pragma unroll
        for (int ai = 0; ai < 2; ++ai)
#pragma unroll
            for (int m = 0; m < 4; ++m) { float* rowp = Y + (size_t)(row0 + ai * HALF + m * 16) * 2048 + col0;
#pragma unroll
                for (int bj = 0; bj < 2; ++bj)
#pragma unroll
                    for (int n = 0; n < 2; ++n) *(f32x4*)(rowp + bj * HALF + n * 16) = acc[ai][bj][m][n]; }
    }
};
struct EpiGeluUV {
    static constexpr bool PERM = true, AFTER_DRAIN = false;
    bf16_t* U; bf16_t* V; f32x2* stat;
    __device__ __forceinline__ void operator()(const f32x4 (&acc)[2][2][4][2], const Unit& u, int wr, int wc, int fr, int fq) const {
        const bool isv = u.pn >= 8; bf16_t* O = isv ? V : U;
        const int row0 = u.pm * BM + wr * 64 + fr, col0 = (u.pn & 7) * BM + wc * 32 + 8 * fq;
#pragma unroll
        for (int ai = 0; ai < 2; ++ai)
#pragma unroll
            for (int m = 0; m < 4; ++m) { const int row = row0 + ai * HALF + m * 16; bf16_t* rowp = O + (size_t)row * 2048 + col0; float s = 0.f, q = 0.f;
#pragma unroll
                for (int bj = 0; bj < 2; ++bj) { const f32x4 v0 = acc[ai][bj][m][0], v1 = acc[ai][bj][m][1];
                    const f32x2 a = gelu_pk((f32x2){v0[0], v0[1]}), b = gelu_pk((f32x2){v0[2], v0[3]}), c = gelu_pk((f32x2){v1[0], v1[1]}), d = gelu_pk((f32x2){v1[2], v1[3]});
                    s += ((a.x + a.y) + (b.x + b.y)) + ((c.x + c.y) + (d.x + d.y));
                    q += ((a.x * a.x + a.y * a.y) + (b.x * b.x + b.y * b.y)) + ((c.x * c.x + c.y * c.y) + (d.x * d.x + d.y * d.y));
                    u32x4 w; w.x = cvt_pk_bf16(a.x, a.y); w.y = cvt_pk_bf16(b.x, b.y); w.z = cvt_pk_bf16(c.x, c.y); w.w = cvt_pk_bf16(d.x, d.y);
                    *(u32x4*)(rowp + bj * HALF) = w; }
                if (isv) { s += __shfl_xor(s, 16); s += __shfl_xor(s, 32); q += __shfl_xor(q, 16); q += __shfl_xor(q, 32);
                    if (fq == 0) stat[(size_t)row * 32 + (u.pn - 8) * 4 + wc] = (f32x2){s, q}; } }
    }
};
struct EpiSwiglu {
    static constexpr bool PERM = true, AFTER_DRAIN = false;
    bf16_t* H;
    __device__ __forceinline__ void operator()(const f32x4 (&acc)[2][2][4][2], const Unit& u, int wr, int wc, int fr, int fq) const {
        const int row0 = u.pm * BM + wr * 64 + fr, col0 = u.pn * HALF + wc * 32 + 8 * fq;
#pragma unroll
        for (int ai = 0; ai < 2; ++ai)
#pragma unroll
            for (int m = 0; m < 4; ++m) { bf16_t* rowp = H + (size_t)(row0 + ai * HALF + m * 16) * 5632 + col0;
                const f32x4 g0 = acc[ai][0][m][0], g1 = acc[ai][0][m][1], u0 = acc[ai][1][m][0], u1 = acc[ai][1][m][1];
                u32x4 w; w.x = cvt_pk_bf16(silu_f(g0[0]) * u0[0], silu_f(g0[1]) * u0[1]); w.y = cvt_pk_bf16(silu_f(g0[2]) * u0[2], silu_f(g0[3]) * u0[3]);
                w.z = cvt_pk_bf16(silu_f(g1[0]) * u1[0], silu_f(g1[1]) * u1[1]); w.w = cvt_pk_bf16(silu_f(g1[2]) * u1[2], silu_f(g1[3]) * u1[3]);
                *(u32x4*)rowp = w; }
    }
};
__device__ __forceinline__ float lg2gamma(int h) {
    const double x = 1.0 / (double)(32 << h); double p = x, s = 0.0;
    const double inv[8] = {1.0, 0.5, 1.0 / 3.0, 0.25, 0.2, 1.0 / 6.0, 1.0 / 7.0, 0.125};
#pragma unroll
    for (int k = 0; k < 8; ++k) { s -= p * inv[k]; p *= x; }
    return (float)(s * 1.4426950408889634);
}
struct EpiQKVG {
    static constexpr bool PERM = true, AFTER_DRAIN = false;
    bf16_t *QH, *KH, *VB, *GS; const float* ropec; const float* ropes;
    __device__ __forceinline__ void operator()(const f32x4 (&acc)[2][2][4][2], const Unit& u, int wr, int wc, int fr, int fq) const {
        const int row0 = u.pm * BM + wr * 64 + fr, cw = wc * 32 + 8 * fq;
        if (u.pn < 16) {
            const bool isq = u.pn < 8; const int head = u.pn & 7; bf16_t* O = (isq ? QH : KH) + head * 256 + cw;
            const float lg = lg2gamma(head) * (isq ? 1.f : -1.f), sc0 = isq ? 0.0625f : 1.f;
#pragma unroll
            for (int ai = 0; ai < 2; ++ai)
#pragma unroll
                for (int m = 0; m < 4; ++m) { const int row = row0 + ai * HALF + m * 16;
                    const int pidx = row < MP ? (row & 2047) : 2048 + ((row - MP) & 31), ib = row < MP ? (row & 63) : ((row - MP) & 31);
                    const float sc = sc0 * __builtin_amdgcn_exp2f(lg * (float)ib);
                    const f32x4 c0 = *(const f32x4*)(ropec + pidx * 128 + cw), c1 = *(const f32x4*)(ropec + pidx * 128 + cw + 4);
                    const f32x4 s0 = *(const f32x4*)(ropes + pidx * 128 + cw), s1 = *(const f32x4*)(ropes + pidx * 128 + cw + 4);
                    const f32x4 a0 = acc[ai][0][m][0], a1 = acc[ai][0][m][1], b0 = acc[ai][1][m][0], b1 = acc[ai][1][m][1];
                    const f32x4 o0 = (a0 * c0 - b0 * s0) * sc, o1 = (a1 * c1 - b1 * s1) * sc, p0 = (a0 * s0 + b0 * c0) * sc, p1 = (a1 * s1 + b1 * c1) * sc;
                    u32x4 w; w.x = cvt_pk_bf16(o0[0], o0[1]); w.y = cvt_pk_bf16(o0[2], o0[3]); w.z = cvt_pk_bf16(o1[0], o1[1]); w.w = cvt_pk_bf16(o1[2], o1[3]);
                    *(u32x4*)(O + (size_t)row * 2048) = w;
                    w.x = cvt_pk_bf16(p0[0], p0[1]); w.y = cvt_pk_bf16(p0[2], p0[3]); w.z = cvt_pk_bf16(p1[0], p1[1]); w.w = cvt_pk_bf16(p1[2], p1[3]);
                    *(u32x4*)(O + (size_t)row * 2048 + HALF) = w; }
        } else {
            const bool isg = u.pn >= 32; bf16_t* O = (isg ? GS : VB) + ((u.pn - 16) & 15) * BM + cw;
#pragma unroll
            for (int ai = 0; ai < 2; ++ai)
#pragma unroll
                for (int m = 0; m < 4; ++m) { bf16_t* rowp = O + (size_t)(row0 + ai * HALF + m * 16) * 4096;
#pragma unroll
                    for (int bj = 0; bj < 2; ++bj) { f32x4 v0 = acc[ai][bj][m][0], v1 = acc[ai][bj][m][1];
                        if (isg) { v0 = (f32x4){silu_f(v0[0]), silu_f(v0[1]), silu_f(v0[2]), silu_f(v0[3])}; v1 = (f32x4){silu_f(v1[0]), silu_f(v1[1]), silu_f(v1[2]), silu_f(v1[3])}; }
                        u32x4 w; w.x = cvt_pk_bf16(v0[0], v0[1]); w.y = cvt_pk_bf16(v0[2], v0[3]); w.z = cvt_pk_bf16(v1[0], v1[1]); w.w = cvt_pk_bf16(v1[2], v1[3]);
                        *(u32x4*)(rowp + bj * HALF) = w; } }
        }
    }
};
template <class Epi, class Sched, bool ALIGN_EPI = false, bool SP2 = false>
__device__ __forceinline__ void gemm_phase(PG8_LAS unsigned char* lds, const Gemm g, const Sched& S, const Epi& E) {
    int tid_ = threadIdx.x; asm volatile("" : "+v"(tid_));
    const int tid = tid_, wid = __builtin_amdgcn_readfirstlane(tid >> 6), lane = tid & 63, wr = wid >> 2, wc = wid & 3, fr = lane & 15, fq = lane >> 4;
    const int K = g.ld;
    unsigned voffA[2], voffB[2];
#pragma unroll
    for (int i = 0; i < 2; ++i) { int R, C; stage_rc(tid * 16 + i * 8192, R, C); const int Rb = Epi::PERM ? ((R & ~31) + perm32(R & 31)) : R;
        voffA[i] = (unsigned)(R * K + C) * 2u; voffB[i] = (unsigned)(Rb * K + C) * 2u; }
    const size_t kstep = (size_t)(BK * 2);
    const size_t hstep = (size_t)HALF * K * 2;
    const size_t tstep = 2 * hstep;
    const unsigned ldsw = (unsigned)wid * 1024u;
    const int aoff = lds_byte(wr * 64 + fr, fq * 8), boff = lds_byte(wc * 32 + fr, fq * 8);
#define PG8_SA(b, h) (((b) * 2 + (h)) * HTB)
#define PG8_SB(b, h) ((4 + (b) * 2 + (h)) * HTB)
#define PG8_STAGE(bufoff, gbase, voff) do { _Pragma("unroll") for (int _i = 0; _i < 2; ++_i) \
        __builtin_amdgcn_global_load_lds((const unsigned*)((const char*)(gbase) + (voff)[_i]), (PG8_LAS unsigned*)(lds + (bufoff) + ldsw + _i * 8192), 16, 0, 0); } while (0)
#define PG8_LDA(dst, b, h) do { _Pragma("unroll") for (int m = 0; m < 4; ++m) _Pragma("unroll") for (int k = 0; k < 2; ++k) dst[m][k] = *(const PG8_LAS bf16x8*)(lds + PG8_SA(b, h) + aoff + m * 2048 + k * 1024); } while (0)
#define PG8_LDB(dst, b, h) do { _Pragma("unroll") for (int n = 0; n < 2; ++n) _Pragma("unroll") for (int k = 0; k < 2; ++k) dst[n][k] = *(const PG8_LAS bf16x8*)(lds + PG8_SB(b, h) + boff + n * 2048 + k * 1024); } while (0)
#define PG8_MMA(ai, bj, At, Bt) do { __builtin_amdgcn_s_setprio(1); _Pragma("unroll") for (int m = 0; m < 4; ++m) _Pragma("unroll") for (int n = 0; n < 2; ++n) _Pragma("unroll") for (int k = 0; k < 2; ++k) \
        acc[ai][bj][m][n] = __builtin_amdgcn_mfma_f32_16x16x32_bf16(Bt[n][k], At[m][k], acc[ai][bj][m][n], 0, 0, 0); __builtin_amdgcn_s_setprio(0); } while (0)
#define PG8_WAIT_V(n) asm volatile("s_waitcnt vmcnt(" #n ")" ::: "memory")
#define PG8_WAIT_L(n) asm volatile("s_waitcnt lgkmcnt(" #n ")" ::: "memory")
#define PG8_BAR __builtin_amdgcn_s_barrier()
#define PG8_SCHED __builtin_amdgcn_sched_barrier(0)
    Unit cur, nxt; int ui = 0;
    if (!S.next(0, cur)) return;
    f32x4 acc[2][2][4][2];
#pragma unroll
    for (int a = 0; a < 2; ++a)
#pragma unroll
        for (int b = 0; b < 2; ++b)
#pragma unroll
            for (int m = 0; m < 4; ++m)
#pragma unroll
                for (int n = 0; n < 2; ++n) acc[a][b][m][n] = (f32x4){0.f, 0.f, 0.f, 0.f};
    bf16x8 At[4][2], B0[2][2], B1[2][2];
    const char* cA = (const char*)g.A + (size_t)cur.pm * tstep + (size_t)cur.k0 * 2; const char* cB = (const char*)g.Bt + (size_t)cur.pn * tstep + (size_t)cur.k0 * 2; int nt = cur.nt;
    S.a_ready(cur);
    if constexpr (SP2) {
        PG8_STAGE(PG8_SB(0, 0), cB, voffB); PG8_STAGE(PG8_SB(0, 1), cB + hstep, voffB); PG8_STAGE(PG8_SA(0, 0), cA, voffA); PG8_STAGE(PG8_SA(0, 1), cA + hstep, voffA);
        if (wr == 1) PG8_BAR;
        PG8_WAIT_V(2); PG8_BAR;
        PG8_STAGE(PG8_SB(1, 0), cB + kstep, voffB); PG8_STAGE(PG8_SA(1, 0), cA + kstep, voffA); PG8_STAGE(PG8_SB(1, 1), cB + hstep + kstep, voffB);
        PG8_WAIT_V(6); PG8_BAR;
    } else {
        PG8_STAGE(PG8_SB(0, 0), cB, voffB); PG8_STAGE(PG8_SA(0, 0), cA, voffA); PG8_STAGE(PG8_SB(0, 1), cB + hstep, voffB); PG8_STAGE(PG8_SA(0, 1), cA + hstep, voffA);
        if (wr == 1) PG8_BAR;
        PG8_WAIT_V(4); PG8_BAR;
        PG8_STAGE(PG8_SB(1, 0), cB + kstep, voffB); PG8_STAGE(PG8_SA(1, 0), cA + kstep, voffA); PG8_STAGE(PG8_SB(1, 1), cB + hstep + kstep, voffB);
        PG8_WAIT_V(6); PG8_BAR;
    }
    for (;;) {
        const bool has_next = S.next(ui + 1, nxt);
        const char* nA = has_next ? (const char*)g.A + (size_t)nxt.pm * tstep + (size_t)nxt.k0 * 2 : cA; const char* nB = has_next ? (const char*)g.Bt + (size_t)nxt.pn * tstep + (size_t)nxt.k0 * 2 : cB;
        for (int t = 0; t < nt; t += 2) {
            const bool last = (t == nt - 2);
            const char* a1 = cA + (size_t)(t + 1) * kstep;
            const char* a2 = last ? nA : cA + (size_t)(t + 2) * kstep; const char* b2 = last ? nB : cB + (size_t)(t + 2) * kstep;
            const char* a3 = a2 + kstep; const char* b3 = b2 + kstep;
            if (last && has_next) S.a_ready(nxt);
            if constexpr (SP2) {
            PG8_LDB(B0, 0, 0); PG8_LDB(B1, 0, 1); PG8_SCHED; PG8_LDA(At, 0, 0); PG8_STAGE(PG8_SA(1, 1), a1 + hstep, voffA);
            PG8_WAIT_V(8); PG8_WAIT_L(0); PG8_BAR; PG8_MMA(0, 0, At, B0); PG8_MMA(0, 1, At, B1); PG8_BAR; PG8_SCHED;
            PG8_LDA(At, 0, 1); PG8_STAGE(PG8_SB(0, 0), b2, voffB); PG8_STAGE(PG8_SB(0, 1), b2 + hstep, voffB); PG8_STAGE(PG8_SA(0, 0), a2, voffA);
            PG8_WAIT_V(8); PG8_WAIT_L(0); PG8_BAR; PG8_MMA(1, 0, At, B0); PG8_MMA(1, 1, At, B1); PG8_BAR; PG8_SCHED;
            PG8_LDB(B0, 1, 0); PG8_LDB(B1, 1, 1); PG8_SCHED; PG8_LDA(At, 1, 0); PG8_STAGE(PG8_SA(0, 1), a2 + hstep, voffA);
            PG8_WAIT_V(8); PG8_WAIT_L(0); PG8_BAR; PG8_MMA(0, 0, At, B0); PG8_MMA(0, 1, At, B1); PG8_BAR; PG8_SCHED;
            PG8_LDA(At, 1, 1); PG8_STAGE(PG8_SB(1, 0), b3, voffB); PG8_STAGE(PG8_SB(1, 1), b3 + hstep, voffB); PG8_STAGE(PG8_SA(1, 0), a3, voffA);
            PG8_WAIT_V(8); PG8_WAIT_L(0); PG8_BAR; PG8_MMA(1, 0, At, B0); PG8_MMA(1, 1, At, B1); PG8_BAR; PG8_SCHED;
            } else {
            PG8_LDB(B0, 0, 0); PG8_SCHED; PG8_LDA(At, 0, 0); PG8_STAGE(PG8_SA(1, 1), a1 + hstep, voffA);
            PG8_WAIT_L(8); PG8_BAR; PG8_WAIT_L(0); PG8_MMA(0, 0, At, B0); PG8_BAR; PG8_SCHED;
            PG8_LDB(B1, 0, 1); PG8_STAGE(PG8_SB(0, 0), b2, voffB);
            PG8_BAR; PG8_WAIT_L(0); PG8_MMA(0, 1, At, B1); PG8_BAR;
            PG8_LDA(At, 0, 1); PG8_STAGE(PG8_SA(0, 0), a2, voffA);
            PG8_BAR; PG8_WAIT_L(0); PG8_MMA(1, 0, At, B0); PG8_BAR; PG8_SCHED;
            PG8_STAGE(PG8_SB(0, 1), b2 + hstep, voffB);
            PG8_WAIT_V(6); PG8_BAR; PG8_MMA(1, 1, At, B1); PG8_BAR;
            PG8_LDB(B0, 1, 0); PG8_SCHED; PG8_LDA(At, 1, 0); PG8_STAGE(PG8_SA(0, 1), a2 + hstep, voffA);
            PG8_WAIT_L(8); PG8_BAR; PG8_WAIT_L(0); PG8_MMA(0, 0, At, B0); PG8_BAR; PG8_SCHED;
            PG8_LDB(B1, 1, 1); PG8_STAGE(PG8_SB(1, 0), b3, voffB);
            PG8_BAR; PG8_WAIT_L(0); PG8_MMA(0, 1, At, B1); PG8_BAR;
            PG8_LDA(At, 1, 1); PG8_STAGE(PG8_SA(1, 0), a3, voffA);
            PG8_BAR; PG8_WAIT_L(0); PG8_MMA(1, 0, At, B0); PG8_BAR; PG8_SCHED;
            PG8_STAGE(PG8_SB(1, 1), b3 + hstep, voffB);
            PG8_WAIT_V(6); PG8_BAR; PG8_MMA(1, 1, At, B1); PG8_BAR;
            }
        }
        if constexpr (ALIGN_EPI) { if (wr == 0) PG8_BAR; }
        if constexpr (!Epi::AFTER_DRAIN) { E(acc, cur, wr, wc, fr, fq); S.done(cur); }
        if (!has_next) break;
#pragma unroll
        for (int a = 0; a < 2; ++a)
#pragma unroll
            for (int b = 0; b < 2; ++b)
#pragma unroll
                for (int m = 0; m < 4; ++m)
#pragma unroll
                    for (int n = 0; n < 2; ++n) acc[a][b][m][n] = (f32x4){0.f, 0.f, 0.f, 0.f};
        cur = nxt; cA = nA; cB = nB; nt = cur.nt; ++ui;
        if constexpr (ALIGN_EPI) { if (wr == 1) PG8_BAR; }
    }
    PG8_WAIT_V(0);
    if constexpr (!ALIGN_EPI) { if (wr == 0) PG8_BAR; }
    PG8_BAR;
    if constexpr (Epi::AFTER_DRAIN) { E.fused(acc, cur, wr, wc, fr, fq, lds, wid, lane); S.done(cur); }
#undef PG8_SA
#undef PG8_SB
#undef PG8_STAGE
#undef PG8_LDA
#undef PG8_LDB
#undef PG8_MMA
#undef PG8_WAIT_V
#undef PG8_WAIT_L
#undef PG8_BAR
#undef PG8_SCHED
}
}
constexpr size_t MiB = 1u << 20;
constexpr size_t WS_WAIN = 0, WS_WAOUT = 16 * MiB, WS_WBIN = 24 * MiB, WS_WBOUT = 72 * MiB, WS_WFIN = 88 * MiB, WS_WFOUT = 176 * MiB;
constexpr size_t WS_XB = 220 * MiB;
constexpr size_t WS_STAT = 256 * MiB;
constexpr size_t WS_ROPE = 259 * MiB;
constexpr size_t WS_YP = 262 * MiB;
constexpr size_t WS_XF = 390 * MiB;
constexpr size_t WS_R1 = 462 * MiB;
constexpr size_t WS_CTL = 678 * MiB, CTL_BYTES = 16384;
constexpr size_t WS_END = 679 * MiB;
constexpr int MISC_OFF = 131072 + 320;
constexpr int LDS_BYTES = 147456;
constexpr int NW = 8;

#define LAS __attribute__((address_space(3)))
typedef unsigned short bf16;
typedef unsigned u32x4 __attribute__((ext_vector_type(4)));
typedef unsigned u32x2 __attribute__((ext_vector_type(2)));
typedef float f32x4 __attribute__((ext_vector_type(4)));
typedef float f32x2 __attribute__((ext_vector_type(2)));
typedef short bf16x8 __attribute__((ext_vector_type(8)));
typedef short s16x4 __attribute__((ext_vector_type(4)));
#define LDS_WAIT() asm volatile("s_waitcnt lgkmcnt(0)" ::: "memory")
__device__ __forceinline__ unsigned pk2(float lo, float hi) { return pg8::cvt_pk_bf16(lo, hi); }
__device__ __forceinline__ float bf_lo(unsigned w) { return __uint_as_float(w << 16); }
__device__ __forceinline__ float bf_hi(unsigned w) { return __uint_as_float(w & 0xffff0000u); }
__device__ __forceinline__ float wave_sum(float v) {
#pragma unroll
    for (int o = 1; o < 64; o <<= 1) v += __shfl_xor(v, o);
    return v;
}

struct Args { const float* in[17]; float* out; unsigned char* ws; };

template <int MAPMODE>
__device__ __forceinline__ void p0_transpose_item(const float* W, int K, int N, bf16* WT, LAS float* scr, int item, int lane) {
    const int nblk = N / 32, kb = item / nblk, nb = item % nblk, k0 = 64 * kb, n0 = 32 * nb;
#pragma unroll 8
    for (int i = 0; i < 32; ++i) { const int kk = 2 * i + (lane >> 5); scr[kk * 33 + (lane & 31)] = W[(size_t)(k0 + kk) * N + n0 + (lane & 31)]; }
    LDS_WAIT(); asm volatile("" ::: "memory");
    int r0 = n0;
    if (MAPMODE == 1) { const int up = n0 >= FF ? 1 : 0, c = n0 - up * FF; r0 = 256 * (c >> 7) + (c & 127) + 128 * up; }
    const int c8 = lane & 7;
#pragma unroll
    for (int j = 0; j < 4; ++j) { const int n = (lane >> 3) + 8 * j; const LAS float* s = scr + (8 * c8) * 33 + n;
        u32x4 o; o.x = pk2(s[0 * 33], s[1 * 33]); o.y = pk2(s[2 * 33], s[3 * 33]); o.z = pk2(s[4 * 33], s[5 * 33]); o.w = pk2(s[6 * 33], s[7 * 33]);
        *(u32x4*)(WT + (size_t)(r0 + n) * K + k0 + 8 * c8) = o; }
    LDS_WAIT(); asm volatile("" ::: "memory");
}
__device__ __forceinline__ void convert_list(const Args& a, LAS unsigned char* lds, int list, int w, int nw, int wave, int lane) {
    LAS float* scr = (LAS float*)(lds + wave * 16384);
    unsigned char* ws = a.ws;
    constexpr int I0 = 32 * 128, I1 = 32 * 64, I2 = 32 * 384, I3 = 64 * 64, I4 = 32 * 352, I5 = 88 * 64;
    if (list == 0) {
        for (int r = w; r < I0; r += nw) p0_transpose_item<0>(a.in[3], 2048, 4096, (bf16*)(ws + WS_WAIN), scr, r, lane);
    } else if (list == 1) {
        for (int it = w; it < I1 + I4 + I5; it += nw) { int r = it;
            if (r < I1) { p0_transpose_item<0>(a.in[8], 2048, 2048, (bf16*)(ws + WS_WAOUT), scr, r, lane); continue; } r -= I1;
            if (r < I4) { p0_transpose_item<1>(a.in[11], 2048, 11264, (bf16*)(ws + WS_WFIN), scr, r, lane); continue; } r -= I4;
            p0_transpose_item<0>(a.in[12], 5632, 2048, (bf16*)(ws + WS_WFOUT), scr, r, lane); }
    } else if (list == 2) {
        for (int it = w; it < I2 + I3 + I4; it += nw) { int r = it;
            if (r < I2) { p0_transpose_item<0>(a.in[9], 2048, 12288, (bf16*)(ws + WS_WBIN), scr, r, lane); continue; } r -= I2;
            if (r < I3) { p0_transpose_item<0>(a.in[10], 4096, 2048, (bf16*)(ws + WS_WBOUT), scr, r, lane); continue; } r -= I3;
            p0_transpose_item<1>(a.in[11] + (size_t)2048 * 11264, 2048, 11264, (bf16*)(ws + WS_WFIN + 44 * MiB), scr, r, lane); }
    } else {
        for (int r = w; r < I5; r += nw) p0_transpose_item<0>(a.in[12] + (size_t)5632 * 2048, 5632, 2048, (bf16*)(ws + WS_WFOUT + 22 * MiB), scr, r, lane);
    }
}
__device__ __forceinline__ void p0_prologue(const Args& a, LAS unsigned char* lds, int gw, int NGW, int wave, int lane) {
    unsigned char* ws = a.ws;
    convert_list(a, lds, 0, gw, NGW, wave, lane);
    bf16* XB = (bf16*)(ws + WS_XB);
    for (int m = gw; m < MT; m += NGW) {
        const f32x4* xr = (const f32x4*)(m < MP ? a.in[0] + (size_t)m * DM : a.in[1] + (size_t)(m - MP) * DM) + lane;
        u32x2* o = (u32x2*)(XB + (size_t)m * DM) + lane;
#pragma unroll
        for (int j = 0; j < 8; ++j) { const f32x4 v = xr[64 * j]; u32x2 w; w.x = pk2(v[0], v[1]); w.y = pk2(v[2], v[3]); o[64 * j] = w; }
    }
    float* rc = (float*)(ws + WS_ROPE); float* rs = rc + 2080 * 128;
    for (int e = gw * 64 + lane; e < 2080 * 128; e += NGW * 64) {
        const int p = e >> 7, d = e & 127; const float pos = (float)(p < 2048 ? p : 4096 + (p - 2048));
        const float inv = __builtin_amdgcn_exp2f(-(float)d * (13.287712379549449f / 128.0f));
        const double rev = (double)(pos * inv) * 0.15915494309189535; const float fr = (float)(rev - __builtin_floor(rev));
        rc[e] = __builtin_amdgcn_cosf(fr); rs[e] = __builtin_amdgcn_sinf(fr);
    }
}

__device__ __forceinline__ void ln_pass(const float* xres_p, const float* xres_s, const bf16* xb, const float* YP, const float* g, const float* b, float* outf, bf16* outb, int gw, int NGW, int lane) {
    for (int row = gw; row < MT; row += NGW) {
        f32x4 v[8];
        if (xres_p) { const f32x4* xr = (const f32x4*)(row < MP ? xres_p + (size_t)row * DM : xres_s + (size_t)(row - MP) * DM) + lane;
#pragma unroll
            for (int j = 0; j < 8; ++j) v[j] = xr[64 * j] * ALPHA;
        } else { const u32x2* xr = (const u32x2*)(xb + (size_t)row * DM) + lane;
#pragma unroll
            for (int j = 0; j < 8; ++j) { const u32x2 w = xr[64 * j]; v[j] = (f32x4){bf_lo(w.x), bf_hi(w.x), bf_lo(w.y), bf_hi(w.y)} * ALPHA; } }
        if (row < MP) { const f32x4* y = (const f32x4*)(YP + (size_t)row * DM) + lane;
#pragma unroll
            for (int j = 0; j < 8; ++j) v[j] += y[64 * j];
        } else {
            for (int ks = 0; ks < 8; ++ks) { const f32x4* y = (const f32x4*)(YP + (size_t)(MP + ks * MS + (row - MP)) * DM) + lane;
#pragma unroll
                for (int j = 0; j < 8; ++j) v[j] += y[64 * j]; }
        }
        float s = 0.f;
#pragma unroll
        for (int j = 0; j < 8; ++j) s += (v[j][0] + v[j][1]) + (v[j][2] + v[j][3]);
        const float mean = wave_sum(s) * (1.f / DM); float q = 0.f;
#pragma unroll
        for (int j = 0; j < 8; ++j) { v[j] = v[j] - mean; q += (v[j][0] * v[j][0] + v[j][1] * v[j][1]) + (v[j][2] * v[j][2] + v[j][3] * v[j][3]); }
        const float rstd = 1.0f / sqrtf(wave_sum(q) * (1.f / DM) + LN_EPS);
#pragma unroll
        for (int j = 0; j < 8; ++j) { const f32x4 gg = ((const f32x4*)g)[lane + 64 * j], bb = ((const f32x4*)b)[lane + 64 * j]; const f32x4 o = v[j] * rstd * gg + bb;
            if (outf) ((f32x4*)(outf + (size_t)row * DM) + lane)[64 * j] = o;
            if (outb) { u32x2 w; w.x = pk2(o[0], o[1]); w.y = pk2(o[2], o[3]); ((u32x2*)(outb + (size_t)row * DM) + lane)[64 * j] = w; } }
    }
}

__device__ __forceinline__ bf16x8 frag_plain(const LAS bf16* X, int ld, int r0, int k0, int lane) { return *(const LAS bf16x8*)(X + (r0 + (lane & 15)) * ld + k0 + 8 * (lane >> 4)); }
typedef short v4i16_t __attribute__((ext_vector_type(4)));
__device__ __forceinline__ bf16x8 frag_tr(const LAS bf16* Y, int ld, int kr0, int c0, int lane) {
    const int i = lane & 15, g4 = lane >> 4; const LAS bf16* p = Y + (kr0 + 8 * g4 + (i >> 2)) * ld + c0 + 4 * (i & 3);
    const v4i16_t lo = __builtin_amdgcn_ds_read_tr16_b64_v4i16((LAS v4i16_t*)p), hi = __builtin_amdgcn_ds_read_tr16_b64_v4i16((LAS v4i16_t*)(p + 4 * ld));
    return (bf16x8){lo[0], lo[1], lo[2], lo[3], hi[0], hi[1], hi[2], hi[3]};
}
#define MFMA16(a, b, c) __builtin_amdgcn_mfma_f32_16x16x32_bf16((a), (b), (c), 0, 0, 0)

__device__ __forceinline__ void mix_phase(const Args& a, LAS unsigned char* lds, int wave, int lane) {
    const int tid = threadIdx.x;
    LAS bf16* Wm = (LAS bf16*)lds;
    LAS bf16* vn = (LAS bf16*)(lds + 34816);
    LAS f32x2* mr = (LAS f32x2*)(lds + 34816 + 67584);
    const bf16* U = (const bf16*)(a.ws + WS_R1); const bf16* V = U + (size_t)MT * DM; bf16* SB = (bf16*)(a.ws + WS_R1 + 72 * MiB);
    const f32x2* stat = (const f32x2*)(a.ws + WS_STAT);
    const float* lng = a.in[4]; const float* lnb = a.in[5]; const float* aws = a.in[6]; const float* abs_ = a.in[7];
    float* gv = a.out + (size_t)MT * DM + (size_t)(4 + 32) * 8 * 256 * 512;
    for (int item = blockIdx.x; item < 72 * 8; item += gridDim.x) {
        const int rb = item >> 3, g = item & 7, row0 = rb * 128; const bool smp = rb >= 64;
        if (tid < 128) { const f32x2* sp = stat + (size_t)(row0 + tid) * 32; float s = 0.f, q = 0.f;
#pragma unroll 8
            for (int k = 0; k < 32; ++k) { const f32x2 v = sp[k]; s += v.x; q += v.y; }
            const float mean = s * (1.f / 2048.f), var = q * (1.f / 2048.f) - mean * mean; mr[tid] = (f32x2){mean, 1.0f / sqrtf(var + LN_EPS)}; }
        { const int t = tid >> 2, s0 = (tid & 3) * 32; const int tw = smp ? (t & 31) : t;
#pragma unroll
            for (int k = 0; k < 4; ++k) { const int s = s0 + 8 * k; const int sw = smp ? (s & 31) : s;
                const f32x4 w0 = *(const f32x4*)(aws + ((size_t)g * 128 + tw) * 128 + sw), w1 = *(const f32x4*)(aws + ((size_t)g * 128 + tw) * 128 + sw + 4);
                float w[8] = {w0[0], w0[1], w0[2], w0[3], w1[0], w1[1], w1[2], w1[3]};
#pragma unroll
                for (int e = 0; e < 8; ++e) { const int ss = s + e; const bool ok = smp ? ((ss >> 5) == (t >> 5) && (ss & 31) <= (t & 31)) : (ss <= t); w[e] = ok ? w[e] : 0.f; }
                u32x4 o; o.x = pk2(w[0], w[1]); o.y = pk2(w[2], w[3]); o.z = pk2(w[4], w[5]); o.w = pk2(w[6], w[7]);
                *(LAS u32x4*)(Wm + t * 136 + s) = o; } }
        __syncthreads();
        { const int s = tid >> 2, cb = (tid & 3) * 64; const f32x2 m = mr[s]; const bf16* vp = V + (size_t)(row0 + s) * DM + g * 256 + cb;
#pragma unroll
            for (int k = 0; k < 8; ++k) { const u32x4 w = *(const u32x4*)(vp + 8 * k); const int c = g * 256 + cb + 8 * k;
                const f32x4 g0 = *(const f32x4*)(lng + c), g1 = *(const f32x4*)(lng + c + 4), b0 = *(const f32x4*)(lnb + c), b1 = *(const f32x4*)(lnb + c + 4);
                f32x4 x0 = (f32x4){bf_lo(w.x), bf_hi(w.x), bf_lo(w.y), bf_hi(w.y)}, x1 = (f32x4){bf_lo(w.z), bf_hi(w.z), bf_lo(w.w), bf_hi(w.w)};
                x0 = (x0 - m.x) * m.y * g0 + b0; x1 = (x1 - m.x) * m.y * g1 + b1;
                u32x4 o; o.x = pk2(x0[0], x0[1]); o.y = pk2(x0[2], x0[3]); o.z = pk2(x1[0], x1[1]); o.w = pk2(x1[2], x1[3]);
                *(LAS u32x4*)(vn + s * 264 + cb + 8 * k) = o;
                if (smp) { float* op = gv + (size_t)(row0 + s - MP) * DM + c; *(f32x4*)op = x0; *(f32x4*)(op + 4) = x1; } } }
        __syncthreads();
        {
            const int t0 = 16 * wave, i = lane & 15, g4 = lane >> 4; f32x4 acc[16];
#pragma unroll
            for (int ct = 0; ct < 16; ++ct) acc[ct] = (f32x4){0.f, 0.f, 0.f, 0.f};
            const int kmax = (t0 + 15) >> 5;
            for (int kk = 0; kk <= kmax; ++kk) { const bf16x8 bw = frag_plain(Wm, 136, t0, 32 * kk, lane);
#pragma unroll
                for (int ct = 0; ct < 16; ++ct) { const bf16x8 av = frag_tr(vn, 264, 32 * kk, 16 * ct, lane); acc[ct] = MFMA16(av, bw, acc[ct]); } }
            const int t = t0 + i, row = row0 + t; const float bias = abs_[g * 128 + (smp ? (t & 31) : t)];
#pragma unroll
            for (int ct = 0; ct < 16; ++ct) { const size_t off = (size_t)row * DM + g * 256 + 16 * ct + 4 * g4; const u32x2 uu = *(const u32x2*)(U + off);
                u32x2 o; o.x = pk2(bf_lo(uu.x) * (acc[ct][0] + bias), bf_hi(uu.x) * (acc[ct][1] + bias)); o.y = pk2(bf_lo(uu.y) * (acc[ct][2] + bias), bf_hi(uu.y) * (acc[ct][3] + bias));
                *(u32x2*)(SB + off) = o; }
        }
        __syncthreads();
    }
}
constexpr int R_QS = 0, R_KS = 33792, R_VS = 67584, R_PS = 76800, R_RT = 86016, R_OS = 119808;
template <int L>
__device__ __forceinline__ void ret_run(LAS unsigned char* lds, const bf16* QH, const bf16* KH, const bf16* VB, bf16* OB, int grow0, int nblk, int h, int slice, const float* S0, float* Sout, int wave, int lane) {
    const int tid = threadIdx.x, i = lane & 15, g4 = lane >> 4;
    LAS bf16* qs = (LAS bf16*)(lds + R_QS); LAS bf16* ks = (LAS bf16*)(lds + R_KS); LAS bf16* vs = (LAS bf16*)(lds + R_VS);
    LAS bf16* ps = (LAS bf16*)(lds + R_PS); LAS bf16* rts = (LAS bf16*)(lds + R_RT); LAS bf16* os = (LAS bf16*)(lds + R_OS);
    const float lg = pg8::lg2gamma(h);
    const float gL = __builtin_amdgcn_exp2f(lg * (float)L), gLm1 = __builtin_amdgcn_exp2f(lg * (float)(L - 1)), gLm1i = __builtin_amdgcn_exp2f(-lg * (float)(L - 1));
    constexpr int NQ = L / 16, NT = L / 32, NKK = L / 32;
    const bool vthr = (L == 64) || tid < 256;
    u32x4 pq[NQ], pk[NQ], pv;
#define RET_GLOAD(blk) do { const int r0_ = grow0 + (blk) * L; _Pragma("unroll") for (int k_ = 0; k_ < NQ; ++k_) { const int e_ = tid + 512 * k_, row_ = e_ >> 5, ch_ = e_ & 31; \
        pq[k_] = *(const u32x4*)(QH + (size_t)(r0_ + row_) * 2048 + h * 256 + ch_ * 8); pk[k_] = *(const u32x4*)(KH + (size_t)(r0_ + row_) * 2048 + h * 256 + ch_ * 8); } \
        if (vthr) pv = *(const u32x4*)(VB + (size_t)(r0_ + (tid >> 3)) * 4096 + h * 512 + slice * 64 + (tid & 7) * 8); } while (0)
#define RET_LSTORE() do { _Pragma("unroll") for (int k_ = 0; k_ < NQ; ++k_) { const int e_ = tid + 512 * k_, row_ = e_ >> 5, ch_ = e_ & 31; \
        *(LAS u32x4*)(qs + row_ * 264 + ch_ * 8) = pq[k_]; *(LAS u32x4*)(ks + row_ * 264 + ch_ * 8) = pk[k_]; } \
        if (vthr) *(LAS u32x4*)(vs + (tid >> 3) * 72 + (tid & 7) * 8) = pv; } while (0)
    f32x4 R[2][4];
    RET_GLOAD(0);
#pragma unroll
    for (int a2 = 0; a2 < 2; ++a2)
#pragma unroll
        for (int d = 0; d < 4; ++d) {
            if (S0) {
#pragma unroll
                for (int e = 0; e < 4; ++e) R[a2][d][e] = S0[(size_t)(32 * wave + 16 * a2 + 4 * g4 + e) * 512 + slice * 64 + 16 * d + i] * gLm1i;
            } else R[a2][d] = (f32x4){0.f, 0.f, 0.f, 0.f};
            u32x2 w; w.x = pk2(R[a2][d][0], R[a2][d][1]); w.y = pk2(R[a2][d][2], R[a2][d][3]);
            *(LAS u32x2*)(rts + (16 * d + i) * 264 + 32 * wave + 16 * a2 + 4 * g4) = w; }
    RET_LSTORE();
    __syncthreads();
    const int it = (L == 64) ? (wave >> 1) : (wave >> 2);
    for (int n = 0; n < nblk; ++n) {
        if (n + 1 < nblk) RET_GLOAD(n + 1);
        if (L == 64 || wave < 4) {
#pragma unroll
            for (int tp = 0; tp < NT; ++tp) { const int i0 = 16 * (wave >> 1), j0 = (L == 64) ? 16 * (2 * (wave & 1) + tp) : 16 * (wave & 1);
                f32x4 acc = (f32x4){0.f, 0.f, 0.f, 0.f};
#pragma unroll
                for (int kk = 0; kk < 8; ++kk) acc = MFMA16(frag_plain(ks, 264, j0, 32 * kk, lane), frag_plain(qs, 264, i0, 32 * kk, lane), acc);
#pragma unroll
                for (int e = 0; e < 4; ++e) acc[e] = (j0 + 4 * g4 + e <= i0 + i) ? acc[e] : 0.f;
                u32x2 w; w.x = pk2(acc[0], acc[1]); w.y = pk2(acc[2], acc[3]); *(LAS u32x2*)(ps + (i0 + i) * 72 + j0 + 4 * g4) = w; }
        }
        f32x4 oacc[NT];
#pragma unroll
        for (int tp = 0; tp < NT; ++tp) { const int dv0 = (L == 64) ? 16 * (2 * (wave & 1) + tp) : 16 * (wave & 3);
            f32x4 acc = (f32x4){0.f, 0.f, 0.f, 0.f};
#pragma unroll
            for (int kk = 0; kk < 8; ++kk) acc = MFMA16(frag_plain(rts, 264, dv0, 32 * kk, lane), frag_plain(qs, 264, 16 * it, 32 * kk, lane), acc);
            oacc[tp] = acc * gL; }
        __syncthreads();
#pragma unroll
        for (int tp = 0; tp < NT; ++tp) { const int dv0 = (L == 64) ? 16 * (2 * (wave & 1) + tp) : 16 * (wave & 3);
#pragma unroll
            for (int kk = 0; kk < NKK; ++kk) oacc[tp] = MFMA16(frag_tr(vs, 72, 32 * kk, dv0, lane), frag_plain(ps, 72, 16 * it, 32 * kk, lane), oacc[tp]);
            u32x2 w; w.x = pk2(oacc[tp][0], oacc[tp][1]); w.y = pk2(oacc[tp][2], oacc[tp][3]); *(LAS u32x2*)(os + (16 * it + i) * 72 + dv0 + 4 * g4) = w; }
#pragma unroll
        for (int a2 = 0; a2 < 2; ++a2)
#pragma unroll
            for (int d = 0; d < 4; ++d) R[a2][d] = R[a2][d] * gL;
#pragma unroll
        for (int kk = 0; kk < NKK; ++kk) { bf16x8 bv[4];
#pragma unroll
            for (int d = 0; d < 4; ++d) bv[d] = frag_tr(vs, 72, 32 * kk, 16 * d, lane);
#pragma unroll
            for (int a2 = 0; a2 < 2; ++a2) { const bf16x8 av = frag_tr(ks, 264, 32 * kk, 32 * wave + 16 * a2, lane);
#pragma unroll
                for (int d = 0; d < 4; ++d) R[a2][d] = MFMA16(av, bv[d], R[a2][d]); } }
        __syncthreads();
#pragma unroll
        for (int a2 = 0; a2 < 2; ++a2)
#pragma unroll
            for (int d = 0; d < 4; ++d) { u32x2 w; w.x = pk2(R[a2][d][0], R[a2][d][1]); w.y = pk2(R[a2][d][2], R[a2][d][3]);
                *(LAS u32x2*)(rts + (16 * d + i) * 264 + 32 * wave + 16 * a2 + 4 * g4) = w; }
        if (vthr) *(u32x4*)(OB + (size_t)(grow0 + n * L + (tid >> 3)) * 4096 + h * 512 + slice * 64 + (tid & 7) * 8) = *(const LAS u32x4*)(os + (tid >> 3) * 72 + (tid & 7) * 8);
        if (n + 1 < nblk) RET_LSTORE();
        __syncthreads();
    }
#pragma unroll
    for (int a2 = 0; a2 < 2; ++a2)
#pragma unroll
        for (int d = 0; d < 4; ++d)
#pragma unroll
            for (int e = 0; e < 4; ++e) Sout[(size_t)(32 * wave + 16 * a2 + 4 * g4 + e) * 512 + slice * 64 + 16 * d + i] = R[a2][d][e] * gLm1;
#undef RET_GLOAD
#undef RET_LSTORE
}
__device__ __forceinline__ void ret_phase(const Args& a, LAS unsigned char* lds, int wave, int lane) {
    const bf16* QH = (const bf16*)(a.ws + WS_R1); const bf16* KH = QH + (size_t)MT * DM; const bf16* VB = (const bf16*)(a.ws + WS_R1 + 72 * MiB); bf16* OB = (bf16*)(a.ws + WS_YP);
    float* sp = a.out + (size_t)MT * DM; float* ss = sp + (size_t)4 * 8 * 256 * 512;
    for (int item = blockIdx.x; item < 256; item += gridDim.x) {
        const int x = item & 7, j = item >> 3, bh = x * 4 + (j >> 3), slice = j & 7, b = bh >> 3, h = bh & 7;
        ret_run<64>(lds, QH, KH, VB, OB, b * 2048, 32, h, slice, nullptr, sp + (size_t)bh * 256 * 512, wave, lane);
    }
    for (int pair = blockIdx.x; pair < 256; pair += gridDim.x) {
        const int b = pair >> 3, h = pair & 7;
        for (int slice = 0; slice < 8; ++slice)
            ret_run<32>(lds, QH, KH, VB, OB, MP + b * 32, 1, h, slice, a.in[2] + (size_t)pair * 256 * 512, ss + (size_t)pair * 256 * 512, wave, lane);
    }
}
__device__ __forceinline__ void gn_gate(const Args& a, int gw, int NGW, int lane) {
    const bf16* O = (const bf16*)(a.ws + WS_YP); bf16* GS = (bf16*)(a.ws + WS_R1 + 144 * MiB);
    for (int p = gw; p < MT * 8; p += NGW) {
        const size_t off = (size_t)(p >> 3) * 4096 + (p & 7) * 512 + 8 * lane;
        const u32x4 ow = *(const u32x4*)(O + off), gwv = *(const u32x4*)(GS + off);
        float o[8] = {bf_lo(ow.x), bf_hi(ow.x), bf_lo(ow.y), bf_hi(ow.y), bf_lo(ow.z), bf_hi(ow.z), bf_lo(ow.w), bf_hi(ow.w)};
        const float g[8] = {bf_lo(gwv.x), bf_hi(gwv.x), bf_lo(gwv.y), bf_hi(gwv.y), bf_lo(gwv.z), bf_hi(gwv.z), bf_lo(gwv.w), bf_hi(gwv.w)};
        float s = 0.f;
#pragma unroll
        for (int e = 0; e < 8; ++e) s += o[e];
        const float mean = wave_sum(s) * (1.f / 512.f); float q = 0.f;
#pragma unroll
        for (int e = 0; e < 8; ++e) { o[e] -= mean; q += o[e] * o[e]; }
        const float rstd = 1.0f / sqrtf(wave_sum(q) * (1.f / 512.f) + GN_EPS);
        u32x4 w; w.x = pk2(g[0] * o[0] * rstd, g[1] * o[1] * rstd); w.y = pk2(g[2] * o[2] * rstd, g[3] * o[3] * rstd); w.z = pk2(g[4] * o[4] * rstd, g[5] * o[5] * rstd); w.w = pk2(g[6] * o[6] * rstd, g[7] * o[7] * rstd);
        *(u32x4*)(GS + off) = w;
    }
}


#ifndef DBG_STOP
#define DBG_STOP 0
#endif
__device__ __forceinline__ void dbg_dump(const Args& a, const bf16* src, size_t n_el) {
    const size_t T = (size_t)gridDim.x * 512, t = (size_t)blockIdx.x * 512 + threadIdx.x, total = 58720256;
    for (size_t i = t; i < total; i += T) { float v = 0.f; if (i < n_el / 2) { const unsigned w = ((const unsigned*)src)[i]; v = bf_lo(w) + bf_hi(w); } a.out[i] = v; }
}
__device__ __forceinline__ void dbg_dump_f32(const Args& a, const float* src, size_t n_el) {
    const size_t T = (size_t)gridDim.x * 512, t = (size_t)blockIdx.x * 512 + threadIdx.x, total = 58720256;
    for (size_t i = t; i < total; i += T) a.out[i] = i < n_el ? src[i] : 0.f;
}
#define XB_TMO      128
#define XB_XCNT(j)  (256  + 64 * (j))
#define XB_XSUB(j)  (1280 + 64 * (j))
#define XB_XGEN(j)  (2304 + 64 * (j))
#define XB_TOP      3328
#define XB_TOPGEN   3392
#define XCD_BAR_WORDS 3456
#define XB_SPIN_CAP (1u << 18)

__device__ __forceinline__ unsigned xb_ld(unsigned* p)              { return __hip_atomic_load(p, __ATOMIC_RELAXED, __HIP_MEMORY_SCOPE_AGENT); }
__device__ __forceinline__ unsigned xb_add(unsigned* p, unsigned v) { return __hip_atomic_fetch_add(p, v, __ATOMIC_RELAXED, __HIP_MEMORY_SCOPE_AGENT); }
__device__ __forceinline__ unsigned xb_xcc_id() { return (unsigned)__builtin_amdgcn_s_getreg((3 << 11) | 20) & 0xFu; }
#define XB_SPIN(cond, bar) do { unsigned _sp = 0; while (cond) { __builtin_amdgcn_s_sleep(1); \
    if ((++_sp & 255u) == 0u) { if (xb_ld(&(bar)[XB_TMO])) break; if (_sp > XB_SPIN_CAP) { atomicAdd(&(bar)[XB_TMO], 1u); break; } } } } while (0)

struct XcdBarrier {
    unsigned* bar; unsigned x;
    volatile LAS unsigned* st;
};

__device__ __forceinline__ XcdBarrier xcd_barrier_post(unsigned* bar, volatile LAS unsigned* st) {
    XcdBarrier b; b.bar = bar; b.x = xb_xcc_id(); b.st = st;
    if (threadIdx.x == 0) (void)xb_add(&bar[XB_XCNT(b.x)], 1u);
    return b;
}
__device__ __forceinline__ void xcd_barrier_complete(unsigned* bar, unsigned x, unsigned& nloc, unsigned& nx) {
    const unsigned G = gridDim.x * gridDim.y * gridDim.z;
    unsigned sum, cnt, mine, sp = 0u;
    for (;;) {
        sum = 0u; cnt = 0u; mine = 0u;
#pragma unroll
        for (unsigned j = 0; j < 16; ++j) { const unsigned c = xb_ld(&bar[XB_XCNT(j)]); sum += c; cnt += (c > 0u) ? 1u : 0u; mine = (j == x) ? c : mine; }
        if (sum == G) break;
        __builtin_amdgcn_s_sleep(1);
        if ((++sp & 255u) == 0u) { if (xb_ld(&bar[XB_TMO])) break; if (sp > XB_SPIN_CAP) { atomicAdd(&bar[XB_TMO], 1u); break; } }
    }
    nloc = mine > 0u ? mine : 1u; nx = cnt > 0u ? cnt : 1u;
}

__device__ __forceinline__ void xcd_barrier(const XcdBarrier& b) {
    asm volatile("s_waitcnt vmcnt(0)" ::: "memory");
    __syncthreads();
    if (threadIdx.x == 0) {
        unsigned* bar = b.bar;
        __builtin_amdgcn_s_waitcnt(0);
        unsigned nloc = b.st[0], nx = b.st[1];
        if (nloc == 0u) { xcd_barrier_complete(bar, b.x, nloc, nx); b.st[0] = nloc; b.st[1] = nx; }
        const unsigned old = xb_add(&bar[XB_XSUB(b.x)], 1u);
        const unsigned gen = old / nloc;
        if (old + 1u == (gen + 1u) * nloc) {
            __builtin_amdgcn_fence(__ATOMIC_RELEASE, "agent");
            asm volatile("s_waitcnt vmcnt(0)" ::: "memory");
            const unsigned og = xb_add(&bar[XB_TOP], 1u);
            const unsigned tg = og / nx;
            if (og + 1u == (tg + 1u) * nx) xb_add(&bar[XB_TOPGEN], 1u);
            else XB_SPIN(xb_ld(&bar[XB_TOPGEN]) == tg, bar);
            __builtin_amdgcn_fence(__ATOMIC_ACQUIRE, "agent");
            xb_add(&bar[XB_XGEN(b.x)], 1u);
            asm volatile("s_waitcnt vmcnt(0)" ::: "memory");
        } else {
            XB_SPIN(xb_ld(&bar[XB_XGEN(b.x)]) == gen, bar);
            __builtin_amdgcn_fence(__ATOMIC_ACQUIRE, "agent");
            asm volatile("s_waitcnt vmcnt(0)" ::: "memory");
        }
    }
    __syncthreads();
}

__global__ void __launch_bounds__(512, 2) fwd(Args a) {
    extern __shared__ __attribute__((aligned(16))) unsigned char lds_raw[];
    cg::grid_group grid = cg::this_grid();
    LAS unsigned char* lds = (LAS unsigned char*)lds_raw;
    const int tid = threadIdx.x, lane = tid & 63, wave = __builtin_amdgcn_readfirstlane(tid >> 6);
    const int G = gridDim.x, c = blockIdx.x, vcu = (G % 8 == 0) ? (c % 8) * (G / 8) + c / 8 : c, gw = vcu * NW + wave, NGW = G * NW;
    unsigned char* ws = a.ws;
    { volatile LAS unsigned* misc = (volatile LAS unsigned*)(lds + MISC_OFF); if (tid < 32) misc[tid] = 0u; }
    __syncthreads();
    XcdBarrier bar = xcd_barrier_post((unsigned*)(ws + WS_CTL), (volatile LAS unsigned*)(lds + MISC_OFF) + 8);
    bf16* XB = (bf16*)(ws + WS_XB); float* YP = (float*)(ws + WS_YP);
    bf16* R1 = (bf16*)(ws + WS_R1);
#define GEMM(EPI, E, Ap, Bp, LD, M1, N, K, SPLIT, CLIST) do { pg8::Gemm g_{(const pg8::bf16_t*)(Ap), (const pg8::bf16_t*)(Bp), (LD)}; pg8::Order S_; S_.init((M1), (N), (K), (SPLIT), G, c); \
        pg8::gemm_phase<EPI, pg8::Order, true, true>(lds, g_, S_, E); if (DBL_GEMM) pg8::gemm_phase<EPI, pg8::Order, true, true>(lds, g_, S_, E); \
        if ((CLIST) > 0) { const int nbusy_ = S_.so.nwg % G;   \
            if (nbusy_ == 0) convert_list(a, lds, (CLIST), gw, NGW, wave, lane); else if (c >= nbusy_) convert_list(a, lds, (CLIST), (c - nbusy_) * NW + wave, (G - nbusy_) * NW, wave, lane); } } while (0)

#define GRID_SYNC() do { asm volatile("s_waitcnt vmcnt(0) lgkmcnt(0)" ::: "memory"); grid.sync(); } while (0)
#define XCD_SYNC() xcd_barrier(bar)

#define DBG_DUMP_1 dbg_dump(a, XB, (size_t)MT * DM)
#define DBG_DUMP_2 dbg_dump(a, R1, (size_t)2 * MT * DM)
#define DBG_DUMP_3 dbg_dump(a, R1 + (size_t)2 * MT * DM, (size_t)MT * DM)
#define DBG_DUMP_4 dbg_dump_f32(a, YP, (size_t)2 * MP * DM)
#define DBG_DUMP_5 dbg_dump(a, XB, (size_t)MT * DM)
#define DBG_DUMP_6 dbg_dump(a, R1, (size_t)MT * FF)
#define DBG_DUMP_7 dbg_dump_f32(a, YP, (size_t)2 * MP * DM)
#define DBG_DUMP_8 dbg_dump(a, XB, (size_t)MT * DM)
#define DBG_DUMP_9 dbg_dump(a, R1, (size_t)6 * MT * DM)
#define DBG_DUMP_10 dbg_dump(a, (const bf16*)YP, (size_t)2 * MT * DM)
#define DBG_DUMP_11 dbg_dump(a, R1 + (size_t)4 * MT * DM, (size_t)2 * MT * DM)
#define DBG_DUMP_12 dbg_dump_f32(a, YP, (size_t)2 * MP * DM)
#define DBG_DUMP_13 dbg_dump(a, XB, (size_t)MT * DM)
#define DBG_DUMP_14 dbg_dump(a, R1, (size_t)MT * FF)
#define DBG_DUMP_15 dbg_dump_f32(a, YP, (size_t)2 * MP * DM)
    p0_prologue(a, lds, gw, NGW, wave, lane);
    if (a.out == nullptr) GRID_SYNC();
    XCD_SYNC();
    if (DBG_STOP == 1) { DBG_DUMP_1; return; }
    { pg8::EpiGeluUV E{R1, R1 + (size_t)MT * DM, (pg8::f32x2*)(ws + WS_STAT)}; GEMM(pg8::EpiGeluUV, E, XB, ws + WS_WAIN, 2048, MT, 4096, 2048, 0, 1); }
    XCD_SYNC();
    if (DBG_STOP == 2) { DBG_DUMP_2; return; }
    mix_phase(a, lds, wave, lane);
    XCD_SYNC();
    if (DBG_STOP == 3) { DBG_DUMP_3; return; }
    { pg8::EpiPart E{YP}; GEMM(pg8::EpiPart, E, ws + WS_R1 + 72 * MiB, ws + WS_WAOUT, 2048, MP, 2048, 2048, 1, 0); }
    XCD_SYNC();
    if (DBG_STOP == 4) { DBG_DUMP_4; return; }
    ln_pass(a.in[0], a.in[1], nullptr, YP, a.in[13], a.in[14], nullptr, XB, gw, NGW, lane);
    XCD_SYNC();
    if (DBG_STOP == 5) { DBG_DUMP_5; return; }
    { pg8::EpiSwiglu E{R1}; GEMM(pg8::EpiSwiglu, E, XB, ws + WS_WFIN, 2048, MT, 11264, 2048, 0, 2); }
    XCD_SYNC();
    if (DBG_STOP == 6) { DBG_DUMP_6; return; }
    { pg8::EpiPart E{YP}; GEMM(pg8::EpiPart, E, R1, ws + WS_WFOUT, 5632, MP, 2048, 5632, 1, 0); }
    XCD_SYNC();
    if (DBG_STOP == 7) { DBG_DUMP_7; return; }
    ln_pass(nullptr, nullptr, XB, YP, a.in[15], a.in[16], nullptr, XB, gw, NGW, lane);
    XCD_SYNC();
    if (DBG_STOP == 8) { DBG_DUMP_8; return; }
    { pg8::EpiQKVG E{R1, R1 + (size_t)MT * DM, (pg8::bf16_t*)(ws + WS_R1 + 72 * MiB), (pg8::bf16_t*)(ws + WS_R1 + 144 * MiB), (const float*)(ws + WS_ROPE), (const float*)(ws + WS_ROPE) + 2080 * 128};
      GEMM(pg8::EpiQKVG, E, XB, ws + WS_WBIN, 2048, MT, 12288, 2048, 0, 3); }
    XCD_SYNC();
    if (DBG_STOP == 9) { DBG_DUMP_9; return; }
    ret_phase(a, lds, wave, lane);
    XCD_SYNC();
    if (DBG_STOP == 10) { DBG_DUMP_10; return; }
    gn_gate(a, gw, NGW, lane);
    XCD_SYNC();
    if (DBG_STOP == 11) { DBG_DUMP_11; return; }
    { pg8::EpiPart E{YP}; GEMM(pg8::EpiPart, E, ws + WS_R1 + 144 * MiB, ws + WS_WBOUT, 4096, MP, 2048, 4096, 1, 0); }
    XCD_SYNC();
    if (DBG_STOP == 12) { DBG_DUMP_12; return; }
    ln_pass(nullptr, nullptr, XB, YP, a.in[13] + DM, a.in[14] + DM, nullptr, XB, gw, NGW, lane);
    XCD_SYNC();
    if (DBG_STOP == 13) { DBG_DUMP_13; return; }
    { pg8::EpiSwiglu E{R1}; GEMM(pg8::EpiSwiglu, E, XB, ws + WS_WFIN + 44 * MiB, 2048, MT, 11264, 2048, 0, 0); }
    XCD_SYNC();
    if (DBG_STOP == 14) { DBG_DUMP_14; return; }
    { pg8::EpiPart E{YP}; GEMM(pg8::EpiPart, E, R1, ws + WS_WFOUT + 22 * MiB, 5632, MP, 2048, 5632, 1, 0); }
    XCD_SYNC();
    if (DBG_STOP == 15) { DBG_DUMP_15; return; }
    ln_pass(nullptr, nullptr, XB, YP, a.in[15] + DM, a.in[16] + DM, a.out, nullptr, gw, NGW, lane);
#undef GEMM
}

extern "C" void kernel_launch(void* const* d_in, const int* in_sizes, int n_in, void* d_out, int out_size, void* d_ws, size_t ws_size, hipStream_t stream) {
    static int grid = 0;
    if (grid == 0) {
        if (n_in != 17 || ws_size < WS_END) { fprintf(stderr, "kernel_launch: needs 17 inputs and >= %zu bytes of workspace (got %d, %zu)\n", (size_t)WS_END, n_in, ws_size); grid = -1; return; }
        int dev = 0, cus = 0, per_cu = 0;
        if (hipGetDevice(&dev) != hipSuccess || hipDeviceGetAttribute(&cus, hipDeviceAttributeMultiprocessorCount, dev) != hipSuccess) { grid = -1; return; }
        if (hipFuncSetAttribute((const void*)fwd, hipFuncAttributeMaxDynamicSharedMemorySize, LDS_BYTES) != hipSuccess) { fprintf(stderr, "kernel_launch: hipFuncSetAttribute failed\n"); grid = -1; return; }
        if (hipOccupancyMaxActiveBlocksPerMultiprocessor(&per_cu, (const void*)fwd, NW * 64, LDS_BYTES) != hipSuccess || per_cu < 1) { fprintf(stderr, "kernel_launch: occupancy query reports %d workgroups per CU\n", per_cu); grid = -1; return; }
        grid = cus;
    }
    if (grid < 0) return;
    if (hipMemsetAsync((char*)d_ws + WS_CTL, 0, CTL_BYTES, stream) != hipSuccess) { fprintf(stderr, "kernel_launch: hipMemsetAsync failed\n"); return; }
    Args a{};
    for (int i = 0; i < 17; ++i) a.in[i] = (const float*)d_in[i];
    a.out = (float*)d_out; a.ws = (unsigned char*)d_ws;
    void* args[] = {&a};
    const hipError_t e = hipLaunchCooperativeKernel((const void*)fwd, dim3(grid), dim3(NW * 64), args, LDS_BYTES, stream);
    if (e != hipSuccess) fprintf(stderr, "kernel_launch: cooperative launch failed: %s (grid %d)\n", hipGetErrorString(e), grid);
}
```

```cpp
#ifndef DBL_GEMM
#define DBL_GEMM 0
#endif
#include <hip/hip_runtime.h>
#include <hip/hip_cooperative_groups.h>
#include <cstdio>
#include <cstdint>
namespace cg = cooperative_groups;

constexpr int DM = 2048, MP = 8192, MS = 1024, MT = MP + MS, FF = 5632, NQKVG = 12288, RV = 4096;
constexpr float ALPHA = 1.41421356237309515f;
constexpr float LN_EPS = 1e-5f, GN_EPS = 1e-6f;

namespace pg8 {
#define PG8_LAS __attribute__((address_space(3)))
typedef unsigned short bf16_t;
typedef short bf16x8 __attribute__((ext_vector_type(8)));
typedef float f32x4 __attribute__((ext_vector_type(4)));
typedef unsigned u32x4 __attribute__((ext_vector_type(4)));
constexpr int BM = 256, BK = 64, HALF = 128, HTB = HALF * BK * 2  , STAGE_BYTES = 8 * HTB, NXCD = 8, WGM = 8;

__host__ __device__ __forceinline__ int lds_byte(int r, int c) { const int st = (r >> 4) * 2 + (c >> 5), rr = r & 15, cc = c & 31, ob = rr * 64 + cc * 2; return st * 1024 + (ob ^ (((ob >> 9) & 1) << 5)); }
__host__ __device__ __forceinline__ void stage_rc(int b, int& R, int& C) { const int st = b / 1024, sb = b % 1024, swz = sb ^ (((sb >> 9) & 1) << 5); R = (st >> 1) * 16 + swz / 64; C = (st & 1) * 32 + (swz % 64) / 2; }
__host__ __device__ __forceinline__ int perm32(int rho) { const int n = rho >> 4, i = rho & 15; return 8 * (i >> 2) + 4 * n + (i & 3); }

struct Unit { int pm, pn, k0, nt, ks; };
struct Gemm { const bf16_t* A; const bf16_t* Bt; int ld; };

struct StaticOrder {
    int nM, nN, nwg, G, c;
    __host__ __device__ void init(int M, int N, int G_, int c_) { nM = M / BM; nN = N / BM; nwg = nM * nN; G = G_; c = c_; }
    __host__ __device__ __forceinline__ void tile(int L, int& pm_, int& pn_) const {
        int wgid = L; { const int q = nwg / NXCD, r = nwg % NXCD, xcd = wgid % NXCD, off = wgid / NXCD; wgid = (xcd < r ? xcd * (q + 1) : r * (q + 1) + (xcd - r) * q) + off; }
        const int nig = WGM * nN, gid = wgid / nig, fm = gid * WGM, gsz = (nM - fm) < WGM ? (nM - fm) : WGM;
        pm_ = fm + ((wgid % nig) % gsz); pn_ = (wgid % nig) / gsz;
    }
    __device__ __forceinline__ void a_ready(const Unit&) const {}
    __device__ __forceinline__ void done(const Unit&) const {}
};

typedef float f32x2_cv __attribute__((ext_vector_type(2))); typedef __bf16 bf16x2_cv __attribute__((ext_vector_type(2)));
__device__ __forceinline__ unsigned cvt_pk_bf16(float lo, float hi) { const f32x2_cv v = {lo, hi}; const bf16x2_cv b = __builtin_convertvector(v, bf16x2_cv); return __builtin_bit_cast(unsigned, b); }
typedef float f32x2 __attribute__((ext_vector_type(2)));
__device__ __forceinline__ f32x2 gelu_pk(f32x2 v) {
    const f32x2 av = __builtin_elementwise_abs(v), d = av * 0.2316418882f + 1.0f;
    f32x2 t; t.x = __builtin_amdgcn_rcpf(d.x); t.y = __builtin_amdgcn_rcpf(d.y);
    f32x2 q = t * 0.5307027145f + (-0.7265760135f); q = q * t + 0.7107068705f; q = q * t + (-0.142248368f); q = q * t + 0.127414796f; q = q * t;
    const f32x2 s = (v * v) * (-0.72134752044f);
    f32x2 e; e.x = __builtin_amdgcn_exp2f(s.x); e.y = __builtin_amdgcn_exp2f(s.y);
    const f32x2 m = v * (q * e), r = v - m;
    f32x2 o; o.x = v.x < 0.f ? m.x : r.x; o.y = v.y < 0.f ? m.y : r.y; return o;
}
struct Order {
    StaticOrder so; int G, c, n1c, ntk, split;
    __device__ __forceinline__ void init(int M1, int N, int K, int split_, int G_, int c_) { so.init(M1, N, G_, c_); G = G_; c = c_; ntk = K / BK; split = split_; n1c = (c < so.nwg) ? (so.nwg - c + G - 1) / G : 0; }
    __device__ __forceinline__ bool next(int i, Unit& u) const {
        const bool p1 = i < n1c; int pm1, pn1; so.tile(p1 ? i * G + c : 0, pm1, pn1);
        const int j = (i - n1c) * G + c; const bool p2 = !p1 && split != 0 && j < 256;
        const int ks = j & 7, jj = (j >> 3) & 31, b = (ntk >> 3) & ~1, rem2 = (ntk - 8 * b) >> 1;
        Unit r; r.pm = p1 ? pm1 : so.nM + (jj & 3); r.pn = p1 ? pn1 : (jj >> 2); r.k0 = p1 ? 0 : (ks * b + 2 * (ks < rem2 ? ks : rem2)) * BK; r.nt = p1 ? ntk : b + (ks < rem2 ? 2 : 0); r.ks = p1 ? -1 : ks;
        u = r; return p1 || p2;
    }
    __device__ __forceinline__ void a_ready(const Unit&) const {}
    __device__ __forceinline__ void done(const Unit&) const {}
};

__device__ __forceinline__ float silu_f(float x) { return x * __builtin_amdgcn_rcpf(1.0f + __builtin_amdgcn_exp2f(-1.4426950408889634f * x)); }

struct EpiPart {
    static constexpr bool PERM = false, AFTER_DRAIN = false;
    float* Y;
    __device__ __forceinline__ void operator()(const f32x4 (&acc)[2][2][4][2], const Unit& u, int wr, int wc, int fr, int fq) const {
        const int row0 = u.pm * BM + wr * 64 + fr + (u.ks > 0 ? u.ks * 1024 : 0), col0 = u.pn * BM + wc * 32 + 4 * fq;
#pragma unroll
        for (int ai = 0; ai < 2; ++ai)
#pragma unroll
            for (int m = 0; m < 4; ++m) { float* rowp = Y + (size_t)(row0 + ai * HALF + m * 16) * 2048 + col0;
#pragma unroll
                for (int bj = 0; bj < 2; ++bj)
#pragma unroll
                    for (int n = 0; n < 2; ++n) *(f32x4*)(rowp + bj * HALF + n * 16) = acc[ai][bj][m][n]; }
    }
};
struct EpiGeluUV {
    static constexpr bool PERM = true, AFTER_DRAIN = false;
    bf16_t* U; bf16_t* V; f32x2* stat;
    __device__ __forceinline__ void operator()(const f32x4 (&acc)[2][2][4][2], const Unit& u, int wr, int wc, int fr, int fq) const {
        const bool isv = u.pn >= 8; bf16_t* O = isv ? V : U;
        const int row0 = u.pm * BM + wr * 64 + fr, col0 = (u.pn & 7) * BM + wc * 32 + 8 * fq;
#pragma unroll
        for (int ai = 0; ai < 2; ++ai)
#pragma unroll
            for (int m = 0; m < 4; ++m) { const int row = row0 + ai * HALF + m * 16; bf16_t* rowp = O + (size_t)row * 2048 + col0; float s = 0.f, q = 0.f;
#pragma unroll
                for (int bj = 0; bj < 2; ++bj) { const f32x4 v0 = acc[ai][bj][m][0], v1 = acc[ai][bj][m][1];
                    const f32x2 a = gelu_pk((f32x2){v0[0], v0[1]}), b = gelu_pk((f32x2){v0[2], v0[3]}), c = gelu_pk((f32x2){v1[0], v1[1]}), d = gelu_pk((f32x2){v1[2], v1[3]});
                    s += ((a.x + a.y) + (b.x + b.y)) + ((c.x + c.y) + (d.x + d.y));
                    q += ((a.x * a.x + a.y * a.y) + (b.x * b.x + b.y * b.y)) + ((c.x * c.x + c.y * c.y) + (d.x * d.x + d.y * d.y));
                    u32x4 w; w.x = cvt_pk_bf16(a.x, a.y); w.y = cvt_pk_bf16(b.x, b.y); w.z = cvt_pk_bf16(c.x, c.y); w.w = cvt_pk_bf16(d.x, d.y);
                    *(u32x4*)(rowp + bj * HALF) = w; }
                if (isv) { s += __shfl_xor(s, 16); s += __shfl_xor(s, 32); q += __shfl_xor(q, 16); q += __shfl_xor(q, 32);
                    if (fq == 0) stat[(size_t)row * 32 + (u.pn - 8) * 4 + wc] = (f32x2){s, q}; } }
    }
};
struct EpiSwiglu {
    static constexpr bool PERM = true, AFTER_DRAIN = false;
    bf16_t* H;
    __device__ __forceinline__ void operator()(const f32x4 (&acc)[2][2][4][2], const Unit& u, int wr, int wc, int fr, int fq) const {
        const int row0 = u.pm * BM + wr * 64 + fr, col0 = u.pn * HALF + wc * 32 + 8 * fq;
#pragma unroll
        for (int ai = 0; ai < 2; ++ai)
#pragma unroll
            for (int m = 0; m < 4; ++m) { bf16_t* rowp = H + (size_t)(row0 + ai * HALF + m * 16) * 5632 + col0;
                const f32x4 g0 = acc[ai][0][m][0], g1 = acc[ai][0][m][1], u0 = acc[ai][1][m][0], u1 = acc[ai][1][m][1];
                u32x4 w; w.x = cvt_pk_bf16(silu_f(g0[0]) * u0[0], silu_f(g0[1]) * u0[1]); w.y = cvt_pk_bf16(silu_f(g0[2]) * u0[2], silu_f(g0[3]) * u0[3]);
                w.z = cvt_pk_bf16(silu_f(g1[0]) * u1[0], silu_f(g1[1]) * u1[1]); w.w = cvt_pk_bf16(silu_f(g1[2]) * u1[2], silu_f(g1[3]) * u1[3]);
                *(u32x4*)rowp = w; }
    }
};
__device__ __forceinline__ float lg2gamma(int h) {
    const double x = 1.0 / (double)(32 << h); double p = x, s = 0.0;
    const double inv[8] = {1.0, 0.5, 1.0 / 3.0, 0.25, 0.2, 1.0 / 6.0, 1.0 / 7.0, 0.125};
#pragma unroll
    for (int k = 0; k < 8; ++k) { s -= p * inv[k]; p *= x; }
    return (float)(s * 1.4426950408889634);
}
struct EpiQKVG {
    static constexpr bool PERM = true, AFTER_DRAIN = false;
    bf16_t *QH, *KH, *VB, *GS; const float* ropec; const float* ropes;
    __device__ __forceinline__ void operator()(const f32x4 (&acc)[2][2][4][2], const Unit& u, int wr, int wc, int fr, int fq) const {
        const int row0 = u.pm * BM + wr * 64 + fr, cw = wc * 32 + 8 * fq;
        if (u.pn < 16) {
            const bool isq = u.pn < 8; const int head = u.pn & 7; bf16_t* O = (isq ? QH : KH) + head * 256 + cw;
            const float lg = lg2gamma(head) * (isq ? 1.f : -1.f), sc0 = isq ? 0.0625f : 1.f;
#pragma unroll
            for (int ai = 0; ai < 2; ++ai)
#pragma unroll
                for (int m = 0; m < 4; ++m) { const int row = row0 + ai * HALF + m * 16;
                    const int pidx = row < MP ? (row & 2047) : 2048 + ((row - MP) & 31), ib = row < MP ? (row & 63) : ((row - MP) & 31);
                    const float sc = sc0 * __builtin_amdgcn_exp2f(lg * (float)ib);
                    const f32x4 c0 = *(const f32x4*)(ropec + pidx * 128 + cw), c1 = *(const f32x4*)(ropec + pidx * 128 + cw + 4);
                    const f32x4 s0 = *(const f32x4*)(ropes + pidx * 128 + cw), s1 = *(const f32x4*)(ropes + pidx * 128 + cw + 4);
                    const f32x4 a0 = acc[ai][0][m][0], a1 = acc[ai][0][m][1], b0 = acc[ai][1][m][0], b1 = acc[ai][1][m][1];
                    const f32x4 o0 = (a0 * c0 - b0 * s0) * sc, o1 = (a1 * c1 - b1 * s1) * sc, p0 = (a0 * s0 + b0 * c0) * sc, p1 = (a1 * s1 + b1 * c1) * sc;
                    u32x4 w; w.x = cvt_pk_bf16(o0[0], o0[1]); w.y = cvt_pk_bf16(o0[2], o0[3]); w.z = cvt_pk_bf16(o1[0], o1[1]); w.w = cvt_pk_bf16(o1[2], o1[3]);
                    *(u32x4*)(O + (size_t)row * 2048) = w;
                    w.x = cvt_pk_bf16(p0[0], p0[1]); w.y = cvt_pk_bf16(p0[2], p0[3]); w.z = cvt_pk_bf16(p1[0], p1[1]); w.w = cvt_pk_bf16(p1[2], p1[3]);
                    *(u32x4*)(O + (size_t)row * 2048 + HALF) = w; }
        } else {
            const bool isg = u.pn >= 32; bf16_t* O = (isg ? GS : VB) + ((u.pn - 16) & 15) * BM + cw;
#pragma unroll
            for (int ai = 0; ai < 2; ++ai)
#pragma unroll
                for (int m = 0; m < 4; ++m) { bf16_t* rowp = O + (size_t)(row0 + ai * HALF + m * 16) * 4096;
#pragma unroll
                    for (int bj = 0; bj < 2; ++bj) { f32x4 v0 = acc[ai][bj][m][0], v1 = acc[ai][bj][m][1];
                        if (isg) { v0 = (f32x4){silu_f(v0[0]), silu_f(v0[1]), silu_f(v0[2]), silu_f(v0[3])}; v1 = (f32x4){silu_f(v1[0]), silu_f(v1[1]), silu_f(v1[2]), silu_f(v1[3])}; }
                        u32x4 w; w.x = cvt_pk_bf16(v0[0], v0[1]); w.y = cvt_pk_bf16(v0[2], v0[3]); w.z = cvt_pk_bf16(v1[0], v1[1]); w.w = cvt_pk_bf16(v1[2], v1[3]);
                        *(u32x4*)(rowp + bj * HALF) = w; } }
        }
    }
};
template <class Epi, class Sched, bool ALIGN_EPI = false, bool SP2 = false>
__device__ __forceinline__ void gemm_phase(PG8_LAS unsigned char* lds, const Gemm g, const Sched& S, const Epi& E) {
    int tid_ = threadIdx.x; asm volatile("" : "+v"(tid_));
    const int tid = tid_, wid = __builtin_amdgcn_readfirstlane(tid >> 6), lane = tid & 63, wr = wid >> 2, wc = wid & 3, fr = lane & 15, fq = lane >> 4;
    const int K = g.ld;
    unsigned voffA[2], voffB[2];
#pragma unroll
    for (int i = 0; i < 2; ++i) { int R, C; stage_rc(tid * 16 + i * 8192, R, C); const int Rb = Epi::PERM ? ((R & ~31) + perm32(R & 31)) : R;
        voffA[i] = (unsigned)(R * K + C) * 2u; voffB[i] = (unsigned)(Rb * K + C) * 2u; }
    const size_t kstep = (size_t)(BK * 2);
    const size_t hstep = (size_t)HALF * K * 2;
    const size_t tstep = 2 * hstep;
    const unsigned ldsw = (unsigned)wid * 1024u;
    const int aoff = lds_byte(wr * 64 + fr, fq * 8), boff = lds_byte(wc * 32 + fr, fq * 8);
#define PG8_SA(b, h) (((b) * 2 + (h)) * HTB)
#define PG8_SB(b, h) ((4 + (b) * 2 + (h)) * HTB)
#define PG8_STAGE(bufoff, gbase, voff) do { _Pragma("unroll") for (int _i = 0; _i < 2; ++_i) \
        __builtin_amdgcn_global_load_lds((const unsigned*)((const char*)(gbase) + (voff)[_i]), (PG8_LAS unsigned*)(lds + (bufoff) + ldsw + _i * 8192), 16, 0, 0); } while (0)
#define PG8_LDA(dst, b, h) do { _Pragma("unroll") for (int m = 0; m < 4; ++m) _Pragma("unroll") for (int k = 0; k < 2; ++k) dst[m][k] = *(const PG8_LAS bf16x8*)(lds + PG8_SA(b, h) + aoff + m * 2048 + k * 1024); } while (0)
#define PG8_LDB(dst, b, h) do { _Pragma("unroll") for (int n = 0; n < 2; ++n) _Pragma("unroll") for (int k = 0; k < 2; ++k) dst[n][k] = *(const PG8_LAS bf16x8*)(lds + PG8_SB(b, h) + boff + n * 2048 + k * 1024); } while (0)
#define PG8_MMA(ai, bj, At, Bt) do { __builtin_amdgcn_s_setprio(1); _Pragma("unroll") for (int m = 0; m < 4; ++m) _Pragma("unroll") for (int n = 0; n < 2; ++n) _Pragma("unroll") for (int k = 0; k < 2; ++k) \
        acc[ai][bj][m][n] = __builtin_amdgcn_mfma_f32_16x16x32_bf16(Bt[n][k], At[m][k], acc[ai][bj][m][n], 0, 0, 0); __builtin_amdgcn_s_setprio(0); } while (0)
#define PG8_WAIT_V(n) asm volatile("s_waitcnt vmcnt(" #n ")" ::: "memory")
#define PG8_WAIT_L(n) asm volatile("s_waitcnt lgkmcnt(" #n ")" ::: "memory")
#define PG8_BAR __builtin_amdgcn_s_barrier()
#define PG8_SCHED __builtin_amdgcn_sched_barrier(0)
    Unit cur, nxt; int ui = 0;
    if (!S.next(0, cur)) return;
    f32x4 acc[2][2][4][2];
#pragma unroll
    for (int a = 0; a < 2; ++a)
#pragma unroll
        for (int b = 0; b < 2; ++b)
#pragma unroll
            for (int m = 0; m < 4; ++m)
#pragma unroll
                for (int n = 0; n < 2; ++n) acc[a][b][m][n] = (f32x4){0.f, 0.f, 0.f, 0.f};
    bf16x8 At[4][2], B0[2][2], B1[2][2];
    const char* cA = (const char*)g.A + (size_t)cur.pm * tstep + (size_t)cur.k0 * 2; const char* cB = (const char*)g.Bt + (size_t)cur.pn * tstep + (size_t)cur.k0 * 2; int nt = cur.nt;
    S.a_ready(cur);
    if constexpr (SP2) {
        PG8_STAGE(PG8_SB(0, 0), cB, voffB); PG8_STAGE(PG8_SB(0, 1), cB + hstep, voffB); PG8_STAGE(PG8_SA(0, 0), cA, voffA); PG8_STAGE(PG8_SA(0, 1), cA + hstep, voffA);
        if (wr == 1) PG8_BAR;
        PG8_WAIT_V(2); PG8_BAR;
        PG8_STAGE(PG8_SB(1, 0), cB + kstep, voffB); PG8_STAGE(PG8_SA(1, 0), cA + kstep, voffA); PG8_STAGE(PG8_SB(1, 1), cB + hstep + kstep, voffB);
        PG8_WAIT_V(6); PG8_BAR;
    } else {
        PG8_STAGE(PG8_SB(0, 0), cB, voffB); PG8_STAGE(PG8_SA(0, 0), cA, voffA); PG8_STAGE(PG8_SB(0, 1), cB + hstep, voffB); PG8_STAGE(PG8_SA(0, 1), cA + hstep, voffA);
        if (wr == 1) PG8_BAR;
        PG8_WAIT_V(4); PG8_BAR;
        PG8_STAGE(PG8_SB(1, 0), cB + kstep, voffB); PG8_STAGE(PG8_SA(1, 0), cA + kstep, voffA); PG8_STAGE(PG8_SB(1, 1), cB + hstep + kstep, voffB);
        PG8_WAIT_V(6); PG8_BAR;
    }
    for (;;) {
        const bool has_next = S.next(ui + 1, nxt);
        const char* nA = has_next ? (const char*)g.A + (size_t)nxt.pm * tstep + (size_t)nxt.k0 * 2 : cA; const char* nB = has_next ? (const char*)g.Bt + (size_t)nxt.pn * tstep + (size_t)nxt.k0 * 2 : cB;
        for (int t = 0; t < nt; t += 2) {
            const bool last = (t == nt - 2);
            const char* a1 = cA + (size_t)(t + 1) * kstep;
            const char* a2 = last ? nA : cA + (size_t)(t + 2) * kstep; const char* b2 = last ? nB : cB + (size_t)(t + 2) * kstep;
            const char* a3 = a2 + kstep; const char* b3 = b2 + kstep;
            if (last && has_next) S.a_ready(nxt);
            if constexpr (SP2) {
            PG8_LDB(B0, 0, 0); PG8_LDB(B1, 0, 1); PG8_SCHED; PG8_LDA(At, 0, 0); PG8_STAGE(PG8_SA(1, 1), a1 + hstep, voffA);
            PG8_WAIT_V(8); PG8_WAIT_L(0); PG8_BAR; PG8_MMA(0, 0, At, B0); PG8_MMA(0, 1, At, B1); PG8_BAR; PG8_SCHED;
            PG8_LDA(At, 0, 1); PG8_STAGE(PG8_SB(0, 0), b2, voffB); PG8_STAGE(PG8_SB(0, 1), b2 + hstep, voffB); PG8_STAGE(PG8_SA(0, 0), a2, voffA);
            PG8_WAIT_V(8); PG8_WAIT_L(0); PG8_BAR; PG8_MMA(1, 0, At, B0); PG8_MMA(1, 1, At, B1); PG8_BAR; PG8_SCHED;
            PG8_LDB(B0, 1, 0); PG8_LDB(B1, 1, 1); PG8_SCHED; PG8_LDA(At, 1, 0); PG8_STAGE(PG8_SA(0, 1), a2 + hstep, voffA);
            PG8_WAIT_V(8); PG8_WAIT_L(0); PG8_BAR; PG8_MMA(0, 0, At, B0); PG8_MMA(0, 1, At, B1); PG8_BAR; PG8_SCHED;
            PG8_LDA(At, 1, 1); PG8_STAGE(PG8_SB(1, 0), b3, voffB); PG8_STAGE(PG8_SB(1, 1), b3 + hstep, voffB); PG8_STAGE(PG8_SA(1, 0), a3, voffA);
            PG8_WAIT_V(8); PG8_WAIT_L(0); PG8_BAR; PG8_MMA(1, 0, At, B0); PG8_MMA(1, 1, At, B1); PG8_BAR; PG8_SCHED;
            } else {
            PG8_LDB(B0, 0, 0); PG8_SCHED; PG8_LDA(At, 0, 0); PG8_STAGE(PG8_SA(1, 1), a1 + hstep, voffA);
            PG8_WAIT_L(8); PG8_BAR; PG8_WAIT_L(0); PG8_MMA(0, 0, At, B0); PG8_BAR; PG8_SCHED;
            PG8_LDB(B1, 0, 1); PG8_STAGE(PG8_SB(0, 0), b2, voffB);
            PG8_BAR; PG8_WAIT_L(0); PG8_MMA(0, 1, At, B1); PG8_BAR;
            PG8_LDA(At, 0, 1); PG8_STAGE(PG8_SA(0, 0), a2, voffA);
            PG8_BAR; PG8_WAIT_L(0); PG8_MMA(1, 0, At, B0); PG8_BAR; PG8_SCHED;
            PG8_STAGE(PG8_SB(0, 1), b2 + hstep, voffB);
            PG8_WAIT_V(6); PG8_BAR; PG8_MMA(1, 1, At, B1); PG8_BAR;
            PG8_LDB(B0, 1, 0); PG8_SCHED; PG8_LDA(At, 1, 0); PG8_STAGE(PG8_SA(0, 1), a2 + hstep, voffA);
            PG8_WAIT_L(8); PG8_BAR; PG8_WAIT_L(0); PG8_MMA(0, 0, At, B0); PG8_BAR; PG8_SCHED;
            PG8_LDB(B1, 1, 1); PG8_STAGE(PG8_SB(1, 0), b3, voffB);
            PG8_BAR; PG8_WAIT_L(0); PG8_MMA(0, 1, At, B1); PG8_BAR;
            PG8_LDA(At, 1, 1); PG8_STAGE(PG8_SA(1, 0), a3, voffA);
            PG8_BAR; PG8_WAIT_L(0); PG8_MMA(1, 0, At, B0); PG8_BAR; PG8_SCHED;
            PG8_STAGE(PG8_SB(1, 1), b3 + hstep, voffB);
            PG8_WAIT_V(6); PG8_BAR; PG8_MMA(1, 1, At, B1); PG8_BAR;
            }
        }
        if constexpr (ALIGN_EPI) { if (wr == 0) PG8_BAR; }
        if constexpr (!Epi::AFTER_DRAIN) { E(acc, cur, wr, wc, fr, fq); S.done(cur); }
        if (!has_next) break;
#pragma unroll
        for (int a = 0; a < 2; ++a)
#pragma unroll
            for (int b = 0; b < 2; ++b)
#pragma unroll
                for (int m = 0; m < 4; ++m)
#pragma unroll
                    for (int n = 0; n < 2; ++n) acc[a][b][m][n] = (f32x4){0.f, 0.f, 0.f, 0.f};
        cur = nxt; cA = nA; cB = nB; nt = cur.nt; ++ui;
        if constexpr (ALIGN_EPI) { if (wr == 1) PG8_BAR; }
    }
    PG8_WAIT_V(0);
    if constexpr (!ALIGN_EPI) { if (wr == 0) PG8_BAR; }
    PG8_BAR;
    if constexpr (Epi::AFTER_DRAIN) { E.fused(acc, cur, wr, wc, fr, fq, lds, wid, lane); S.done(cur); }
#undef PG8_SA
#undef PG8_SB
#undef PG8_STAGE
#undef PG8_LDA
#undef PG8_LDB
#undef PG8_MMA
#undef PG8_WAIT_V
#undef PG8_WAIT_L
#undef PG8_BAR
#undef PG8_SCHED
}
}
constexpr size_t MiB = 1u << 20;
constexpr size_t WS_WAIN = 0, WS_WAOUT = 16 * MiB, WS_WBIN = 24 * MiB, WS_WBOUT = 72 * MiB, WS_WFIN = 88 * MiB, WS_WFOUT = 176 * MiB;
constexpr size_t WS_XB = 220 * MiB;
constexpr size_t WS_STAT = 256 * MiB;
constexpr size_t WS_ROPE = 259 * MiB;
constexpr size_t WS_YP = 262 * MiB;
constexpr size_t WS_XF = 390 * MiB;
constexpr size_t WS_R1 = 462 * MiB;
constexpr size_t WS_CTL = 678 * MiB, CTL_BYTES = 16384;
constexpr size_t WS_END = 679 * MiB;
constexpr int MISC_OFF = 131072 + 320;
constexpr int LDS_BYTES = 147456;
constexpr int NW = 8;

#define LAS __attribute__((address_space(3)))
typedef unsigned short bf16;
typedef unsigned u32x4 __attribute__((ext_vector_type(4)));
typedef unsigned u32x2 __attribute__((ext_vector_type(2)));
typedef float f32x4 __attribute__((ext_vector_type(4)));
typedef float f32x2 __attribute__((ext_vector_type(2)));
typedef short bf16x8 __attribute__((ext_vector_type(8)));
typedef short s16x4 __attribute__((ext_vector_type(4)));
#define LDS_WAIT() asm volatile("s_waitcnt lgkmcnt(0)" ::: "memory")
__device__ __forceinline__ unsigned pk2(float lo, float hi) { return pg8::cvt_pk_bf16(lo, hi); }
__device__ __forceinline__ float bf_lo(unsigned w) { return __uint_as_float(w << 16); }
__device__ __forceinline__ float bf_hi(unsigned w) { return __uint_as_float(w & 0xffff0000u); }
__device__ __forceinline__ float wave_sum(float v) {
#pragma unroll
    for (int o = 1; o < 64; o <<= 1) v += __shfl_xor(v, o);
    return v;
}

struct Args { const float* in[17]; float* out; unsigned char* ws; };

template <int MAPMODE>
__device__ __forceinline__ void p0_transpose_item(const float* W, int K, int N, bf16* WT, LAS float* scr, int item, int lane) {
    const int nblk = N / 32, kb = item / nblk, nb = item % nblk, k0 = 64 * kb, n0 = 32 * nb;
#pragma unroll 8
    for (int i = 0; i < 32; ++i) { const int kk = 2 * i + (lane >> 5); scr[kk * 33 + (lane & 31)] = W[(size_t)(k0 + kk) * N + n0 + (lane & 31)]; }
    LDS_WAIT(); asm volatile("" ::: "memory");
    int r0 = n0;
    if (MAPMODE == 1) { const int up = n0 >= FF ? 1 : 0, c = n0 - up * FF; r0 = 256 * (c >> 7) + (c & 127) + 128 * up; }
    const int c8 = lane & 7;
#pragma unroll
    for (int j = 0; j < 4; ++j) { const int n = (lane >> 3) + 8 * j; const LAS float* s = scr + (8 * c8) * 33 + n;
        u32x4 o; o.x = pk2(s[0 * 33], s[1 * 33]); o.y = pk2(s[2 * 33], s[3 * 33]); o.z = pk2(s[4 * 33], s[5 * 33]); o.w = pk2(s[6 * 33], s[7 * 33]);
        *(u32x4*)(WT + (size_t)(r0 + n) * K + k0 + 8 * c8) = o; }
    LDS_WAIT(); asm volatile("" ::: "memory");
}
__device__ __forceinline__ void convert_list(const Args& a, LAS unsigned char* lds, int list, int w, int nw, int wave, int lane) {
    LAS float* scr = (LAS float*)(lds + wave * 16384);
    unsigned char* ws = a.ws;
    constexpr int I0 = 32 * 128, I1 = 32 * 64, I2 = 32 * 384, I3 = 64 * 64, I4 = 32 * 352, I5 = 88 * 64;
    if (list == 0) {
        for (int r = w; r < I0; r += nw) p0_transpose_item<0>(a.in[3], 2048, 4096, (bf16*)(ws + WS_WAIN), scr, r, lane);
    } else if (list == 1) {
        for (int it = w; it < I1 + I4 + I5; it += nw) { int r = it;
            if (r < I1) { p0_transpose_item<0>(a.in[8], 2048, 2048, (bf16*)(ws + WS_WAOUT), scr, r, lane); continue; } r -= I1;
            if (r < I4) { p0_transpose_item<1>(a.in[11], 2048, 11264, (bf16*)(ws + WS_WFIN), scr, r, lane); continue; } r -= I4;
            p0_transpose_item<0>(a.in[12], 5632, 2048, (bf16*)(ws + WS_WFOUT), scr, r, lane); }
    } else if (list == 2) {
        for (int it = w; it < I2 + I3 + I4; it += nw) { int r = it;
            if (r < I2) { p0_transpose_item<0>(a.in[9], 2048, 12288, (bf16*)(ws + WS_WBIN), scr, r, lane); continue; } r -= I2;
            if (r < I3) { p0_transpose_item<0>(a.in[10], 4096, 2048, (bf16*)(ws + WS_WBOUT), scr, r, lane); continue; } r -= I3;
            p0_transpose_item<1>(a.in[11] + (size_t)2048 * 11264, 2048, 11264, (bf16*)(ws + WS_WFIN + 44 * MiB), scr, r, lane); }
    } else {
        for (int r = w; r < I5; r += nw) p0_transpose_item<0>(a.in[12] + (size_t)5632 * 2048, 5632, 2048, (bf16*)(ws + WS_WFOUT + 22 * MiB), scr, r, lane);
    }
}
__device__ __forceinline__ void p0_prologue(const Args& a, LAS unsigned char* lds, int gw, int NGW, int wave, int lane) {
    unsigned char* ws = a.ws;
    convert_list(a, lds, 0, gw, NGW, wave, lane);
    bf16* XB = (bf16*)(ws + WS_XB);
    for (int m = gw; m < MT; m += NGW) {
        const f32x4* xr = (const f32x4*)(m < MP ? a.in[0] + (size_t)m * DM : a.in[1] + (size_t)(m - MP) * DM) + lane;
        u32x2* o = (u32x2*)(XB + (size_t)m * DM) + lane;
#pragma unroll
        for (int j = 0; j < 8; ++j) { const f32x4 v = xr[64 * j]; u32x2 w; w.x = pk2(v[0], v[1]); w.y = pk2(v[2], v[3]); o[64 * j] = w; }
    }
    float* rc = (float*)(ws + WS_ROPE); float* rs = rc + 2080 * 128;
    for (int e = gw * 64 + lane; e < 2080 * 128; e += NGW * 64) {
        const int p = e >> 7, d = e & 127; const float pos = (float)(p < 2048 ? p : 4096 + (p - 2048));
        const float inv = __builtin_amdgcn_exp2f(-(float)d * (13.287712379549449f / 128.0f));
        const double rev = (double)(pos * inv) * 0.15915494309189535; const float fr = (float)(rev - __builtin_floor(rev));
        rc[e] = __builtin_amdgcn_cosf(fr); rs[e] = __builtin_amdgcn_sinf(fr);
    }
}

struct LnIO { const float* xres_p; const float* xres_s; const bf16* xb; const float* YP; const float* g; const float* b; float* outf; bf16* outb; };
__device__ __forceinline__ void ln_load(const LnIO& io, f32x4 (&v)[8], int row, int lane) {
    if (io.xres_p) { const f32x4* xr = (const f32x4*)(row < MP ? io.xres_p + (size_t)row * DM : io.xres_s + (size_t)(row - MP) * DM) + lane;
#pragma unroll
        for (int j = 0; j < 8; ++j) v[j] = xr[64 * j] * ALPHA;
    } else { const u32x2* xr = (const u32x2*)(io.xb + (size_t)row * DM) + lane;
#pragma unroll
        for (int j = 0; j < 8; ++j) { const u32x2 w = xr[64 * j]; v[j] = (f32x4){bf_lo(w.x), bf_hi(w.x), bf_lo(w.y), bf_hi(w.y)} * ALPHA; } }
    if (row < MP) { const f32x4* y = (const f32x4*)(io.YP + (size_t)row * DM) + lane;
#pragma unroll
        for (int j = 0; j < 8; ++j) v[j] += y[64 * j];
    } else {
#pragma unroll 2
        for (int ks = 0; ks < 8; ++ks) { const f32x4* y = (const f32x4*)(io.YP + (size_t)(MP + ks * MS + (row - MP)) * DM) + lane;
#pragma unroll
            for (int j = 0; j < 8; ++j) v[j] += y[64 * j]; }
    }
}
__device__ __forceinline__ void ln_finish(const LnIO& io, f32x4 (&v)[8], int row, int lane) {
    float s = 0.f;
#pragma unroll
    for (int j = 0; j < 8; ++j) s += (v[j][0] + v[j][1]) + (v[j][2] + v[j][3]);
    const float mean = wave_sum(s) * (1.f / DM); float q = 0.f;
#pragma unroll
    for (int j = 0; j < 8; ++j) { v[j] = v[j] - mean; q += (v[j][0] * v[j][0] + v[j][1] * v[j][1]) + (v[j][2] * v[j][2] + v[j][3] * v[j][3]); }
    const float rstd = 1.0f / sqrtf(wave_sum(q) * (1.f / DM) + LN_EPS);
#pragma unroll
    for (int j = 0; j < 8; ++j) { const f32x4 gg = ((const f32x4*)io.g)[lane + 64 * j], bb = ((const f32x4*)io.b)[lane + 64 * j]; const f32x4 o = v[j] * rstd * gg + bb;
        if (io.outf) ((f32x4*)(io.outf + (size_t)row * DM) + lane)[64 * j] = o;
        if (io.outb) { u32x2 w; w.x = pk2(o[0], o[1]); w.y = pk2(o[2], o[3]); ((u32x2*)(io.outb + (size_t)row * DM) + lane)[64 * j] = w; } }
}
__device__ __forceinline__ void ln_pair(const LnIO& io, int r0, int r1, int lane) { f32x4 va[8], vb[8]; ln_load(io, va, r0, lane); ln_load(io, vb, r1, lane); ln_finish(io, va, r0, lane); ln_finish(io, vb, r1, lane); }
__device__ __forceinline__ void ln_one(const LnIO& io, int r0, int lane) { f32x4 va[8]; ln_load(io, va, r0, lane); ln_finish(io, va, r0, lane); }
__device__ __forceinline__ void ln_pass(const float* xres_p, const float* xres_s, const bf16* xb, const float* YP, const float* g, const float* b, float* outf, bf16* outb, int gw, int NGW, int lane) {
    const LnIO io{xres_p, xres_s, xb, YP, g, b, outf, outb};
    if (NGW == 2048) {
        if (gw < 1024) { ln_one(io, MP + gw, lane); ln_pair(io, gw, gw + 1024, lane); }
        else { const int r = 2048 + (gw - 1024); ln_pair(io, r, r + 1024, lane); ln_pair(io, r + 2048, r + 3072, lane); ln_pair(io, r + 4096, r + 5120, lane); }
    } else {
        for (int row = gw; row < MT; row += NGW) ln_one(io, row, lane);
    }
}

__device__ __forceinline__ bf16x8 frag_plain(const LAS bf16* X, int ld, int r0, int k0, int lane) { return *(const LAS bf16x8*)(X + (r0 + (lane & 15)) * ld + k0 + 8 * (lane >> 4)); }
typedef short v4i16_t __attribute__((ext_vector_type(4)));
__device__ __forceinline__ bf16x8 frag_tr(const LAS bf16* Y, int ld, int kr0, int c0, int lane) {
    const int i = lane & 15, g4 = lane >> 4; const LAS bf16* p = Y + (kr0 + 8 * g4 + (i >> 2)) * ld + c0 + 4 * (i & 3);
    const v4i16_t lo = __builtin_amdgcn_ds_read_tr16_b64_v4i16((LAS v4i16_t*)p), hi = __builtin_amdgcn_ds_read_tr16_b64_v4i16((LAS v4i16_t*)(p + 4 * ld));
    return (bf16x8){lo[0], lo[1], lo[2], lo[3], hi[0], hi[1], hi[2], hi[3]};
}
#define MFMA16(a, b, c) __builtin_amdgcn_mfma_f32_16x16x32_bf16((a), (b), (c), 0, 0, 0)

__device__ __forceinline__ void mix_phase(const Args& a, LAS unsigned char* lds, int wave, int lane) {
    const int tid = threadIdx.x;
    LAS bf16* Wm = (LAS bf16*)lds;
    LAS bf16* vn = (LAS bf16*)(lds + 34816);
    LAS f32x2* mr = (LAS f32x2*)(lds + 34816 + 67584);
    const bf16* U = (const bf16*)(a.ws + WS_R1); const bf16* V = U + (size_t)MT * DM; bf16* SB = (bf16*)(a.ws + WS_R1 + 72 * MiB);
    const f32x2* stat = (const f32x2*)(a.ws + WS_STAT);
    const float* lng = a.in[4]; const float* lnb = a.in[5]; const float* aws = a.in[6]; const float* abs_ = a.in[7];
    float* gv = a.out + (size_t)MT * DM + (size_t)(4 + 32) * 8 * 256 * 512;
    for (int item = blockIdx.x; item < 72 * 8; item += gridDim.x) {
        const int rb = item >> 3, g = item & 7, row0 = rb * 128; const bool smp = rb >= 64;
        if (tid < 128) { const f32x2* sp = stat + (size_t)(row0 + tid) * 32; float s = 0.f, q = 0.f;
#pragma unroll 8
            for (int k = 0; k < 32; ++k) { const f32x2 v = sp[k]; s += v.x; q += v.y; }
            const float mean = s * (1.f / 2048.f), var = q * (1.f / 2048.f) - mean * mean; mr[tid] = (f32x2){mean, 1.0f / sqrtf(var + LN_EPS)}; }
        { const int t = tid >> 2, s0 = (tid & 3) * 32; const int tw = smp ? (t & 31) : t;
#pragma unroll
            for (int k = 0; k < 4; ++k) { const int s = s0 + 8 * k; const int sw = smp ? (s & 31) : s;
                const f32x4 w0 = *(const f32x4*)(aws + ((size_t)g * 128 + tw) * 128 + sw), w1 = *(const f32x4*)(aws + ((size_t)g * 128 + tw) * 128 + sw + 4);
                float w[8] = {w0[0], w0[1], w0[2], w0[3], w1[0], w1[1], w1[2], w1[3]};
#pragma unroll
                for (int e = 0; e < 8; ++e) { const int ss = s + e; const bool ok = smp ? ((ss >> 5) == (t >> 5) && (ss & 31) <= (t & 31)) : (ss <= t); w[e] = ok ? w[e] : 0.f; }
                u32x4 o; o.x = pk2(w[0], w[1]); o.y = pk2(w[2], w[3]); o.z = pk2(w[4], w[5]); o.w = pk2(w[6], w[7]);
                *(LAS u32x4*)(Wm + t * 136 + s) = o; } }
        __syncthreads();
        { const int s = tid >> 2, cb = (tid & 3) * 64; const f32x2 m = mr[s]; const bf16* vp = V + (size_t)(row0 + s) * DM + g * 256 + cb;
#pragma unroll
            for (int k = 0; k < 8; ++k) { const u32x4 w = *(const u32x4*)(vp + 8 * k); const int c = g * 256 + cb + 8 * k;
                const f32x4 g0 = *(const f32x4*)(lng + c), g1 = *(const f32x4*)(lng + c + 4), b0 = *(const f32x4*)(lnb + c), b1 = *(const f32x4*)(lnb + c + 4);
                f32x4 x0 = (f32x4){bf_lo(w.x), bf_hi(w.x), bf_lo(w.y), bf_hi(w.y)}, x1 = (f32x4){bf_lo(w.z), bf_hi(w.z), bf_lo(w.w), bf_hi(w.w)};
                x0 = (x0 - m.x) * m.y * g0 + b0; x1 = (x1 - m.x) * m.y * g1 + b1;
                u32x4 o; o.x = pk2(x0[0], x0[1]); o.y = pk2(x0[2], x0[3]); o.z = pk2(x1[0], x1[1]); o.w = pk2(x1[2], x1[3]);
                *(LAS u32x4*)(vn + s * 264 + cb + 8 * k) = o;
                if (smp) { float* op = gv + (size_t)(row0 + s - MP) * DM + c; *(f32x4*)op = x0; *(f32x4*)(op + 4) = x1; } } }
        __syncthreads();
        {
            const int t0 = 16 * wave, i = lane & 15, g4 = lane >> 4; f32x4 acc[16];
#pragma unroll
            for (int ct = 0; ct < 16; ++ct) acc[ct] = (f32x4){0.f, 0.f, 0.f, 0.f};
            const int kmax = (t0 + 15) >> 5;
            for (int kk = 0; kk <= kmax; ++kk) { const bf16x8 bw = frag_plain(Wm, 136, t0, 32 * kk, lane);
#pragma unroll
                for (int ct = 0; ct < 16; ++ct) { const bf16x8 av = frag_tr(vn, 264, 32 * kk, 16 * ct, lane); acc[ct] = MFMA16(av, bw, acc[ct]); } }
            const int t = t0 + i, row = row0 + t; const float bias = abs_[g * 128 + (smp ? (t & 31) : t)];
#pragma unroll
            for (int ct = 0; ct < 16; ++ct) { const size_t off = (size_t)row * DM + g * 256 + 16 * ct + 4 * g4; const u32x2 uu = *(const u32x2*)(U + off);
                u32x2 o; o.x = pk2(bf_lo(uu.x) * (acc[ct][0] + bias), bf_hi(uu.x) * (acc[ct][1] + bias)); o.y = pk2(bf_lo(uu.y) * (acc[ct][2] + bias), bf_hi(uu.y) * (acc[ct][3] + bias));
                *(u32x2*)(SB + off) = o; }
        }
        __syncthreads();
    }
}
constexpr int R_QS = 0, R_KS = 33792, R_VS = 67584, R_PS = 76800, R_RT = 86016, R_OS = 119808;
template <int L>
__device__ __forceinline__ void ret_run(LAS unsigned char* lds, const bf16* QH, const bf16* KH, const bf16* VB, bf16* OB, int grow0, int nblk, int h, int slice, const float* S0, float* Sout, int wave, int lane) {
    const int tid = threadIdx.x, i = lane & 15, g4 = lane >> 4;
    LAS bf16* qs = (LAS bf16*)(lds + R_QS); LAS bf16* ks = (LAS bf16*)(lds + R_KS); LAS bf16* vs = (LAS bf16*)(lds + R_VS);
    LAS bf16* ps = (LAS bf16*)(lds + R_PS); LAS bf16* rts = (LAS bf16*)(lds + R_RT); LAS bf16* os = (LAS bf16*)(lds + R_OS);
    const float lg = pg8::lg2gamma(h);
    const float gL = __builtin_amdgcn_exp2f(lg * (float)L), gLm1 = __builtin_amdgcn_exp2f(lg * (float)(L - 1)), gLm1i = __builtin_amdgcn_exp2f(-lg * (float)(L - 1));
    constexpr int NQ = L / 16, NT = L / 32, NKK = L / 32;
    const bool vthr = (L == 64) || tid < 256;
    u32x4 pq[NQ], pk[NQ], pv;
#define RET_GLOAD(blk) do { const int r0_ = grow0 + (blk) * L; _Pragma("unroll") for (int k_ = 0; k_ < NQ; ++k_) { const int e_ = tid + 512 * k_, row_ = e_ >> 5, ch_ = e_ & 31; \
        pq[k_] = *(const u32x4*)(QH + (size_t)(r0_ + row_) * 2048 + h * 256 + ch_ * 8); pk[k_] = *(const u32x4*)(KH + (size_t)(r0_ + row_) * 2048 + h * 256 + ch_ * 8); } \
        if (vthr) pv = *(const u32x4*)(VB + (size_t)(r0_ + (tid >> 3)) * 4096 + h * 512 + slice * 64 + (tid & 7) * 8); } while (0)
#define RET_LSTORE() do { _Pragma("unroll") for (int k_ = 0; k_ < NQ; ++k_) { const int e_ = tid + 512 * k_, row_ = e_ >> 5, ch_ = e_ & 31; \
        *(LAS u32x4*)(qs + row_ * 264 + ch_ * 8) = pq[k_]; *(LAS u32x4*)(ks + row_ * 264 + ch_ * 8) = pk[k_]; } \
        if (vthr) *(LAS u32x4*)(vs + (tid >> 3) * 72 + (tid & 7) * 8) = pv; } while (0)
    f32x4 R[2][4];
    RET_GLOAD(0);
#pragma unroll
    for (int a2 = 0; a2 < 2; ++a2)
#pragma unroll
        for (int d = 0; d < 4; ++d) {
            if (S0) {
#pragma unroll
                for (int e = 0; e < 4; ++e) R[a2][d][e] = S0[(size_t)(32 * wave + 16 * a2 + 4 * g4 + e) * 512 + slice * 64 + 16 * d + i] * gLm1i;
            } else R[a2][d] = (f32x4){0.f, 0.f, 0.f, 0.f};
            u32x2 w; w.x = pk2(R[a2][d][0], R[a2][d][1]); w.y = pk2(R[a2][d][2], R[a2][d][3]);
            *(LAS u32x2*)(rts + (16 * d + i) * 264 + 32 * wave + 16 * a2 + 4 * g4) = w; }
    RET_LSTORE();
    __syncthreads();
    const int it = (L == 64) ? (wave >> 1) : (wave >> 2);
    for (int n = 0; n < nblk; ++n) {
        if (n + 1 < nblk) RET_GLOAD(n + 1);
        bf16x8 qf[8];
#pragma unroll
        for (int kk = 0; kk < 8; ++kk) qf[kk] = frag_plain(qs, 264, 16 * it, 32 * kk, lane);
        if (L == 64 || wave < 4) {
#pragma unroll
            for (int tp = 0; tp < NT; ++tp) { const int i0 = 16 * (wave >> 1), j0 = (L == 64) ? 16 * (2 * (wave & 1) + tp) : 16 * (wave & 1);
                f32x4 acc = (f32x4){0.f, 0.f, 0.f, 0.f};
#pragma unroll
                for (int kk = 0; kk < 8; ++kk) acc = MFMA16(frag_plain(ks, 264, j0, 32 * kk, lane), (L == 64) ? qf[kk] : frag_plain(qs, 264, i0, 32 * kk, lane), acc);
#pragma unroll
                for (int e = 0; e < 4; ++e) acc[e] = (j0 + 4 * g4 + e <= i0 + i) ? acc[e] : 0.f;
                u32x2 w; w.x = pk2(acc[0], acc[1]); w.y = pk2(acc[2], acc[3]); *(LAS u32x2*)(ps + (i0 + i) * 72 + j0 + 4 * g4) = w; }
        }
        f32x4 oacc[NT];
#pragma unroll
        for (int tp = 0; tp < NT; ++tp) { const int dv0 = (L == 64) ? 16 * (2 * (wave & 1) + tp) : 16 * (wave & 3);
            f32x4 acc = (f32x4){0.f, 0.f, 0.f, 0.f};
#pragma unroll
            for (int kk = 0; kk < 8; ++kk) acc = MFMA16(frag_plain(rts, 264, dv0, 32 * kk, lane), qf[kk], acc);
            oacc[tp] = acc * gL; }
        __syncthreads();
#pragma unroll
        for (int tp = 0; tp < NT; ++tp) { const int dv0 = (L == 64) ? 16 * (2 * (wave & 1) + tp) : 16 * (wave & 3);
#pragma unroll
            for (int kk = 0; kk < NKK; ++kk) oacc[tp] = MFMA16(frag_tr(vs, 72, 32 * kk, dv0, lane), frag_plain(ps, 72, 16 * it, 32 * kk, lane), oacc[tp]);
            u32x2 w; w.x = pk2(oacc[tp][0], oacc[tp][1]); w.y = pk2(oacc[tp][2], oacc[tp][3]); *(LAS u32x2*)(os + (16 * it + i) * 72 + dv0 + 4 * g4) = w; }
#pragma unroll
        for (int a2 = 0; a2 < 2; ++a2)
#pragma unroll
            for (int d = 0; d < 4; ++d) R[a2][d] = R[a2][d] * gL;
#pragma unroll
        for (int kk = 0; kk < NKK; ++kk) { bf16x8 bv[4];
#pragma unroll
            for (int d = 0; d < 4; ++d) bv[d] = frag_tr(vs, 72, 32 * kk, 16 * d, lane);
#pragma unroll
            for (int a2 = 0; a2 < 2; ++a2) { const bf16x8 av = frag_tr(ks, 264, 32 * kk, 32 * wave + 16 * a2, lane);
#pragma unroll
                for (int d = 0; d < 4; ++d) R[a2][d] = MFMA16(av, bv[d], R[a2][d]); } }
        __syncthreads();
#pragma unroll
        for (int a2 = 0; a2 < 2; ++a2)
#pragma unroll
            for (int d = 0; d < 4; ++d) { u32x2 w; w.x = pk2(R[a2][d][0], R[a2][d][1]); w.y = pk2(R[a2][d][2], R[a2][d][3]);
                *(LAS u32x2*)(rts + (16 * d + i) * 264 + 32 * wave + 16 * a2 + 4 * g4) = w; }
        if (vthr) *(u32x4*)(OB + (size_t)(grow0 + n * L + (tid >> 3)) * 4096 + h * 512 + slice * 64 + (tid & 7) * 8) = *(const LAS u32x4*)(os + (tid >> 3) * 72 + (tid & 7) * 8);
        if (n + 1 < nblk) RET_LSTORE();
        __syncthreads();
    }
#pragma unroll
    for (int a2 = 0; a2 < 2; ++a2)
#pragma unroll
        for (int d = 0; d < 4; ++d)
#pragma unroll
            for (int e = 0; e < 4; ++e) Sout[(size_t)(32 * wave + 16 * a2 + 4 * g4 + e) * 512 + slice * 64 + 16 * d + i] = R[a2][d][e] * gLm1;
#undef RET_GLOAD
#undef RET_LSTORE
}

constexpr int S_QS = 0, S_KS = 16896, S_PS = 33792, S_RT = 38400, S_VS = 105984, S_OS = 115200;
__device__ __forceinline__ void ret_sample(LAS unsigned char* lds, const bf16* QH, const bf16* KH, const bf16* VB, bf16* OB, int grow0, int h, const float* S0, float* Sout, int wave, int lane) {
    const int tid = threadIdx.x, i = lane & 15, g4 = lane >> 4;
    LAS bf16* qs = (LAS bf16*)(lds + S_QS); LAS bf16* ks = (LAS bf16*)(lds + S_KS); LAS bf16* ps = (LAS bf16*)(lds + S_PS);
    const float lg = pg8::lg2gamma(h);
    const float gL = __builtin_amdgcn_exp2f(lg * 32.f), gLm1 = __builtin_amdgcn_exp2f(lg * 31.f), gLm1i = __builtin_amdgcn_exp2f(-lg * 31.f);
    const bool vthr = tid < 256;
#pragma unroll
    for (int k = 0; k < 2; ++k) { const int e = tid + 512 * k, row = e >> 5, ch = e & 31;
        *(LAS u32x4*)(qs + row * 264 + ch * 8) = *(const u32x4*)(QH + (size_t)(grow0 + row) * 2048 + h * 256 + ch * 8);
        *(LAS u32x4*)(ks + row * 264 + ch * 8) = *(const u32x4*)(KH + (size_t)(grow0 + row) * 2048 + h * 256 + ch * 8); }
    f32x4 Rn[2][4]; u32x4 vn = (u32x4){0u, 0u, 0u, 0u};
#define SMP_PREFETCH(sl) do { _Pragma("unroll") for (int a2 = 0; a2 < 2; ++a2) _Pragma("unroll") for (int d = 0; d < 4; ++d) _Pragma("unroll") for (int e = 0; e < 4; ++e) \
        Rn[a2][d][e] = S0[(size_t)(32 * wave + 16 * a2 + 4 * g4 + e) * 512 + (sl) * 64 + 16 * d + i]; \
        if (vthr) vn = *(const u32x4*)(VB + (size_t)(grow0 + (tid >> 3)) * 4096 + h * 512 + (sl) * 64 + (tid & 7) * 8); } while (0)
    SMP_PREFETCH(0);
    __syncthreads();
    if (wave < 4) {
        const int i0 = 16 * (wave >> 1), j0 = 16 * (wave & 1); f32x4 acc = (f32x4){0.f, 0.f, 0.f, 0.f};
#pragma unroll
        for (int kk = 0; kk < 8; ++kk) acc = MFMA16(frag_plain(ks, 264, j0, 32 * kk, lane), frag_plain(qs, 264, i0, 32 * kk, lane), acc);
#pragma unroll
        for (int e = 0; e < 4; ++e) acc[e] = (j0 + 4 * g4 + e <= i0 + i) ? acc[e] : 0.f;
        u32x2 w; w.x = pk2(acc[0], acc[1]); w.y = pk2(acc[2], acc[3]); *(LAS u32x2*)(ps + (i0 + i) * 72 + j0 + 4 * g4) = w;
    }
    const int it = wave >> 2, dv0 = 16 * (wave & 3);
    bf16x8 qf[8], av[2];
#pragma unroll
    for (int kk = 0; kk < 8; ++kk) qf[kk] = frag_plain(qs, 264, 16 * it, 32 * kk, lane);
#pragma unroll
    for (int a2 = 0; a2 < 2; ++a2) av[a2] = frag_tr(ks, 264, 0, 32 * wave + 16 * a2, lane);
    __syncthreads();
    const bf16x8 pf = frag_plain(ps, 72, 16 * it, 0, lane);
    for (int sl = 0; sl < 8; ++sl) {
        LAS bf16* rts = (LAS bf16*)(lds + S_RT + (sl & 1) * 33792); LAS bf16* vs = (LAS bf16*)(lds + S_VS + (sl & 1) * 4608); LAS bf16* os = (LAS bf16*)(lds + S_OS + (sl & 1) * 4608);
        f32x4 R[2][4];
#pragma unroll
        for (int a2 = 0; a2 < 2; ++a2)
#pragma unroll
            for (int d = 0; d < 4; ++d) { R[a2][d] = Rn[a2][d] * gLm1i; u32x2 w; w.x = pk2(R[a2][d][0], R[a2][d][1]); w.y = pk2(R[a2][d][2], R[a2][d][3]);
                *(LAS u32x2*)(rts + (16 * d + i) * 264 + 32 * wave + 16 * a2 + 4 * g4) = w; }
        if (vthr) *(LAS u32x4*)(vs + (tid >> 3) * 72 + (tid & 7) * 8) = vn;
        if (sl + 1 < 8) SMP_PREFETCH(sl + 1);
        __syncthreads();
        if (sl > 0 && vthr) *(u32x4*)(OB + (size_t)(grow0 + (tid >> 3)) * 4096 + h * 512 + (sl - 1) * 64 + (tid & 7) * 8) = *(const LAS u32x4*)((LAS bf16*)(lds + S_OS + ((sl - 1) & 1) * 4608) + (tid >> 3) * 72 + (tid & 7) * 8);
        f32x4 acc = (f32x4){0.f, 0.f, 0.f, 0.f};
#pragma unroll
        for (int kk = 0; kk < 8; ++kk) acc = MFMA16(frag_plain(rts, 264, dv0, 32 * kk, lane), qf[kk], acc);
        acc = acc * gL;
        acc = MFMA16(frag_tr(vs, 72, 0, dv0, lane), pf, acc);
        { u32x2 w; w.x = pk2(acc[0], acc[1]); w.y = pk2(acc[2], acc[3]); *(LAS u32x2*)(os + (16 * it + i) * 72 + dv0 + 4 * g4) = w; }
        bf16x8 bv[4];
#pragma unroll
        for (int d = 0; d < 4; ++d) bv[d] = frag_tr(vs, 72, 0, 16 * d, lane);
#pragma unroll
        for (int a2 = 0; a2 < 2; ++a2)
#pragma unroll
            for (int d = 0; d < 4; ++d) { R[a2][d] = MFMA16(av[a2], bv[d], R[a2][d] * gL);
#pragma unroll
                for (int e = 0; e < 4; ++e) Sout[(size_t)(32 * wave + 16 * a2 + 4 * g4 + e) * 512 + sl * 64 + 16 * d + i] = R[a2][d][e] * gLm1; }
    }
    __syncthreads();
    if (vthr) *(u32x4*)(OB + (size_t)(grow0 + (tid >> 3)) * 4096 + h * 512 + 7 * 64 + (tid & 7) * 8) = *(const LAS u32x4*)((LAS bf16*)(lds + S_OS + 4608) + (tid >> 3) * 72 + (tid & 7) * 8);
    __syncthreads();
#undef SMP_PREFETCH
}
__device__ __forceinline__ void ret_phase(const Args& a, LAS unsigned char* lds, int wave, int lane) {
    const bf16* QH = (const bf16*)(a.ws + WS_R1); const bf16* KH = QH + (size_t)MT * DM; const bf16* VB = (const bf16*)(a.ws + WS_R1 + 72 * MiB); bf16* OB = (bf16*)(a.ws + WS_YP);
    float* sp = a.out + (size_t)MT * DM; float* ss = sp + (size_t)4 * 8 * 256 * 512;
    for (int item = blockIdx.x; item < 256; item += gridDim.x) {
        const int x = item & 7, j = item >> 3, bh = x * 4 + (j >> 3), slice = j & 7, b = bh >> 3, h = bh & 7;
        ret_run<64>(lds, QH, KH, VB, OB, b * 2048, 32, h, slice, nullptr, sp + (size_t)bh * 256 * 512, wave, lane);
    }
    for (int pair = blockIdx.x; pair < 256; pair += gridDim.x) {
        const int b = pair >> 3, h = pair & 7;
        ret_sample(lds, QH, KH, VB, OB, MP + b * 32, h, a.in[2] + (size_t)pair * 256 * 512, ss + (size_t)pair * 256 * 512, wave, lane);
    }
}
__device__ __forceinline__ void gn_gate(const Args& a, int gw, int NGW, int lane) {
    const bf16* O = (const bf16*)(a.ws + WS_YP); bf16* GS = (bf16*)(a.ws + WS_R1 + 144 * MiB);
    for (int row = gw; row < MT; row += NGW) {
        const size_t off = (size_t)row * 4096 + 8 * lane;
        u32x4 ow[8], gv[8];
#pragma unroll
        for (int h = 0; h < 8; ++h) { ow[h] = *(const u32x4*)(O + off + h * 512); gv[h] = *(const u32x4*)(GS + off + h * 512); }
#pragma unroll
        for (int h = 0; h < 8; ++h) {
            float o[8] = {bf_lo(ow[h].x), bf_hi(ow[h].x), bf_lo(ow[h].y), bf_hi(ow[h].y), bf_lo(ow[h].z), bf_hi(ow[h].z), bf_lo(ow[h].w), bf_hi(ow[h].w)};
            const float g[8] = {bf_lo(gv[h].x), bf_hi(gv[h].x), bf_lo(gv[h].y), bf_hi(gv[h].y), bf_lo(gv[h].z), bf_hi(gv[h].z), bf_lo(gv[h].w), bf_hi(gv[h].w)};
            float s = 0.f;
#pragma unroll
            for (int e = 0; e < 8; ++e) s += o[e];
            const float mean = wave_sum(s) * (1.f / 512.f); float q = 0.f;
#pragma unroll
            for (int e = 0; e < 8; ++e) { o[e] -= mean; q += o[e] * o[e]; }
            const float rstd = 1.0f / sqrtf(wave_sum(q) * (1.f / 512.f) + GN_EPS);
            u32x4 w; w.x = pk2(g[0] * o[0] * rstd, g[1] * o[1] * rstd); w.y = pk2(g[2] * o[2] * rstd, g[3] * o[3] * rstd); w.z = pk2(g[4] * o[4] * rstd, g[5] * o[5] * rstd); w.w = pk2(g[6] * o[6] * rstd, g[7] * o[7] * rstd);
            *(u32x4*)(GS + off + h * 512) = w;
        }
    }
}

#ifndef DBG_STOP
#define DBG_STOP 0
#endif
__device__ __forceinline__ void dbg_dump(const Args& a, const bf16* src, size_t n_el) {
    const size_t T = (size_t)gridDim.x * 512, t = (size_t)blockIdx.x * 512 + threadIdx.x, total = 58720256;
    for (size_t i = t; i < total; i += T) { float v = 0.f; if (i < n_el / 2) { const unsigned w = ((const unsigned*)src)[i]; v = bf_lo(w) + bf_hi(w); } a.out[i] = v; }
}
__device__ __forceinline__ void dbg_dump_f32(const Args& a, const float* src, size_t n_el) {
    const size_t T = (size_t)gridDim.x * 512, t = (size_t)blockIdx.x * 512 + threadIdx.x, total = 58720256;
    for (size_t i = t; i < total; i += T) a.out[i] = i < n_el ? src[i] : 0.f;
}
#define XB_TMO      128
#define XB_XCNT(j)  (256  + 64 * (j))
#define XB_XSUB(j)  (1280 + 64 * (j))
#define XB_XGEN(j)  (2304 + 64 * (j))
#define XB_TOP      3328
#define XB_TOPGEN   3392
#define XCD_BAR_WORDS 3456
#define XB_SPIN_CAP (1u << 18)

__device__ __forceinline__ unsigned xb_ld(unsigned* p)              { return __hip_atomic_load(p, __ATOMIC_RELAXED, __HIP_MEMORY_SCOPE_AGENT); }
__device__ __forceinline__ unsigned xb_add(unsigned* p, unsigned v) { return __hip_atomic_fetch_add(p, v, __ATOMIC_RELAXED, __HIP_MEMORY_SCOPE_AGENT); }
__device__ __forceinline__ unsigned xb_xcc_id() { return (unsigned)__builtin_amdgcn_s_getreg((3 << 11) | 20) & 0xFu; }
#define XB_SPIN(cond, bar) do { unsigned _sp = 0; while (cond) { __builtin_amdgcn_s_sleep(1); \
    if ((++_sp & 255u) == 0u) { if (xb_ld(&(bar)[XB_TMO])) break; if (_sp > XB_SPIN_CAP) { atomicAdd(&(bar)[XB_TMO], 1u); break; } } } } while (0)

struct XcdBarrier {
    unsigned* bar; unsigned x;
    volatile LAS unsigned* st;
};

__device__ __forceinline__ XcdBarrier xcd_barrier_post(unsigned* bar, volatile LAS unsigned* st) {
    XcdBarrier b; b.bar = bar; b.x = xb_xcc_id(); b.st = st;
    if (threadIdx.x == 0) (void)xb_add(&bar[XB_XCNT(b.x)], 1u);
    return b;
}
__device__ __forceinline__ void xcd_barrier_complete(unsigned* bar, unsigned x, unsigned& nloc, unsigned& nx) {
    const unsigned G = gridDim.x * gridDim.y * gridDim.z;
    unsigned sum, cnt, mine, sp = 0u;
    for (;;) {
        sum = 0u; cnt = 0u; mine = 0u;
#pragma unroll
        for (unsigned j = 0; j < 16; ++j) { const unsigned c = xb_ld(&bar[XB_XCNT(j)]); sum += c; cnt += (c > 0u) ? 1u : 0u; mine = (j == x) ? c : mine; }
        if (sum == G) break;
        __builtin_amdgcn_s_sleep(1);
        if ((++sp & 255u) == 0u) { if (xb_ld(&bar[XB_TMO])) break; if (sp > XB_SPIN_CAP) { atomicAdd(&bar[XB_TMO], 1u); break; } }
    }
    nloc = mine > 0u ? mine : 1u; nx = cnt > 0u ? cnt : 1u;
}

__device__ __forceinline__ void xcd_barrier(const XcdBarrier& b) {
    asm volatile("s_waitcnt vmcnt(0)" ::: "memory");
    __syncthreads();
    if (threadIdx.x == 0) {
        unsigned* bar = b.bar;
        __builtin_amdgcn_s_waitcnt(0);
        unsigned nloc = b.st[0], nx = b.st[1];
        if (nloc == 0u) { xcd_barrier_complete(bar, b.x, nloc, nx); b.st[0] = nloc; b.st[1] = nx; }
        const unsigned old = xb_add(&bar[XB_XSUB(b.x)], 1u);
        const unsigned gen = old / nloc;
        if (old + 1u == (gen + 1u) * nloc) {
            __builtin_amdgcn_fence(__ATOMIC_RELEASE, "agent");
            asm volatile("s_waitcnt vmcnt(0)" ::: "memory");
            const unsigned og = xb_add(&bar[XB_TOP], 1u);
            const unsigned tg = og / nx;
            if (og + 1u == (tg + 1u) * nx) xb_add(&bar[XB_TOPGEN], 1u);
            else XB_SPIN(xb_ld(&bar[XB_TOPGEN]) == tg, bar);
            __builtin_amdgcn_fence(__ATOMIC_ACQUIRE, "agent");
            xb_add(&bar[XB_XGEN(b.x)], 1u);
            asm volatile("s_waitcnt vmcnt(0)" ::: "memory");
        } else {
            XB_SPIN(xb_ld(&bar[XB_XGEN(b.x)]) == gen, bar);
            __builtin_amdgcn_fence(__ATOMIC_ACQUIRE, "agent");
            asm volatile("s_waitcnt vmcnt(0)" ::: "memory");
        }
    }
    __syncthreads();
}

__global__ void __launch_bounds__(512, 2) fwd(Args a) {
    extern __shared__ __attribute__((aligned(16))) unsigned char lds_raw[];
    cg::grid_group grid = cg::this_grid();
    LAS unsigned char* lds = (LAS unsigned char*)lds_raw;
    const int tid = threadIdx.x, lane = tid & 63, wave = __builtin_amdgcn_readfirstlane(tid >> 6);
    const int G = gridDim.x, c = blockIdx.x, vcu = (G % 8 == 0) ? (c % 8) * (G / 8) + c / 8 : c, gw = vcu * NW + wave, NGW = G * NW;
    unsigned char* ws = a.ws;
    { volatile LAS unsigned* misc = (volatile LAS unsigned*)(lds + MISC_OFF); if (tid < 32) misc[tid] = 0u; }
    __syncthreads();
    XcdBarrier bar = xcd_barrier_post((unsigned*)(ws + WS_CTL), (volatile LAS unsigned*)(lds + MISC_OFF) + 8);
    bf16* XB = (bf16*)(ws + WS_XB); float* YP = (float*)(ws + WS_YP);
    bf16* R1 = (bf16*)(ws + WS_R1);
#define GEMM(EPI, E, Ap, Bp, LD, M1, N, K, SPLIT, CLIST) do { pg8::Gemm g_{(const pg8::bf16_t*)(Ap), (const pg8::bf16_t*)(Bp), (LD)}; pg8::Order S_; S_.init((M1), (N), (K), (SPLIT), G, c); \
        pg8::gemm_phase<EPI, pg8::Order, true, true>(lds, g_, S_, E); if (DBL_GEMM) pg8::gemm_phase<EPI, pg8::Order, true, true>(lds, g_, S_, E); \
        if ((CLIST) > 0) { const int nbusy_ = S_.so.nwg % G;   \
            if (nbusy_ == 0) convert_list(a, lds, (CLIST), gw, NGW, wave, lane); else if (c >= nbusy_) convert_list(a, lds, (CLIST), (c - nbusy_) * NW + wave, (G - nbusy_) * NW, wave, lane); } } while (0)

#define GRID_SYNC() do { asm volatile("s_waitcnt vmcnt(0) lgkmcnt(0)" ::: "memory"); grid.sync(); } while (0)
#define XCD_SYNC() xcd_barrier(bar)

#define DBG_DUMP_1 dbg_dump(a, XB, (size_t)MT * DM)
#define DBG_DUMP_2 dbg_dump(a, R1, (size_t)2 * MT * DM)
#define DBG_DUMP_3 dbg_dump(a, R1 + (size_t)2 * MT * DM, (size_t)MT * DM)
#define DBG_DUMP_4 dbg_dump_f32(a, YP, (size_t)2 * MP * DM)
#define DBG_DUMP_5 dbg_dump(a, XB, (size_t)MT * DM)
#define DBG_DUMP_6 dbg_dump(a, R1, (size_t)MT * FF)
#define DBG_DUMP_7 dbg_dump_f32(a, YP, (size_t)2 * MP * DM)
#define DBG_DUMP_8 dbg_dump(a, XB, (size_t)MT * DM)
#define DBG_DUMP_9 dbg_dump(a, R1, (size_t)6 * MT * DM)
#define DBG_DUMP_10 dbg_dump(a, (const bf16*)YP, (size_t)2 * MT * DM)
#define DBG_DUMP_11 dbg_dump(a, R1 + (size_t)4 * MT * DM, (size_t)2 * MT * DM)
#define DBG_DUMP_12 dbg_dump_f32(a, YP, (size_t)2 * MP * DM)
#define DBG_DUMP_13 dbg_dump(a, XB, (size_t)MT * DM)
#define DBG_DUMP_14 dbg_dump(a, R1, (size_t)MT * FF)
#define DBG_DUMP_15 dbg_dump_f32(a, YP, (size_t)2 * MP * DM)
    p0_prologue(a, lds, gw, NGW, wave, lane);
    if (a.out == nullptr) GRID_SYNC();
    XCD_SYNC();
    if (DBG_STOP == 1) { DBG_DUMP_1; return; }
    { pg8::EpiGeluUV E{R1, R1 + (size_t)MT * DM, (pg8::f32x2*)(ws + WS_STAT)}; GEMM(pg8::EpiGeluUV, E, XB, ws + WS_WAIN, 2048, MT, 4096, 2048, 0, 1); }
    XCD_SYNC();
    if (DBG_STOP == 2) { DBG_DUMP_2; return; }
    mix_phase(a, lds, wave, lane);
    XCD_SYNC();
    if (DBG_STOP == 3) { DBG_DUMP_3; return; }
    { pg8::EpiPart E{YP}; GEMM(pg8::EpiPart, E, ws + WS_R1 + 72 * MiB, ws + WS_WAOUT, 2048, MP, 2048, 2048, 1, 0); }
    XCD_SYNC();
    if (DBG_STOP == 4) { DBG_DUMP_4; return; }
    ln_pass(a.in[0], a.in[1], nullptr, YP, a.in[13], a.in[14], nullptr, XB, gw, NGW, lane);
    XCD_SYNC();
    if (DBG_STOP == 5) { DBG_DUMP_5; return; }
    { pg8::EpiSwiglu E{R1}; GEMM(pg8::EpiSwiglu, E, XB, ws + WS_WFIN, 2048, MT, 11264, 2048, 0, 2); }
    XCD_SYNC();
    if (DBG_STOP == 6) { DBG_DUMP_6; return; }
    { pg8::EpiPart E{YP}; GEMM(pg8::EpiPart, E, R1, ws + WS_WFOUT, 5632, MP, 2048, 5632, 1, 0); }
    XCD_SYNC();
    if (DBG_STOP == 7) { DBG_DUMP_7; return; }
    ln_pass(nullptr, nullptr, XB, YP, a.in[15], a.in[16], nullptr, XB, gw, NGW, lane);
    XCD_SYNC();
    if (DBG_STOP == 8) { DBG_DUMP_8; return; }
    { pg8::EpiQKVG E{R1, R1 + (size_t)MT * DM, (pg8::bf16_t*)(ws + WS_R1 + 72 * MiB), (pg8::bf16_t*)(ws + WS_R1 + 144 * MiB), (const float*)(ws + WS_ROPE), (const float*)(ws + WS_ROPE) + 2080 * 128};
      GEMM(pg8::EpiQKVG, E, XB, ws + WS_WBIN, 2048, MT, 12288, 2048, 0, 3); }
    XCD_SYNC();
    if (DBG_STOP == 9) { DBG_DUMP_9; return; }
    ret_phase(a, lds, wave, lane);
    XCD_SYNC();
    if (DBG_STOP == 10) { DBG_DUMP_10; return; }
    gn_gate(a, gw, NGW, lane);
    XCD_SYNC();
    if (DBG_STOP == 11) { DBG_DUMP_11; return; }
    { pg8::EpiPart E{YP}; GEMM(pg8::EpiPart, E, ws + WS_R1 + 144 * MiB, ws + WS_WBOUT, 4096, MP, 2048, 4096, 1, 0); }
    XCD_SYNC();
    if (DBG_STOP == 12) { DBG_DUMP_12; return; }
    ln_pass(nullptr, nullptr, XB, YP, a.in[13] + DM, a.in[14] + DM, nullptr, XB, gw, NGW, lane);
    XCD_SYNC();
    if (DBG_STOP == 13) { DBG_DUMP_13; return; }
    { pg8::EpiSwiglu E{R1}; GEMM(pg8::EpiSwiglu, E, XB, ws + WS_WFIN + 44 * MiB, 2048, MT, 11264, 2048, 0, 0); }
    XCD_SYNC();
    if (DBG_STOP == 14) { DBG_DUMP_14; return; }
    { pg8::EpiPart E{YP}; GEMM(pg8::EpiPart, E, R1, ws + WS_WFOUT + 22 * MiB, 5632, MP, 2048, 5632, 1, 0); }
    XCD_SYNC();
    if (DBG_STOP == 15) { DBG_DUMP_15; return; }
    ln_pass(nullptr, nullptr, XB, YP, a.in[15] + DM, a.in[16] + DM, a.out, nullptr, gw, NGW, lane);
#undef GEMM
}

extern "C" void kernel_launch(void* const* d_in, const int* in_sizes, int n_in, void* d_out, int out_size, void* d_ws, size_t ws_size, hipStream_t stream) {
    static int grid = 0;
    if (grid == 0) {
        if (n_in != 17 || ws_size < WS_END) { fprintf(stderr, "kernel_launch: needs 17 inputs and >= %zu bytes of workspace (got %d, %zu)\n", (size_t)WS_END, n_in, ws_size); grid = -1; return; }
        int dev = 0, cus = 0, per_cu = 0;
        if (hipGetDevice(&dev) != hipSuccess || hipDeviceGetAttribute(&cus, hipDeviceAttributeMultiprocessorCount, dev) != hipSuccess) { grid = -1; return; }
        if (hipFuncSetAttribute((const void*)fwd, hipFuncAttributeMaxDynamicSharedMemorySize, LDS_BYTES) != hipSuccess) { fprintf(stderr, "kernel_launch: hipFuncSetAttribute failed\n"); grid = -1; return; }
        if (hipOccupancyMaxActiveBlocksPerMultiprocessor(&per_cu, (const void*)fwd, NW * 64, LDS_BYTES) != hipSuccess || per_cu < 1) { fprintf(stderr, "kernel_launch: occupancy query reports %d workgroups per CU\n", per_cu); grid = -1; return; }
        grid = cus;
    }
    if (grid < 0) return;
    if (hipMemsetAsync((char*)d_ws + WS_CTL, 0, CTL_BYTES, stream) != hipSuccess) { fprintf(stderr, "kernel_launch: hipMemsetAsync failed\n"); return; }
    Args a{};
    for (int i = 0; i < 17; ++i) a.in[i] = (const float*)d_in[i];
    a.out = (float*)d_out; a.ws = (unsigned char*)d_ws;
    void* args[] = {&a};
    const hipError_t e = hipLaunchCooperativeKernel((const void*)fwd, dim3(grid), dim3(NW * 64), args, LDS_BYTES, stream);
    if (e != hipSuccess) fprintf(stderr, "kernel_launch: cooperative launch failed: %s (grid %d)\n", hipGetErrorString(e), grid);
}
```

```cpp
#ifndef DBL_GEMM
#define DBL_GEMM 0
#endif
#include <hip/hip_runtime.h>
#include <hip/hip_cooperative_groups.h>
#include <cstdio>
#include <cstdint>
namespace cg = cooperative_groups;

constexpr int DM = 2048, MP = 8192, MS = 1024, MT = MP + MS, FF = 5632, NQKVG = 12288, RV = 4096;
constexpr float ALPHA = 1.41421356237309515f;
constexpr float LN_EPS = 1e-5f, GN_EPS = 1e-6f;

namespace pg8 {
#define PG8_LAS __attribute__((address_space(3)))
typedef unsigned short bf16_t;
typedef short bf16x8 __attribute__((ext_vector_type(8)));
typedef float f32x4 __attribute__((ext_vector_type(4)));
typedef unsigned u32x4 __attribute__((ext_vector_type(4)));
constexpr int BM = 256, BK = 64, HALF = 128, HTB = HALF * BK * 2  , STAGE_BYTES = 8 * HTB, NXCD = 8, WGM = 8;

__host__ __device__ __forceinline__ int lds_byte(int r, int c) { const int st = (r >> 4) * 2 + (c >> 5), rr = r & 15, cc = c & 31, ob = rr * 64 + cc * 2; return st * 1024 + (ob ^ (((ob >> 9) & 1) << 5)); }
__host__ __device__ __forceinline__ void stage_rc(int b, int& R, int& C) { const int st = b / 1024, sb = b % 1024, swz = sb ^ (((sb >> 9) & 1) << 5); R = (st >> 1) * 16 + swz / 64; C = (st & 1) * 32 + (swz % 64) / 2; }
__host__ __device__ __forceinline__ int perm32(int rho) { const int n = rho >> 4, i = rho & 15; return 8 * (i >> 2) + 4 * n + (i & 3); }

struct Unit { int pm, pn, k0, nt, ks; };
struct Gemm { const bf16_t* A; const bf16_t* Bt; int ld; };

struct StaticOrder {
    int nM, nN, nwg, G, c;
    __host__ __device__ void init(int M, int N, int G_, int c_) { nM = M / BM; nN = N / BM; nwg = nM * nN; G = G_; c = c_; }
    __host__ __device__ __forceinline__ void tile(int L, int& pm_, int& pn_) const {
        int wgid = L; { const int q = nwg / NXCD, r = nwg % NXCD, xcd = wgid % NXCD, off = wgid / NXCD; wgid = (xcd < r ? xcd * (q + 1) : r * (q + 1) + (xcd - r) * q) + off; }
        const int nig = WGM * nN, gid = wgid / nig, fm = gid * WGM, gsz = (nM - fm) < WGM ? (nM - fm) : WGM;
        pm_ = fm + ((wgid % nig) % gsz); pn_ = (wgid % nig) / gsz;
    }
    __device__ __forceinline__ void a_ready(const Unit&) const {}
    __device__ __forceinline__ void done(const Unit&) const {}
};

typedef float f32x2_cv __attribute__((ext_vector_type(2))); typedef __bf16 bf16x2_cv __attribute__((ext_vector_type(2)));
__device__ __forceinline__ unsigned cvt_pk_bf16(float lo, float hi) { const f32x2_cv v = {lo, hi}; const bf16x2_cv b = __builtin_convertvector(v, bf16x2_cv); return __builtin_bit_cast(unsigned, b); }
typedef float f32x2 __attribute__((ext_vector_type(2)));
__device__ __forceinline__ f32x2 gelu_pk(f32x2 v) {
    const f32x2 av = __builtin_elementwise_abs(v), d = av * 0.2316418882f + 1.0f;
    f32x2 t; t.x = __builtin_amdgcn_rcpf(d.x); t.y = __builtin_amdgcn_rcpf(d.y);
    f32x2 q = t * 0.5307027145f + (-0.7265760135f); q = q * t + 0.7107068705f; q = q * t + (-0.142248368f); q = q * t + 0.127414796f; q = q * t;
    const f32x2 s = (v * v) * (-0.72134752044f);
    f32x2 e; e.x = __builtin_amdgcn_exp2f(s.x); e.y = __builtin_amdgcn_exp2f(s.y);
    const f32x2 m = v * (q * e), r = v - m;
    f32x2 o; o.x = v.x < 0.f ? m.x : r.x; o.y = v.y < 0.f ? m.y : r.y; return o;
}
struct Order {
    StaticOrder so; int G, c, n1c, ntk, split;
    __device__ __forceinline__ void init(int M1, int N, int K, int split_, int G_, int c_) { so.init(M1, N, G_, c_); G = G_; c = c_; ntk = K / BK; split = split_; n1c = (c < so.nwg) ? (so.nwg - c + G - 1) / G : 0; }
    __device__ __forceinline__ bool next(int i, Unit& u) const {
        const bool p1 = i < n1c; int pm1, pn1; so.tile(p1 ? i * G + c : 0, pm1, pn1);
        const int j = (i - n1c) * G + c; const bool p2 = !p1 && split != 0 && j < 256;
        const int ks = j & 7, jj = (j >> 3) & 31, b = (ntk >> 3) & ~1, rem2 = (ntk - 8 * b) >> 1;
        Unit r; r.pm = p1 ? pm1 : so.nM + (jj & 3); r.pn = p1 ? pn1 : (jj >> 2); r.k0 = p1 ? 0 : (ks * b + 2 * (ks < rem2 ? ks : rem2)) * BK; r.nt = p1 ? ntk : b + (ks < rem2 ? 2 : 0); r.ks = p1 ? -1 : ks;
        u = r; return p1 || p2;
    }
    __device__ __forceinline__ void a_ready(const Unit&) const {}
    __device__ __forceinline__ void done(const Unit&) const {}
};

__device__ __forceinline__ float silu_f(float x) { return x * __builtin_amdgcn_rcpf(1.0f + __builtin_amdgcn_exp2f(-1.4426950408889634f * x)); }

struct EpiPart {
    static constexpr bool PERM = false, AFTER_DRAIN = false;
    float* Y;
    __device__ __forceinline__ void operator()(const f32x4 (&acc)[2][2][4][2], const Unit& u, int wr, int wc, int fr, int fq) const {
        const int row0 = u.pm * BM + wr * 64 + fr + (u.ks > 0 ? u.ks * 1024 : 0), col0 = u.pn * BM + wc * 32 + 4 * fq;
#pragma unroll
        for (int ai = 0; ai < 2; ++ai)
#pragma unroll
            for (int m = 0; m < 4; ++m) { float* rowp = Y + (size_t)(row0 + ai * HALF + m * 16) * 2048 + col0;
#pragma unroll
                for (int bj = 0; bj < 2; ++bj)
#pragma unroll
                    for (int n = 0; n < 2; ++n) *(f32x4*)(rowp + bj * HALF + n * 16) = acc[ai][bj][m][n]; }
    }
};
struct EpiGeluUV {
    static constexpr bool PERM = true, AFTER_DRAIN = false;
    bf16_t* U; bf16_t* V; f32x2* stat;
    __device__ __forceinline__ void operator()(const f32x4 (&acc)[2][2][4][2], const Unit& u, int wr, int wc, int fr, int fq) const {
        const bool isv = u.pn >= 8; bf16_t* O = isv ? V : U;
        const int row0 = u.pm * BM + wr * 64 + fr, col0 = (u.pn & 7) * BM + wc * 32 + 8 * fq;
#pragma unroll
        for (int ai = 0; ai < 2; ++ai)
#pragma unroll
            for (int m = 0; m < 4; ++m) { const int row = row0 + ai * HALF + m * 16; bf16_t* rowp = O + (size_t)row * 2048 + col0; float s = 0.f, q = 0.f;
#pragma unroll
                for (int bj = 0; bj < 2; ++bj) { const f32x4 v0 = acc[ai][bj][m][0], v1 = acc[ai][bj][m][1];
                    const f32x2 a = gelu_pk((f32x2){v0[0], v0[1]}), b = gelu_pk((f32x2){v0[2], v0[3]}), c = gelu_pk((f32x2){v1[0], v1[1]}), d = gelu_pk((f32x2){v1[2], v1[3]});
                    s += ((a.x + a.y) + (b.x + b.y)) + ((c.x + c.y) + (d.x + d.y));
                    q += ((a.x * a.x + a.y * a.y) + (b.x * b.x + b.y * b.y)) + ((c.x * c.x + c.y * c.y) + (d.x * d.x + d.y * d.y));
                    u32x4 w; w.x = cvt_pk_bf16(a.x, a.y); w.y = cvt_pk_bf16(b.x, b.y); w.z = cvt_pk_bf16(c.x, c.y); w.w = cvt_pk_bf16(d.x, d.y);
                    *(u32x4*)(rowp + bj * HALF) = w; }
                if (isv) { s += __shfl_xor(s, 16); s += __shfl_xor(s, 32); q += __shfl_xor(q, 16); q += __shfl_xor(q, 32);
                    if (fq == 0) stat[(size_t)row * 32 + (u.pn - 8) * 4 + wc] = (f32x2){s, q}; } }
    }
};
struct EpiSwiglu {
    static constexpr bool PERM = true, AFTER_DRAIN = false;
    bf16_t* H;
    __device__ __forceinline__ void operator()(const f32x4 (&acc)[2][2][4][2], const Unit& u, int wr, int wc, int fr, int fq) const {
        const int row0 = u.pm * BM + wr * 64 + fr, col0 = u.pn * HALF + wc * 32 + 8 * fq;
#pragma unroll
        for (int ai = 0; ai < 2; ++ai)
#pragma unroll
            for (int m = 0; m < 4; ++m) { bf16_t* rowp = H + (size_t)(row0 + ai * HALF + m * 16) * 5632 + col0;
                const f32x4 g0 = acc[ai][0][m][0], g1 = acc[ai][0][m][1], u0 = acc[ai][1][m][0], u1 = acc[ai][1][m][1];
                u32x4 w; w.x = cvt_pk_bf16(silu_f(g0[0]) * u0[0], silu_f(g0[1]) * u0[1]); w.y = cvt_pk_bf16(silu_f(g0[2]) * u0[2], silu_f(g0[3]) * u0[3]);
                w.z = cvt_pk_bf16(silu_f(g1[0]) * u1[0], silu_f(g1[1]) * u1[1]); w.w = cvt_pk_bf16(silu_f(g1[2]) * u1[2], silu_f(g1[3]) * u1[3]);
                *(u32x4*)rowp = w; }
    }
};
__device__ __forceinline__ float lg2gamma(int h) {
    const double x = 1.0 / (double)(32 << h); double p = x, s = 0.0;
    const double inv[8] = {1.0, 0.5, 1.0 / 3.0, 0.25, 0.2, 1.0 / 6.0, 1.0 / 7.0, 0.125};
#pragma unroll
    for (int k = 0; k < 8; ++k) { s -= p * inv[k]; p *= x; }
    return (float)(s * 1.4426950408889634);
}
struct EpiQKVG {
    static constexpr bool PERM = true, AFTER_DRAIN = false;
    bf16_t *QH, *KH, *VB, *GS; const float* ropec; const float* ropes;
    __device__ __forceinline__ void operator()(const f32x4 (&acc)[2][2][4][2], const Unit& u, int wr, int wc, int fr, int fq) const {
        const int row0 = u.pm * BM + wr * 64 + fr, cw = wc * 32 + 8 * fq;
        if (u.pn < 16) {
            const bool isq = u.pn < 8; const int head = u.pn & 7; bf16_t* O = (isq ? QH : KH) + head * 256 + cw;
            const float lg = lg2gamma(head) * (isq ? 1.f : -1.f), sc0 = isq ? 0.0625f : 1.f;
#pragma unroll
            for (int ai = 0; ai < 2; ++ai)
#pragma unroll
                for (int m = 0; m < 4; ++m) { const int row = row0 + ai * HALF + m * 16;
                    const int pidx = row < MP ? (row & 2047) : 2048 + ((row - MP) & 31), ib = row < MP ? (row & 63) : ((row - MP) & 31);
                    const float sc = sc0 * __builtin_amdgcn_exp2f(lg * (float)ib);
                    const f32x4 c0 = *(const f32x4*)(ropec + pidx * 128 + cw), c1 = *(const f32x4*)(ropec + pidx * 128 + cw + 4);
                    const f32x4 s0 = *(const f32x4*)(ropes + pidx * 128 + cw), s1 = *(const f32x4*)(ropes + pidx * 128 + cw + 4);
                    const f32x4 a0 = acc[ai][0][m][0], a1 = acc[ai][0][m][1], b0 = acc[ai][1][m][0], b1 = acc[ai][1][m][1];
                    const f32x4 o0 = (a0 * c0 - b0 * s0) * sc, o1 = (a1 * c1 - b1 * s1) * sc, p0 = (a0 * s0 + b0 * c0) * sc, p1 = (a1 * s1 + b1 * c1) * sc;
                    u32x4 w; w.x = cvt_pk_bf16(o0[0], o0[1]); w.y = cvt_pk_bf16(o0[2], o0[3]); w.z = cvt_pk_bf16(o1[0], o1[1]); w.w = cvt_pk_bf16(o1[2], o1[3]);
                    *(u32x4*)(O + (size_t)row * 2048) = w;
                    w.x = cvt_pk_bf16(p0[0], p0[1]); w.y = cvt_pk_bf16(p0[2], p0[3]); w.z = cvt_pk_bf16(p1[0], p1[1]); w.w = cvt_pk_bf16(p1[2], p1[3]);
                    *(u32x4*)(O + (size_t)row * 2048 + HALF) = w; }
        } else {
            const bool isg = u.pn >= 32; bf16_t* O = (isg ? GS : VB) + ((u.pn - 16) & 15) * BM + cw;
#pragma unroll
            for (int ai = 0; ai < 2; ++ai)
#pragma unroll
                for (int m = 0; m < 4; ++m) { bf16_t* rowp = O + (size_t)(row0 + ai * HALF + m * 16) * 4096;
#pragma unroll
                    for (int bj = 0; bj < 2; ++bj) { f32x4 v0 = acc[ai][bj][m][0], v1 = acc[ai][bj][m][1];
                        if (isg) { v0 = (f32x4){silu_f(v0[0]), silu_f(v0[1]), silu_f(v0[2]), silu_f(v0[3])}; v1 = (f32x4){silu_f(v1[0]), silu_f(v1[1]), silu_f(v1[2]), silu_f(v1[3])}; }
                        u32x4 w; w.x = cvt_pk_bf16(v0[0], v0[1]); w.y = cvt_pk_bf16(v0[2], v0[3]); w.z = cvt_pk_bf16(v1[0], v1[1]); w.w = cvt_pk_bf16(v1[2], v1[3]);
                        *(u32x4*)(rowp + bj * HALF) = w; } }
        }
    }
};
template <class Epi, class Sched, bool ALIGN_EPI = false, bool SP2 = false>
__device__ __forceinline__ void gemm_phase(PG8_LAS unsigned char* lds, const Gemm g, const Sched& S, const Epi& E) {
    int tid_ = threadIdx.x; asm volatile("" : "+v"(tid_));
    const int tid = tid_, wid = __builtin_amdgcn_readfirstlane(tid >> 6), lane = tid & 63, wr = wid >> 2, wc = wid & 3, fr = lane & 15, fq = lane >> 4;
    const int K = g.ld;
    unsigned voffA[2], voffB[2];
#pragma unroll
    for (int i = 0; i < 2; ++i) { int R, C; stage_rc(tid * 16 + i * 8192, R, C); const int Rb = Epi::PERM ? ((R & ~31) + perm32(R & 31)) : R;
        voffA[i] = (unsigned)(R * K + C) * 2u; voffB[i] = (unsigned)(Rb * K + C) * 2u; }
    const size_t kstep = (size_t)(BK * 2);
    const size_t hstep = (size_t)HALF * K * 2;
    const size_t tstep = 2 * hstep;
    const unsigned ldsw = (unsigned)wid * 1024u;
    const int aoff = lds_byte(wr * 64 + fr, fq * 8), boff = lds_byte(wc * 32 + fr, fq * 8);
#define PG8_SA(b, h) (((b) * 2 + (h)) * HTB)
#define PG8_SB(b, h) ((4 + (b) * 2 + (h)) * HTB)
#define PG8_STAGE(bufoff, gbase, voff) do { _Pragma("unroll") for (int _i = 0; _i < 2; ++_i) \
        __builtin_amdgcn_global_load_lds((const unsigned*)((const char*)(gbase) + (voff)[_i]), (PG8_LAS unsigned*)(lds + (bufoff) + ldsw + _i * 8192), 16, 0, 0); } while (0)
#define PG8_LDA(dst, b, h) do { _Pragma("unroll") for (int m = 0; m < 4; ++m) _Pragma("unroll") for (int k = 0; k < 2; ++k) dst[m][k] = *(const PG8_LAS bf16x8*)(lds + PG8_SA(b, h) + aoff + m * 2048 + k * 1024); } while (0)
#define PG8_LDB(dst, b, h) do { _Pragma("unroll") for (int n = 0; n < 2; ++n) _Pragma("unroll") for (int k = 0; k < 2; ++k) dst[n][k] = *(const PG8_LAS bf16x8*)(lds + PG8_SB(b, h) + boff + n * 2048 + k * 1024); } while (0)
#define PG8_MMA(ai, bj, At, Bt) do { __builtin_amdgcn_s_setprio(1); _Pragma("unroll") for (int m = 0; m < 4; ++m) _Pragma("unroll") for (int n = 0; n < 2; ++n) _Pragma("unroll") for (int k = 0; k < 2; ++k) \
        acc[ai][bj][m][n] = __builtin_amdgcn_mfma_f32_16x16x32_bf16(Bt[n][k], At[m][k], acc[ai][bj][m][n], 0, 0, 0); __builtin_amdgcn_s_setprio(0); } while (0)
#define PG8_WAIT_V(n) asm volatile("s_waitcnt vmcnt(" #n ")" ::: "memory")
#define PG8_WAIT_L(n) asm volatile("s_waitcnt lgkmcnt(" #n ")" ::: "memory")
#define PG8_BAR __builtin_amdgcn_s_barrier()
#define PG8_SCHED __builtin_amdgcn_sched_barrier(0)
    Unit cur, nxt; int ui = 0;
    if (!S.next(0, cur)) return;
    f32x4 acc[2][2][4][2];
#pragma unroll
    for (int a = 0; a < 2; ++a)
#pragma unroll
        for (int b = 0; b < 2; ++b)
#pragma unroll
            for (int m = 0; m < 4; ++m)
#pragma unroll
                for (int n = 0; n < 2; ++n) acc[a][b][m][n] = (f32x4){0.f, 0.f, 0.f, 0.f};
    bf16x8 At[4][2], B0[2][2], B1[2][2];
    const char* cA = (const char*)g.A + (size_t)cur.pm * tstep + (size_t)cur.k0 * 2; const char* cB = (const char*)g.Bt + (size_t)cur.pn * tstep + (size_t)cur.k0 * 2; int nt = cur.nt;
    S.a_ready(cur);
    if constexpr (SP2) {
        PG8_STAGE(PG8_SB(0, 0), cB, voffB); PG8_STAGE(PG8_SB(0, 1), cB + hstep, voffB); PG8_STAGE(PG8_SA(0, 0), cA, voffA); PG8_STAGE(PG8_SA(0, 1), cA + hstep, voffA);
        if (wr == 1) PG8_BAR;
        PG8_WAIT_V(2); PG8_BAR;
        PG8_STAGE(PG8_SB(1, 0), cB + kstep, voffB); PG8_STAGE(PG8_SA(1, 0), cA + kstep, voffA); PG8_STAGE(PG8_SB(1, 1), cB + hstep + kstep, voffB);
        PG8_WAIT_V(6); PG8_BAR;
    } else {
        PG8_STAGE(PG8_SB(0, 0), cB, voffB); PG8_STAGE(PG8_SA(0, 0), cA, voffA); PG8_STAGE(PG8_SB(0, 1), cB + hstep, voffB); PG8_STAGE(PG8_SA(0, 1), cA + hstep, voffA);
        if (wr == 1) PG8_BAR;
        PG8_WAIT_V(4); PG8_BAR;
        PG8_STAGE(PG8_SB(1, 0), cB + kstep, voffB); PG8_STAGE(PG8_SA(1, 0), cA + kstep, voffA); PG8_STAGE(PG8_SB(1, 1), cB + hstep + kstep, voffB);
        PG8_WAIT_V(6); PG8_BAR;
    }
    for (;;) {
        const bool has_next = S.next(ui + 1, nxt);
        const char* nA = has_next ? (const char*)g.A + (size_t)nxt.pm * tstep + (size_t)nxt.k0 * 2 : cA; const char* nB = has_next ? (const char*)g.Bt + (size_t)nxt.pn * tstep + (size_t)nxt.k0 * 2 : cB;
        for (int t = 0; t < nt; t += 2) {
            const bool last = (t == nt - 2);
            const char* a1 = cA + (size_t)(t + 1) * kstep;
            const char* a2 = last ? nA : cA + (size_t)(t + 2) * kstep; const char* b2 = last ? nB : cB + (size_t)(t + 2) * kstep;
            const char* a3 = a2 + kstep; const char* b3 = b2 + kstep;
            if (last && has_next) S.a_ready(nxt);
            if constexpr (SP2) {
            PG8_LDB(B0, 0, 0); PG8_LDB(B1, 0, 1); PG8_SCHED; PG8_LDA(At, 0, 0); PG8_STAGE(PG8_SA(1, 1), a1 + hstep, voffA);
            PG8_WAIT_V(8); PG8_WAIT_L(0); PG8_BAR; PG8_MMA(0, 0, At, B0); PG8_MMA(0, 1, At, B1); PG8_BAR; PG8_SCHED;
            PG8_LDA(At, 0, 1); PG8_STAGE(PG8_SB(0, 0), b2, voffB); PG8_STAGE(PG8_SB(0, 1), b2 + hstep, voffB); PG8_STAGE(PG8_SA(0, 0), a2, voffA);
            PG8_WAIT_V(8); PG8_WAIT_L(0); PG8_BAR; PG8_MMA(1, 0, At, B0); PG8_MMA(1, 1, At, B1); PG8_BAR; PG8_SCHED;
            PG8_LDB(B0, 1, 0); PG8_LDB(B1, 1, 1); PG8_SCHED; PG8_LDA(At, 1, 0); PG8_STAGE(PG8_SA(0, 1), a2 + hstep, voffA);
            PG8_WAIT_V(8); PG8_WAIT_L(0); PG8_BAR; PG8_MMA(0, 0, At, B0); PG8_MMA(0, 1, At, B1); PG8_BAR; PG8_SCHED;
            PG8_LDA(At, 1, 1); PG8_STAGE(PG8_SB(1, 0), b3, voffB); PG8_STAGE(PG8_SB(1, 1), b3 + hstep, voffB); PG8_STAGE(PG8_SA(1, 0), a3, voffA);
            PG8_WAIT_V(8); PG8_WAIT_L(0); PG8_BAR; PG8_MMA(1, 0, At, B0); PG8_MMA(1, 1, At, B1); PG8_BAR; PG8_SCHED;
            } else {
            PG8_LDB(B0, 0, 0); PG8_SCHED; PG8_LDA(At, 0, 0); PG8_STAGE(PG8_SA(1, 1), a1 + hstep, voffA);
            PG8_WAIT_L(8); PG8_BAR; PG8_WAIT_L(0); PG8_MMA(0, 0, At, B0); PG8_BAR; PG8_SCHED;
            PG8_LDB(B1, 0, 1); PG8_STAGE(PG8_SB(0, 0), b2, voffB);
            PG8_BAR; PG8_WAIT_L(0); PG8_MMA(0, 1, At, B1); PG8_BAR;
            PG8_LDA(At, 0, 1); PG8_STAGE(PG8_SA(0, 0), a2, voffA);
            PG8_BAR; PG8_WAIT_L(0); PG8_MMA(1, 0, At, B0); PG8_BAR; PG8_SCHED;
            PG8_STAGE(PG8_SB(0, 1), b2 + hstep, voffB);
            PG8_WAIT_V(6); PG8_BAR; PG8_MMA(1, 1, At, B1); PG8_BAR;
            PG8_LDB(B0, 1, 0); PG8_SCHED; PG8_LDA(At, 1, 0); PG8_STAGE(PG8_SA(0, 1), a2 + hstep, voffA);
            PG8_WAIT_L(8); PG8_BAR; PG8_WAIT_L(0); PG8_MMA(0, 0, At, B0); PG8_BAR; PG8_SCHED;
            PG8_LDB(B1, 1, 1); PG8_STAGE(PG8_SB(1, 0), b3, voffB);
            PG8_BAR; PG8_WAIT_L(0); PG8_MMA(0, 1, At, B1); PG8_BAR;
            PG8_LDA(At, 1, 1); PG8_STAGE(PG8_SA(1, 0), a3, voffA);
            PG8_BAR; PG8_WAIT_L(0); PG8_MMA(1, 0, At, B0); PG8_BAR; PG8_SCHED;
            PG8_STAGE(PG8_SB(1, 1), b3 + hstep, voffB);
            PG8_WAIT_V(6); PG8_BAR; PG8_MMA(1, 1, At, B1); PG8_BAR;
            }
        }
        if constexpr (ALIGN_EPI) { if (wr == 0) PG8_BAR; }
        if constexpr (!Epi::AFTER_DRAIN) { E(acc, cur, wr, wc, fr, fq); S.done(cur); }
        if (!has_next) break;
#pragma unroll
        for (int a = 0; a < 2; ++a)
#pragma unroll
            for (int b = 0; b < 2; ++b)
#pragma unroll
                for (int m = 0; m < 4; ++m)
#pragma unroll
                    for (int n = 0; n < 2; ++n) acc[a][b][m][n] = (f32x4){0.f, 0.f, 0.f, 0.f};
        cur = nxt; cA = nA; cB = nB; nt = cur.nt; ++ui;
        if constexpr (ALIGN_EPI) { if (wr == 1) PG8_BAR; }
    }
    PG8_WAIT_V(0);
    if constexpr (!ALIGN_EPI) { if (wr == 0) PG8_BAR; }
    PG8_BAR;
    if constexpr (Epi::AFTER_DRAIN) { E.fused(acc, cur, wr, wc, fr, fq, lds, wid, lane); S.done(cur); }
#undef PG8_SA
#undef PG8_SB
#undef PG8_STAGE
#undef PG8_LDA
#undef PG8_LDB
#undef PG8_MMA
#undef PG8_WAIT_V
#undef PG8_WAIT_L
#undef PG8_BAR
#undef PG8_SCHED
}
}
constexpr size_t MiB = 1u << 20;
constexpr size_t WS_WAIN = 0, WS_WAOUT = 16 * MiB, WS_WBIN = 24 * MiB, WS_WBOUT = 72 * MiB, WS_WFIN = 88 * MiB, WS_WFOUT = 176 * MiB;
constexpr size_t WS_XB = 220 * MiB;
constexpr size_t WS_STAT = 256 * MiB;
constexpr size_t WS_ROPE = 259 * MiB;
constexpr size_t WS_YP = 262 * MiB;
constexpr size_t WS_XF = 390 * MiB;
constexpr size_t WS_R1 = 462 * MiB;
constexpr size_t WS_CTL = 678 * MiB, CTL_BYTES = 16384;
constexpr size_t WS_END = 679 * MiB;
constexpr int MISC_OFF = 131072 + 320;
constexpr int LDS_BYTES = 147456;
constexpr int NW = 8;

#define LAS __attribute__((address_space(3)))
typedef unsigned short bf16;
typedef unsigned u32x4 __attribute__((ext_vector_type(4)));
typedef unsigned u32x2 __attribute__((ext_vector_type(2)));
typedef float f32x4 __attribute__((ext_vector_type(4)));
typedef float f32x2 __attribute__((ext_vector_type(2)));
typedef short bf16x8 __attribute__((ext_vector_type(8)));
typedef short s16x4 __attribute__((ext_vector_type(4)));
#define LDS_WAIT() asm volatile("s_waitcnt lgkmcnt(0)" ::: "memory")
__device__ __forceinline__ unsigned pk2(float lo, float hi) { return pg8::cvt_pk_bf16(lo, hi); }
__device__ __forceinline__ float bf_lo(unsigned w) { return __uint_as_float(w << 16); }
__device__ __forceinline__ float bf_hi(unsigned w) { return __uint_as_float(w & 0xffff0000u); }
__device__ __forceinline__ float wave_sum(float v) {
#pragma unroll
    for (int o = 1; o < 64; o <<= 1) v += __shfl_xor(v, o);
    return v;
}

struct Args { const float* in[17]; float* out; unsigned char* ws; };

template <int MAPMODE>
__device__ __forceinline__ void p0_transpose_item(const float* W, int K, int N, bf16* WT, LAS float* scr, int item, int lane) {
    const int nblk = N / 32, kb = item / nblk, nb = item % nblk, k0 = 64 * kb, n0 = 32 * nb;
#pragma unroll 8
    for (int i = 0; i < 32; ++i) { const int kk = 2 * i + (lane >> 5); scr[kk * 33 + (lane & 31)] = W[(size_t)(k0 + kk) * N + n0 + (lane & 31)]; }
    LDS_WAIT(); asm volatile("" ::: "memory");
    int r0 = n0;
    if (MAPMODE == 1) { const int up = n0 >= FF ? 1 : 0, c = n0 - up * FF; r0 = 256 * (c >> 7) + (c & 127) + 128 * up; }
    const int c8 = lane & 7;
#pragma unroll
    for (int j = 0; j < 4; ++j) { const int n = (lane >> 3) + 8 * j; const LAS float* s = scr + (8 * c8) * 33 + n;
        u32x4 o; o.x = pk2(s[0 * 33], s[1 * 33]); o.y = pk2(s[2 * 33], s[3 * 33]); o.z = pk2(s[4 * 33], s[5 * 33]); o.w = pk2(s[6 * 33], s[7 * 33]);
        *(u32x4*)(WT + (size_t)(r0 + n) * K + k0 + 8 * c8) = o; }
    LDS_WAIT(); asm volatile("" ::: "memory");
}
__device__ __forceinline__ void convert_list(const Args& a, LAS unsigned char* lds, int list, int w, int nw, int wave, int lane) {
    LAS float* scr = (LAS float*)(lds + wave * 16384);
    unsigned char* ws = a.ws;
    constexpr int I0 = 32 * 128, I1 = 32 * 64, I2 = 32 * 384, I3 = 64 * 64, I4 = 32 * 352, I5 = 88 * 64;
    if (list == 0) {
        for (int r = w; r < I0; r += nw) p0_transpose_item<0>(a.in[3], 2048, 4096, (bf16*)(ws + WS_WAIN), scr, r, lane);
    } else if (list == 1) {
        for (int it = w; it < I1 + I4 + I5; it += nw) { int r = it;
            if (r < I1) { p0_transpose_item<0>(a.in[8], 2048, 2048, (bf16*)(ws + WS_WAOUT), scr, r, lane); continue; } r -= I1;
            if (r < I4) { p0_transpose_item<1>(a.in[11], 2048, 11264, (bf16*)(ws + WS_WFIN), scr, r, lane); continue; } r -= I4;
            p0_transpose_item<0>(a.in[12], 5632, 2048, (bf16*)(ws + WS_WFOUT), scr, r, lane); }
    } else if (list == 2) {
        for (int it = w; it < I2 + I4; it += nw) { int r = it;
            if (r < I2) { p0_transpose_item<0>(a.in[9], 2048, 12288, (bf16*)(ws + WS_WBIN), scr, r, lane); continue; } r -= I2;
            p0_transpose_item<1>(a.in[11] + (size_t)2048 * 11264, 2048, 11264, (bf16*)(ws + WS_WFIN + 44 * MiB), scr, r, lane); }
    } else if (list == 3) {
        for (int r = w; r < I3; r += nw) p0_transpose_item<0>(a.in[10], 4096, 2048, (bf16*)(ws + WS_WBOUT), scr, r, lane);
    } else {
        for (int r = w; r < I5; r += nw) p0_transpose_item<0>(a.in[12] + (size_t)5632 * 2048, 5632, 2048, (bf16*)(ws + WS_WFOUT + 22 * MiB), scr, r, lane);
    }
}
__device__ __forceinline__ void p0_prologue(const Args& a, LAS unsigned char* lds, int gw, int NGW, int wave, int lane) {
    unsigned char* ws = a.ws;
    convert_list(a, lds, 0, gw, NGW, wave, lane);
    bf16* XB = (bf16*)(ws + WS_XB);
    for (int m = gw; m < MT; m += NGW) {
        const f32x4* xr = (const f32x4*)(m < MP ? a.in[0] + (size_t)m * DM : a.in[1] + (size_t)(m - MP) * DM) + lane;
        u32x2* o = (u32x2*)(XB + (size_t)m * DM) + lane;
#pragma unroll
        for (int j = 0; j < 8; ++j) { const f32x4 v = xr[64 * j]; u32x2 w; w.x = pk2(v[0], v[1]); w.y = pk2(v[2], v[3]); o[64 * j] = w; }
    }
    float* rc = (float*)(ws + WS_ROPE); float* rs = rc + 2080 * 128;
    for (int e = gw * 64 + lane; e < 2080 * 128; e += NGW * 64) {
        const int p = e >> 7, d = e & 127; const float pos = (float)(p < 2048 ? p : 4096 + (p - 2048));
        const float inv = __builtin_amdgcn_exp2f(-(float)d * (13.287712379549449f / 128.0f));
        const double rev = (double)(pos * inv) * 0.15915494309189535; const float fr = (float)(rev - __builtin_floor(rev));
        rc[e] = __builtin_amdgcn_cosf(fr); rs[e] = __builtin_amdgcn_sinf(fr);
    }
}

struct LnIO { const float* xres_p; const float* xres_s; const bf16* xb; const float* YP; const float* g; const float* b; float* outf; bf16* outb; };
__device__ __forceinline__ void ln_load(const LnIO& io, f32x4 (&v)[8], int row, int lane) {
    if (io.xres_p) { const f32x4* xr = (const f32x4*)(row < MP ? io.xres_p + (size_t)row * DM : io.xres_s + (size_t)(row - MP) * DM) + lane;
#pragma unroll
        for (int j = 0; j < 8; ++j) v[j] = xr[64 * j] * ALPHA;
    } else { const u32x2* xr = (const u32x2*)(io.xb + (size_t)row * DM) + lane;
#pragma unroll
        for (int j = 0; j < 8; ++j) { const u32x2 w = xr[64 * j]; v[j] = (f32x4){bf_lo(w.x), bf_hi(w.x), bf_lo(w.y), bf_hi(w.y)} * ALPHA; } }
    if (row < MP) { const f32x4* y = (const f32x4*)(io.YP + (size_t)row * DM) + lane;
#pragma unroll
        for (int j = 0; j < 8; ++j) v[j] += y[64 * j];
    } else {
#pragma unroll 2
        for (int ks = 0; ks < 8; ++ks) { const f32x4* y = (const f32x4*)(io.YP + (size_t)(MP + ks * MS + (row - MP)) * DM) + lane;
#pragma unroll
            for (int j = 0; j < 8; ++j) v[j] += y[64 * j]; }
    }
}
__device__ __forceinline__ void ln_finish(const LnIO& io, f32x4 (&v)[8], int row, int lane) {
    float s = 0.f;
#pragma unroll
    for (int j = 0; j < 8; ++j) s += (v[j][0] + v[j][1]) + (v[j][2] + v[j][3]);
    const float mean = wave_sum(s) * (1.f / DM); float q = 0.f;
#pragma unroll
    for (int j = 0; j < 8; ++j) { v[j] = v[j] - mean; q += (v[j][0] * v[j][0] + v[j][1] * v[j][1]) + (v[j][2] * v[j][2] + v[j][3] * v[j][3]); }
    const float rstd = 1.0f / sqrtf(wave_sum(q) * (1.f / DM) + LN_EPS);
#pragma unroll
    for (int j = 0; j < 8; ++j) { const f32x4 gg = ((const f32x4*)io.g)[lane + 64 * j], bb = ((const f32x4*)io.b)[lane + 64 * j]; const f32x4 o = v[j] * rstd * gg + bb;
        if (io.outf) ((f32x4*)(io.outf + (size_t)row * DM) + lane)[64 * j] = o;
        if (io.outb) { u32x2 w; w.x = pk2(o[0], o[1]); w.y = pk2(o[2], o[3]); ((u32x2*)(io.outb + (size_t)row * DM) + lane)[64 * j] = w; } }
}
__device__ __forceinline__ void ln_pair(const LnIO& io, int r0, int r1, int lane) { f32x4 va[8], vb[8]; ln_load(io, va, r0, lane); ln_load(io, vb, r1, lane); ln_finish(io, va, r0, lane); ln_finish(io, vb, r1, lane); }
__device__ __forceinline__ void ln_one(const LnIO& io, int r0, int lane) { f32x4 va[8]; ln_load(io, va, r0, lane); ln_finish(io, va, r0, lane); }
__device__ __forceinline__ void ln_pass(const float* xres_p, const float* xres_s, const bf16* xb, const float* YP, const float* g, const float* b, float* outf, bf16* outb, int gw, int NGW, int lane) {
    const LnIO io{xres_p, xres_s, xb, YP, g, b, outf, outb};
    if (NGW == 2048) {
        if (gw < 1024) { ln_one(io, MP + gw, lane); ln_pair(io, gw, gw + 1024, lane); }
        else { const int r = 2048 + (gw - 1024); ln_pair(io, r, r + 1024, lane); ln_pair(io, r + 2048, r + 3072, lane); ln_pair(io, r + 4096, r + 5120, lane); }
    } else {
        for (int row = gw; row < MT; row += NGW) ln_one(io, row, lane);
    }
}

__device__ __forceinline__ bf16x8 frag_plain(const LAS bf16* X, int ld, int r0, int k0, int lane) { return *(const LAS bf16x8*)(X + (r0 + (lane & 15)) * ld + k0 + 8 * (lane >> 4)); }
typedef short v4i16_t __attribute__((ext_vector_type(4)));
__device__ __forceinline__ bf16x8 frag_tr(const LAS bf16* Y, int ld, int kr0, int c0, int lane) {
    const int i = lane & 15, g4 = lane >> 4; const LAS bf16* p = Y + (kr0 + 8 * g4 + (i >> 2)) * ld + c0 + 4 * (i & 3);
    const v4i16_t lo = __builtin_amdgcn_ds_read_tr16_b64_v4i16((LAS v4i16_t*)p), hi = __builtin_amdgcn_ds_read_tr16_b64_v4i16((LAS v4i16_t*)(p + 4 * ld));
    return (bf16x8){lo[0], lo[1], lo[2], lo[3], hi[0], hi[1], hi[2], hi[3]};
}
#define MFMA16(a, b, c) __builtin_amdgcn_mfma_f32_16x16x32_bf16((a), (b), (c), 0, 0, 0)

template <int Q>
__device__ __forceinline__ void mix_item(const Args& a, LAS unsigned char* lds, int rb, int g, int cq, int wave, int lane) {
    constexpr int NCT = 16 / Q, NV = 8 / Q;
    const int tid = threadIdx.x;
    LAS bf16* Wm = (LAS bf16*)lds;
    LAS bf16* vn = (LAS bf16*)(lds + 34816);
    LAS f32x2* mr = (LAS f32x2*)(lds + 34816 + 67584);
    const bf16* U = (const bf16*)(a.ws + WS_R1); const bf16* V = U + (size_t)MT * DM; bf16* SB = (bf16*)(a.ws + WS_R1 + 72 * MiB);
    const f32x2* stat = (const f32x2*)(a.ws + WS_STAT);
    const float* lng = a.in[4]; const float* lnb = a.in[5]; const float* aws = a.in[6]; const float* abs_ = a.in[7];
    float* gv = a.out + (size_t)MT * DM + (size_t)(4 + 32) * 8 * 256 * 512;
    const int row0 = rb * 128, cbase = g * 256 + cq * (256 / Q); const bool smp = rb >= 64;
    const int wt = tid >> 2, ws0 = (tid & 3) * 32, wtw = smp ? (wt & 31) : wt;
    f32x4 wreg[8];
#pragma unroll
    for (int k = 0; k < 4; ++k) { const int sw = smp ? ((ws0 + 8 * k) & 31) : (ws0 + 8 * k); const float* wp = aws + ((size_t)g * 128 + wtw) * 128 + sw; wreg[2 * k] = *(const f32x4*)wp; wreg[2 * k + 1] = *(const f32x4*)(wp + 4); }
    const int vs_ = tid >> 2, vcb = (tid & 3) * (64 / Q); const bf16* vp = V + (size_t)(row0 + vs_) * DM + cbase + vcb;
    u32x4 vreg[NV];
#pragma unroll
    for (int k = 0; k < NV; ++k) vreg[k] = *(const u32x4*)(vp + 8 * k);
    const int t0 = 16 * wave, i = lane & 15, g4 = lane >> 4, t = t0 + i, row = row0 + t;
    u32x2 ureg[NCT];
#pragma unroll
    for (int ct = 0; ct < NCT; ++ct) ureg[ct] = *(const u32x2*)(U + (size_t)row * DM + cbase + 16 * ct + 4 * g4);
    const float bias = abs_[g * 128 + (smp ? (t & 31) : t)];
    if (tid < 128) { const f32x4* sp = (const f32x4*)(stat + (size_t)(row0 + tid) * 32); float s_ = 0.f, q_ = 0.f;
#pragma unroll
        for (int k = 0; k < 16; ++k) { const f32x4 v = sp[k]; s_ += v[0] + v[2]; q_ += v[1] + v[3]; }
        const float mean = s_ * (1.f / 2048.f), var = q_ * (1.f / 2048.f) - mean * mean; mr[tid] = (f32x2){mean, 1.0f / sqrtf(var + LN_EPS)}; }
#pragma unroll
    for (int k = 0; k < 4; ++k) { const int s0 = ws0 + 8 * k; const f32x4 w0 = wreg[2 * k], w1 = wreg[2 * k + 1];
        float w[8] = {w0[0], w0[1], w0[2], w0[3], w1[0], w1[1], w1[2], w1[3]};
#pragma unroll
        for (int e = 0; e < 8; ++e) { const int ss = s0 + e; const bool ok = smp ? ((ss >> 5) == (wt >> 5) && (ss & 31) <= (wt & 31)) : (ss <= wt); w[e] = ok ? w[e] : 0.f; }
        u32x4 o; o.x = pk2(w[0], w[1]); o.y = pk2(w[2], w[3]); o.z = pk2(w[4], w[5]); o.w = pk2(w[6], w[7]);
        *(LAS u32x4*)(Wm + wt * 136 + s0) = o; }
    __syncthreads();
    { const f32x2 m = mr[vs_];
#pragma unroll
        for (int k = 0; k < NV; ++k) { const u32x4 w = vreg[k]; const int c = cbase + vcb + 8 * k;
            const f32x4 g0 = *(const f32x4*)(lng + c), g1 = *(const f32x4*)(lng + c + 4), b0 = *(const f32x4*)(lnb + c), b1 = *(const f32x4*)(lnb + c + 4);
            f32x4 x0 = (f32x4){bf_lo(w.x), bf_hi(w.x), bf_lo(w.y), bf_hi(w.y)}, x1 = (f32x4){bf_lo(w.z), bf_hi(w.z), bf_lo(w.w), bf_hi(w.w)};
            x0 = (x0 - m.x) * m.y * g0 + b0; x1 = (x1 - m.x) * m.y * g1 + b1;
            u32x4 o; o.x = pk2(x0[0], x0[1]); o.y = pk2(x0[2], x0[3]); o.z = pk2(x1[0], x1[1]); o.w = pk2(x1[2], x1[3]);
            *(LAS u32x4*)(vn + vs_ * 264 + vcb + 8 * k) = o;
            if (smp) { float* op = gv + (size_t)(row0 + vs_ - MP) * DM + c; *(f32x4*)op = x0; *(f32x4*)(op + 4) = x1; } } }
    __syncthreads();
    {
        f32x4 acc[NCT];
#pragma unroll
        for (int ct = 0; ct < NCT; ++ct) acc[ct] = (f32x4){0.f, 0.f, 0.f, 0.f};
        const int kmax = (t0 + 15) >> 5;
        for (int kk = 0; kk <= kmax; ++kk) { const bf16x8 bw = frag_plain(Wm, 136, t0, 32 * kk, lane);
#pragma unroll
            for (int ct = 0; ct < NCT; ++ct) { const bf16x8 av = frag_tr(vn, 264, 32 * kk, 16 * ct, lane); acc[ct] = MFMA16(av, bw, acc[ct]); } }
#pragma unroll
        for (int ct = 0; ct < NCT; ++ct) { const size_t off = (size_t)row * DM + cbase + 16 * ct + 4 * g4; const u32x2 uu = ureg[ct];
            u32x2 o; o.x = pk2(bf_lo(uu.x) * (acc[ct][0] + bias), bf_hi(uu.x) * (acc[ct][1] + bias)); o.y = pk2(bf_lo(uu.y) * (acc[ct][2] + bias), bf_hi(uu.y) * (acc[ct][3] + bias));
            *(u32x2*)(SB + off) = o; }
    }
    __syncthreads();
}
__device__ __forceinline__ void mix_phase(const Args& a, LAS unsigned char* lds, int wave, int lane) {
    for (int item = blockIdx.x; item < 64 * 8; item += gridDim.x) mix_item<1>(a, lds, item >> 3, item & 7, 0, wave, lane);
    for (int item = blockIdx.x; item < 8 * 8 * 4; item += gridDim.x) mix_item<4>(a, lds, 64 + (item >> 5), (item >> 2) & 7, item & 3, wave, lane);
}
constexpr int R_QS = 0, R_KS = 33792, R_VS = 67584, R_PS = 76800, R_RT = 86016, R_OS = 119808;
template <int L>
__device__ __forceinline__ void ret_run(LAS unsigned char* lds, const bf16* QH, const bf16* KH, const bf16* VB, bf16* OB, int grow0, int nblk, int h, int slice, const float* S0, float* Sout, int wave, int lane) {
    const int tid = threadIdx.x, i = lane & 15, g4 = lane >> 4;
    LAS bf16* qs = (LAS bf16*)(lds + R_QS); LAS bf16* ks = (LAS bf16*)(lds + R_KS); LAS bf16* vs = (LAS bf16*)(lds + R_VS);
    LAS bf16* ps = (LAS bf16*)(lds + R_PS); LAS bf16* rts = (LAS bf16*)(lds + R_RT); LAS bf16* os = (LAS bf16*)(lds + R_OS);
    const float lg = pg8::lg2gamma(h);
    const float gL = __builtin_amdgcn_exp2f(lg * (float)L), gLm1 = __builtin_amdgcn_exp2f(lg * (float)(L - 1)), gLm1i = __builtin_amdgcn_exp2f(-lg * (float)(L - 1));
    constexpr int NQ = L / 16, NT = L / 32, NKK = L / 32;
    const bool vthr = (L == 64) || tid < 256;
    u32x4 pq[NQ], pk[NQ], pv;
#define RET_GLOAD(blk) do { const int r0_ = grow0 + (blk) * L; _Pragma("unroll") for (int k_ = 0; k_ < NQ; ++k_) { const int e_ = tid + 512 * k_, row_ = e_ >> 5, ch_ = e_ & 31; \
        pq[k_] = *(const u32x4*)(QH + (size_t)(r0_ + row_) * 2048 + h * 256 + ch_ * 8); pk[k_] = *(const u32x4*)(KH + (size_t)(r0_ + row_) * 2048 + h * 256 + ch_ * 8); } \
        if (vthr) pv = *(const u32x4*)(VB + (size_t)(r0_ + (tid >> 3)) * 4096 + h * 512 + slice * 64 + (tid & 7) * 8); } while (0)
#define RET_LSTORE() do { _Pragma("unroll") for (int k_ = 0; k_ < NQ; ++k_) { const int e_ = tid + 512 * k_, row_ = e_ >> 5, ch_ = e_ & 31; \
        *(LAS u32x4*)(qs + row_ * 264 + ch_ * 8) = pq[k_]; *(LAS u32x4*)(ks + row_ * 264 + ch_ * 8) = pk[k_]; } \
        if (vthr) *(LAS u32x4*)(vs + (tid >> 3) * 72 + (tid & 7) * 8) = pv; } while (0)
    f32x4 R[2][4];
    RET_GLOAD(0);
#pragma unroll
    for (int a2 = 0; a2 < 2; ++a2)
#pragma unroll
        for (int d = 0; d < 4; ++d) {
            if (S0) {
#pragma unroll
                for (int e = 0; e < 4; ++e) R[a2][d][e] = S0[(size_t)(32 * wave + 16 * a2 + 4 * g4 + e) * 512 + slice * 64 + 16 * d + i] * gLm1i;
            } else R[a2][d] = (f32x4){0.f, 0.f, 0.f, 0.f};
            u32x2 w; w.x = pk2(R[a2][d][0], R[a2][d][1]); w.y = pk2(R[a2][d][2], R[a2][d][3]);
            *(LAS u32x2*)(rts + (16 * d + i) * 264 + 32 * wave + 16 * a2 + 4 * g4) = w; }
    RET_LSTORE();
    __syncthreads();
    const int it = (L == 64) ? (wave >> 1) : (wave >> 2);
    for (int n = 0; n < nblk; ++n) {
        if (n + 1 < nblk) RET_GLOAD(n + 1);
        bf16x8 qf[8];
#pragma unroll
        for (int kk = 0; kk < 8; ++kk) qf[kk] = frag_plain(qs, 264, 16 * it, 32 * kk, lane);
        if (L == 64 || wave < 4) {
#pragma unroll
            for (int tp = 0; tp < NT; ++tp) { const int i0 = 16 * (wave >> 1), j0 = (L == 64) ? 16 * (2 * (wave & 1) + tp) : 16 * (wave & 1);
                f32x4 acc = (f32x4){0.f, 0.f, 0.f, 0.f};
#pragma unroll
                for (int kk = 0; kk < 8; ++kk) acc = MFMA16(frag_plain(ks, 264, j0, 32 * kk, lane), (L == 64) ? qf[kk] : frag_plain(qs, 264, i0, 32 * kk, lane), acc);
#pragma unroll
                for (int e = 0; e < 4; ++e) acc[e] = (j0 + 4 * g4 + e <= i0 + i) ? acc[e] : 0.f;
                u32x2 w; w.x = pk2(acc[0], acc[1]); w.y = pk2(acc[2], acc[3]); *(LAS u32x2*)(ps + (i0 + i) * 72 + j0 + 4 * g4) = w; }
        }
        f32x4 oacc[NT];
#pragma unroll
        for (int tp = 0; tp < NT; ++tp) { const int dv0 = (L == 64) ? 16 * (2 * (wave & 1) + tp) : 16 * (wave & 3);
            f32x4 acc = (f32x4){0.f, 0.f, 0.f, 0.f};
#pragma unroll
            for (int kk = 0; kk < 8; ++kk) acc = MFMA16(frag_plain(rts, 264, dv0, 32 * kk, lane), qf[kk], acc);
            oacc[tp] = acc * gL; }
        __syncthreads();
#pragma unroll
        for (int tp = 0; tp < NT; ++tp) { const int dv0 = (L == 64) ? 16 * (2 * (wave & 1) + tp) : 16 * (wave & 3);
#pragma unroll
            for (int kk = 0; kk < NKK; ++kk) oacc[tp] = MFMA16(frag_tr(vs, 72, 32 * kk, dv0, lane), frag_plain(ps, 72, 16 * it, 32 * kk, lane), oacc[tp]);
            u32x2 w; w.x = pk2(oacc[tp][0], oacc[tp][1]); w.y = pk2(oacc[tp][2], oacc[tp][3]); *(LAS u32x2*)(os + (16 * it + i) * 72 + dv0 + 4 * g4) = w; }
#pragma unroll
        for (int a2 = 0; a2 < 2; ++a2)
#pragma unroll
            for (int d = 0; d < 4; ++d) R[a2][d] = R[a2][d] * gL;
#pragma unroll
        for (int kk = 0; kk < NKK; ++kk) { bf16x8 bv[4];
#pragma unroll
            for (int d = 0; d < 4; ++d) bv[d] = frag_tr(vs, 72, 32 * kk, 16 * d, lane);
#pragma unroll
            for (int a2 = 0; a2 < 2; ++a2) { const bf16x8 av = frag_tr(ks, 264, 32 * kk, 32 * wave + 16 * a2, lane);
#pragma unroll
                for (int d = 0; d < 4; ++d) R[a2][d] = MFMA16(av, bv[d], R[a2][d]); } }
        __syncthreads();
#pragma unroll
        for (int a2 = 0; a2 < 2; ++a2)
#pragma unroll
            for (int d = 0; d < 4; ++d) { u32x2 w; w.x = pk2(R[a2][d][0], R[a2][d][1]); w.y = pk2(R[a2][d][2], R[a2][d][3]);
                *(LAS u32x2*)(rts + (16 * d + i) * 264 + 32 * wave + 16 * a2 + 4 * g4) = w; }
        if (vthr) *(u32x4*)(OB + (size_t)(grow0 + n * L + (tid >> 3)) * 4096 + h * 512 + slice * 64 + (tid & 7) * 8) = *(const LAS u32x4*)(os + (tid >> 3) * 72 + (tid & 7) * 8);
        if (n + 1 < nblk) RET_LSTORE();
        __syncthreads();
    }
#pragma unroll
    for (int a2 = 0; a2 < 2; ++a2)
#pragma unroll
        for (int d = 0; d < 4; ++d)
#pragma unroll
            for (int e = 0; e < 4; ++e) Sout[(size_t)(32 * wave + 16 * a2 + 4 * g4 + e) * 512 + slice * 64 + 16 * d + i] = R[a2][d][e] * gLm1;
#undef RET_GLOAD
#undef RET_LSTORE
}

constexpr int S_QS = 0, S_KS = 16896, S_PS = 33792, S_RT = 38400, S_VS = 105984, S_OS = 115200;
__device__ __forceinline__ void ret_sample(LAS unsigned char* lds, const bf16* QH, const bf16* KH, const bf16* VB, bf16* OB, int grow0, int h, const float* S0, float* Sout, int wave, int lane) {
    const int tid = threadIdx.x, i = lane & 15, g4 = lane >> 4;
    LAS bf16* qs = (LAS bf16*)(lds + S_QS); LAS bf16* ks = (LAS bf16*)(lds + S_KS); LAS bf16* ps = (LAS bf16*)(lds + S_PS);
    const float lg = pg8::lg2gamma(h);
    const float gL = __builtin_amdgcn_exp2f(lg * 32.f), gLm1 = __builtin_amdgcn_exp2f(lg * 31.f), gLm1i = __builtin_amdgcn_exp2f(-lg * 31.f);
    const bool vthr = tid < 256;
#pragma unroll
    for (int k = 0; k < 2; ++k) { const int e = tid + 512 * k, row = e >> 5, ch = e & 31;
        *(LAS u32x4*)(qs + row * 264 + ch * 8) = *(const u32x4*)(QH + (size_t)(grow0 + row) * 2048 + h * 256 + ch * 8);
        *(LAS u32x4*)(ks + row * 264 + ch * 8) = *(const u32x4*)(KH + (size_t)(grow0 + row) * 2048 + h * 256 + ch * 8); }
    f32x4 Rn[2][4]; u32x4 vn = (u32x4){0u, 0u, 0u, 0u};
#define SMP_PREFETCH(sl) do { _Pragma("unroll") for (int a2 = 0; a2 < 2; ++a2) _Pragma("unroll") for (int d = 0; d < 4; ++d) _Pragma("unroll") for (int e = 0; e < 4; ++e) \
        Rn[a2][d][e] = S0[(size_t)(32 * wave + 16 * a2 + 4 * g4 + e) * 512 + (sl) * 64 + 16 * d + i]; \
        if (vthr) vn = *(const u32x4*)(VB + (size_t)(grow0 + (tid >> 3)) * 4096 + h * 512 + (sl) * 64 + (tid & 7) * 8); } while (0)
    SMP_PREFETCH(0);
    __syncthreads();
    if (wave < 4) {
        const int i0 = 16 * (wave >> 1), j0 = 16 * (wave & 1); f32x4 acc = (f32x4){0.f, 0.f, 0.f, 0.f};
#pragma unroll
        for (int kk = 0; kk < 8; ++kk) acc = MFMA16(frag_plain(ks, 264, j0, 32 * kk, lane), frag_plain(qs, 264, i0, 32 * kk, lane), acc);
#pragma unroll
        for (int e = 0; e < 4; ++e) acc[e] = (j0 + 4 * g4 + e <= i0 + i) ? acc[e] : 0.f;
        u32x2 w; w.x = pk2(acc[0], acc[1]); w.y = pk2(acc[2], acc[3]); *(LAS u32x2*)(ps + (i0 + i) * 72 + j0 + 4 * g4) = w;
    }
    const int it = wave >> 2, dv0 = 16 * (wave & 3);
    bf16x8 qf[8], av[2];
#pragma unroll
    for (int kk = 0; kk < 8; ++kk) qf[kk] = frag_plain(qs, 264, 16 * it, 32 * kk, lane);
#pragma unroll
    for (int a2 = 0; a2 < 2; ++a2) av[a2] = frag_tr(ks, 264, 0, 32 * wave + 16 * a2, lane);
    __syncthreads();
    const bf16x8 pf = frag_plain(ps, 72, 16 * it, 0, lane);
    for (int sl = 0; sl < 8; ++sl) {
        LAS bf16* rts = (LAS bf16*)(lds + S_RT + (sl & 1) * 33792); LAS bf16* vs = (LAS bf16*)(lds + S_VS + (sl & 1) * 4608); LAS bf16* os = (LAS bf16*)(lds + S_OS + (sl & 1) * 4608);
        f32x4 R[2][4];
#pragma unroll
        for (int a2 = 0; a2 < 2; ++a2)
#pragma unroll
            for (int d = 0; d < 4; ++d) { R[a2][d] = Rn[a2][d] * gLm1i; u32x2 w; w.x = pk2(R[a2][d][0], R[a2][d][1]); w.y = pk2(R[a2][d][2], R[a2][d][3]);
                *(LAS u32x2*)(rts + (16 * d + i) * 264 + 32 * wave + 16 * a2 + 4 * g4) = w; }
        if (vthr) *(LAS u32x4*)(vs + (tid >> 3) * 72 + (tid & 7) * 8) = vn;
        if (sl + 1 < 8) SMP_PREFETCH(sl + 1);
        __syncthreads();
        if (sl > 0 && vthr) *(u32x4*)(OB + (size_t)(grow0 + (tid >> 3)) * 4096 + h * 512 + (sl - 1) * 64 + (tid & 7) * 8) = *(const LAS u32x4*)((LAS bf16*)(lds + S_OS + ((sl - 1) & 1) * 4608) + (tid >> 3) * 72 + (tid & 7) * 8);
        f32x4 acc = (f32x4){0.f, 0.f, 0.f, 0.f};
#pragma unroll
        for (int kk = 0; kk < 8; ++kk) acc = MFMA16(frag_plain(rts, 264, dv0, 32 * kk, lane), qf[kk], acc);
        acc = acc * gL;
        acc = MFMA16(frag_tr(vs, 72, 0, dv0, lane), pf, acc);
        { u32x2 w; w.x = pk2(acc[0], acc[1]); w.y = pk2(acc[2], acc[3]); *(LAS u32x2*)(os + (16 * it + i) * 72 + dv0 + 4 * g4) = w; }
        bf16x8 bv[4];
#pragma unroll
        for (int d = 0; d < 4; ++d) bv[d] = frag_tr(vs, 72, 0, 16 * d, lane);
#pragma unroll
        for (int a2 = 0; a2 < 2; ++a2)
#pragma unroll
            for (int d = 0; d < 4; ++d) { R[a2][d] = MFMA16(av[a2], bv[d], R[a2][d] * gL);
#pragma unroll
                for (int e = 0; e < 4; ++e) Sout[(size_t)(32 * wave + 16 * a2 + 4 * g4 + e) * 512 + sl * 64 + 16 * d + i] = R[a2][d][e] * gLm1; }
    }
    __syncthreads();
    if (vthr) *(u32x4*)(OB + (size_t)(grow0 + (tid >> 3)) * 4096 + h * 512 + 7 * 64 + (tid & 7) * 8) = *(const LAS u32x4*)((LAS bf16*)(lds + S_OS + 4608) + (tid >> 3) * 72 + (tid & 7) * 8);
    __syncthreads();
#undef SMP_PREFETCH
}
__device__ __forceinline__ void ret_phase(const Args& a, LAS unsigned char* lds, int wave, int lane) {
    const bf16* QH = (const bf16*)(a.ws + WS_R1); const bf16* KH = QH + (size_t)MT * DM; const bf16* VB = (const bf16*)(a.ws + WS_R1 + 72 * MiB); bf16* OB = (bf16*)(a.ws + WS_YP);
    float* sp = a.out + (size_t)MT * DM; float* ss = sp + (size_t)4 * 8 * 256 * 512;
    for (int item = blockIdx.x; item < 256; item += gridDim.x) {
        const int x = item & 7, j = item >> 3, bh = x * 4 + (j >> 3), slice = j & 7, b = bh >> 3, h = bh & 7;
        ret_run<64>(lds, QH, KH, VB, OB, b * 2048, 32, h, slice, nullptr, sp + (size_t)bh * 256 * 512, wave, lane);
    }
    for (int pair = blockIdx.x; pair < 256; pair += gridDim.x) {
        const int b = pair >> 3, h = pair & 7;
        ret_sample(lds, QH, KH, VB, OB, MP + b * 32, h, a.in[2] + (size_t)pair * 256 * 512, ss + (size_t)pair * 256 * 512, wave, lane);
    }
}
__device__ __forceinline__ void gn_gate(const Args& a, int gw, int NGW, int lane) {
    const bf16* O = (const bf16*)(a.ws + WS_YP); bf16* GS = (bf16*)(a.ws + WS_R1 + 144 * MiB);
    for (int row = gw; row < MT; row += NGW) {
        const size_t off = (size_t)row * 4096 + 8 * lane;
        u32x4 ow[8], gv[8];
#pragma unroll
        for (int h = 0; h < 8; ++h) { ow[h] = *(const u32x4*)(O + off + h * 512); gv[h] = *(const u32x4*)(GS + off + h * 512); }
#pragma unroll
        for (int h = 0; h < 8; ++h) {
            float o[8] = {bf_lo(ow[h].x), bf_hi(ow[h].x), bf_lo(ow[h].y), bf_hi(ow[h].y), bf_lo(ow[h].z), bf_hi(ow[h].z), bf_lo(ow[h].w), bf_hi(ow[h].w)};
            const float g[8] = {bf_lo(gv[h].x), bf_hi(gv[h].x), bf_lo(gv[h].y), bf_hi(gv[h].y), bf_lo(gv[h].z), bf_hi(gv[h].z), bf_lo(gv[h].w), bf_hi(gv[h].w)};
            float s = 0.f;
#pragma unroll
            for (int e = 0; e < 8; ++e) s += o[e];
            const float mean = wave_sum(s) * (1.f / 512.f); float q = 0.f;
#pragma unroll
            for (int e = 0; e < 8; ++e) { o[e] -= mean; q += o[e] * o[e]; }
            const float rstd = 1.0f / sqrtf(wave_sum(q) * (1.f / 512.f) + GN_EPS);
            u32x4 w; w.x = pk2(g[0] * o[0] * rstd, g[1] * o[1] * rstd); w.y = pk2(g[2] * o[2] * rstd, g[3] * o[3] * rstd); w.z = pk2(g[4] * o[4] * rstd, g[5] * o[5] * rstd); w.w = pk2(g[6] * o[6] * rstd, g[7] * o[7] * rstd);
            *(u32x4*)(GS + off + h * 512) = w;
        }
    }
}

#ifndef DBG_STOP
#define DBG_STOP 0
#endif
__device__ __forceinline__ void dbg_dump(const Args& a, const bf16* src, size_t n_el) {
    const size_t T = (size_t)gridDim.x * 512, t = (size_t)blockIdx.x * 512 + threadIdx.x, total = 58720256;
    for (size_t i = t; i < total; i += T) { float v = 0.f; if (i < n_el / 2) { const unsigned w = ((const unsigned*)src)[i]; v = bf_lo(w) + bf_hi(w); } a.out[i] = v; }
}
__device__ __forceinline__ void dbg_dump_f32(const Args& a, const float* src, size_t n_el) {
    const size_t T = (size_t)gridDim.x * 512, t = (size_t)blockIdx.x * 512 + threadIdx.x, total = 58720256;
    for (size_t i = t; i < total; i += T) a.out[i] = i < n_el ? src[i] : 0.f;
}
#define XB_TMO      128
#define XB_XCNT(j)  (256  + 64 * (j))
#define XB_XSUB(j)  (1280 + 64 * (j))
#define XB_XGEN(j)  (2304 + 64 * (j))
#define XB_TOP      3328
#define XB_TOPGEN   3392
#define XCD_BAR_WORDS 3456
#define XB_SPIN_CAP (1u << 18)

__device__ __forceinline__ unsigned xb_ld(unsigned* p)              { return __hip_atomic_load(p, __ATOMIC_RELAXED, __HIP_MEMORY_SCOPE_AGENT); }
__device__ __forceinline__ unsigned xb_add(unsigned* p, unsigned v) { return __hip_atomic_fetch_add(p, v, __ATOMIC_RELAXED, __HIP_MEMORY_SCOPE_AGENT); }
__device__ __forceinline__ unsigned xb_xcc_id() { return (unsigned)__builtin_amdgcn_s_getreg((3 << 11) | 20) & 0xFu; }
#define XB_SPIN(cond, bar) do { unsigned _sp = 0; while (cond) { __builtin_amdgcn_s_sleep(1); \
    if ((++_sp & 255u) == 0u) { if (xb_ld(&(bar)[XB_TMO])) break; if (_sp > XB_SPIN_CAP) { atomicAdd(&(bar)[XB_TMO], 1u); break; } } } } while (0)

struct XcdBarrier {
    unsigned* bar; unsigned x;
    volatile LAS unsigned* st;
};

__device__ __forceinline__ XcdBarrier xcd_barrier_post(unsigned* bar, volatile LAS unsigned* st) {
    XcdBarrier b; b.bar = bar; b.x = xb_xcc_id(); b.st = st;
    if (threadIdx.x == 0) (void)xb_add(&bar[XB_XCNT(b.x)], 1u);
    return b;
}
__device__ __forceinline__ void xcd_barrier_complete(unsigned* bar, unsigned x, unsigned& nloc, unsigned& nx) {
    const unsigned G = gridDim.x * gridDim.y * gridDim.z;
    unsigned sum, cnt, mine, sp = 0u;
    for (;;) {
        sum = 0u; cnt = 0u; mine = 0u;
#pragma unroll
        for (unsigned j = 0; j < 16; ++j) { const unsigned c = xb_ld(&bar[XB_XCNT(j)]); sum += c; cnt += (c > 0u) ? 1u : 0u; mine = (j == x) ? c : mine; }
        if (sum == G) break;
        __builtin_amdgcn_s_sleep(1);
        if ((++sp & 255u) == 0u) { if (xb_ld(&bar[XB_TMO])) break; if (sp > XB_SPIN_CAP) { atomicAdd(&bar[XB_TMO], 1u); break; } }
    }
    nloc = mine > 0u ? mine : 1u; nx = cnt > 0u ? cnt : 1u;
}

__device__ __forceinline__ void xcd_barrier(const XcdBarrier& b) {
    asm volatile("s_waitcnt vmcnt(0)" ::: "memory");
    __syncthreads();
    if (threadIdx.x == 0) {
        unsigned* bar = b.bar;
        __builtin_amdgcn_s_waitcnt(0);
        unsigned nloc = b.st[0], nx = b.st[1];
        if (nloc == 0u) { xcd_barrier_complete(bar, b.x, nloc, nx); b.st[0] = nloc; b.st[1] = nx; }
        const unsigned old = xb_add(&bar[XB_XSUB(b.x)], 1u);
        const unsigned gen = old / nloc;
        if (old + 1u == (gen + 1u) * nloc) {
            __builtin_amdgcn_fence(__ATOMIC_RELEASE, "agent");
            asm volatile("s_waitcnt vmcnt(0)" ::: "memory");
            const unsigned og = xb_add(&bar[XB_TOP], 1u);
            const unsigned tg = og / nx;
            if (og + 1u == (tg + 1u) * nx) xb_add(&bar[XB_TOPGEN], 1u);
            else XB_SPIN(xb_ld(&bar[XB_TOPGEN]) == tg, bar);
            __builtin_amdgcn_fence(__ATOMIC_ACQUIRE, "agent");
            xb_add(&bar[XB_XGEN(b.x)], 1u);
            asm volatile("s_waitcnt vmcnt(0)" ::: "memory");
        } else {
            XB_SPIN(xb_ld(&bar[XB_XGEN(b.x)]) == gen, bar);
            __builtin_amdgcn_fence(__ATOMIC_ACQUIRE, "agent");
            asm volatile("s_waitcnt vmcnt(0)" ::: "memory");
        }
    }
    __syncthreads();
}

__global__ void __launch_bounds__(512, 2) fwd(Args a) {
    extern __shared__ __attribute__((aligned(16))) unsigned char lds_raw[];
    cg::grid_group grid = cg::this_grid();
    LAS unsigned char* lds = (LAS unsigned char*)lds_raw;
    const int tid = threadIdx.x, lane = tid & 63, wave = __builtin_amdgcn_readfirstlane(tid >> 6);
    const int G = gridDim.x, c = blockIdx.x, vcu = (G % 8 == 0) ? (c % 8) * (G / 8) + c / 8 : c, gw = vcu * NW + wave, NGW = G * NW;
    unsigned char* ws = a.ws;
    { volatile LAS unsigned* misc = (volatile LAS unsigned*)(lds + MISC_OFF); if (tid < 32) misc[tid] = 0u; }
    __syncthreads();
    XcdBarrier bar = xcd_barrier_post((unsigned*)(ws + WS_CTL), (volatile LAS unsigned*)(lds + MISC_OFF) + 8);
    bf16* XB = (bf16*)(ws + WS_XB); float* YP = (float*)(ws + WS_YP);
    bf16* R1 = (bf16*)(ws + WS_R1);
#define GEMM(EPI, E, Ap, Bp, LD, M1, N, K, SPLIT, CLIST) do { pg8::Gemm g_{(const pg8::bf16_t*)(Ap), (const pg8::bf16_t*)(Bp), (LD)}; pg8::Order S_; S_.init((M1), (N), (K), (SPLIT), G, c); \
        pg8::gemm_phase<EPI, pg8::Order, true, true>(lds, g_, S_, E); if (DBL_GEMM) pg8::gemm_phase<EPI, pg8::Order, true, true>(lds, g_, S_, E); \
        if ((CLIST) > 0) { const int nbusy_ = S_.so.nwg % G;   \
            if (nbusy_ == 0) convert_list(a, lds, (CLIST), gw, NGW, wave, lane); else if (c >= nbusy_) convert_list(a, lds, (CLIST), (c - nbusy_) * NW + wave, (G - nbusy_) * NW, wave, lane); } } while (0)

#define GRID_SYNC() do { asm volatile("s_waitcnt vmcnt(0) lgkmcnt(0)" ::: "memory"); grid.sync(); } while (0)
#define XCD_SYNC() xcd_barrier(bar)

#define DBG_DUMP_1 dbg_dump(a, XB, (size_t)MT * DM)
#define DBG_DUMP_2 dbg_dump(a, R1, (size_t)2 * MT * DM)
#define DBG_DUMP_3 dbg_dump(a, R1 + (size_t)2 * MT * DM, (size_t)MT * DM)
#define DBG_DUMP_4 dbg_dump_f32(a, YP, (size_t)2 * MP * DM)
#define DBG_DUMP_5 dbg_dump(a, XB, (size_t)MT * DM)
#define DBG_DUMP_6 dbg_dump(a, R1, (size_t)MT * FF)
#define DBG_DUMP_7 dbg_dump_f32(a, YP, (size_t)2 * MP * DM)
#define DBG_DUMP_8 dbg_dump(a, XB, (size_t)MT * DM)
#define DBG_DUMP_9 dbg_dump(a, R1, (size_t)6 * MT * DM)
#define DBG_DUMP_10 dbg_dump(a, (const bf16*)YP, (size_t)2 * MT * DM)
#define DBG_DUMP_11 dbg_dump(a, R1 + (size_t)4 * MT * DM, (size_t)2 * MT * DM)
#define DBG_DUMP_12 dbg_dump_f32(a, YP, (size_t)2 * MP * DM)
#define DBG_DUMP_13 dbg_dump(a, XB, (size_t)MT * DM)
#define DBG_DUMP_14 dbg_dump(a, R1, (size_t)MT * FF)
#define DBG_DUMP_15 dbg_dump_f32(a, YP, (size_t)2 * MP * DM)
    p0_prologue(a, lds, gw, NGW, wave, lane);
    if (a.out == nullptr) GRID_SYNC();
    XCD_SYNC();
    if (DBG_STOP == 1) { DBG_DUMP_1; return; }
    { pg8::EpiGeluUV E{R1, R1 + (size_t)MT * DM, (pg8::f32x2*)(ws + WS_STAT)}; GEMM(pg8::EpiGeluUV, E, XB, ws + WS_WAIN, 2048, MT, 4096, 2048, 0, 1); }
    XCD_SYNC();
    if (DBG_STOP == 2) { DBG_DUMP_2; return; }
    mix_phase(a, lds, wave, lane);
    XCD_SYNC();
    if (DBG_STOP == 3) { DBG_DUMP_3; return; }
    { pg8::EpiPart E{YP}; GEMM(pg8::EpiPart, E, ws + WS_R1 + 72 * MiB, ws + WS_WAOUT, 2048, MP, 2048, 2048, 1, 0); }
    XCD_SYNC();
    if (DBG_STOP == 4) { DBG_DUMP_4; return; }
    ln_pass(a.in[0], a.in[1], nullptr, YP, a.in[13], a.in[14], nullptr, XB, gw, NGW, lane);
    XCD_SYNC();
    if (DBG_STOP == 5) { DBG_DUMP_5; return; }
    { pg8::EpiSwiglu E{R1}; GEMM(pg8::EpiSwiglu, E, XB, ws + WS_WFIN, 2048, MT, 11264, 2048, 0, 2); }
    XCD_SYNC();
    if (DBG_STOP == 6) { DBG_DUMP_6; return; }
    { pg8::EpiPart E{YP}; GEMM(pg8::EpiPart, E, R1, ws + WS_WFOUT, 5632, MP, 2048, 5632, 1, 0); }
    XCD_SYNC();
    if (DBG_STOP == 7) { DBG_DUMP_7; return; }
    ln_pass(nullptr, nullptr, XB, YP, a.in[15], a.in[16], nullptr, XB, gw, NGW, lane);
    XCD_SYNC();
    if (DBG_STOP == 8) { DBG_DUMP_8; return; }
    { pg8::EpiQKVG E{R1, R1 + (size_t)MT * DM, (pg8::bf16_t*)(ws + WS_R1 + 72 * MiB), (pg8::bf16_t*)(ws + WS_R1 + 144 * MiB), (const float*)(ws + WS_ROPE), (const float*)(ws + WS_ROPE) + 2080 * 128};
      GEMM(pg8::EpiQKVG, E, XB, ws + WS_WBIN, 2048, MT, 12288, 2048, 0, 3); }
    XCD_SYNC();
    if (DBG_STOP == 9) { DBG_DUMP_9; return; }
    ret_phase(a, lds, wave, lane);
    XCD_SYNC();
    if (DBG_STOP == 10) { DBG_DUMP_10; return; }
    gn_gate(a, gw, NGW, lane);
    XCD_SYNC();
    if (DBG_STOP == 11) { DBG_DUMP_11; return; }
    { pg8::EpiPart E{YP}; GEMM(pg8::EpiPart, E, ws + WS_R1 + 144 * MiB, ws + WS_WBOUT, 4096, MP, 2048, 4096, 1, 0); }
    XCD_SYNC();
    if (DBG_STOP == 12) { DBG_DUMP_12; return; }
    ln_pass(nullptr, nullptr, XB, YP, a.in[13] + DM, a.in[14] + DM, nullptr, XB, gw, NGW, lane);
    XCD_SYNC();
    if (DBG_STOP == 13) { DBG_DUMP_13; return; }
    { pg8::EpiSwiglu E{R1}; GEMM(pg8::EpiSwiglu, E, XB, ws + WS_WFIN + 44 * MiB, 2048, MT, 11264, 2048, 0, 4); }
    XCD_SYNC();
    if (DBG_STOP == 14) { DBG_DUMP_14; return; }
    { pg8::EpiPart E{YP}; GEMM(pg8::EpiPart, E, R1, ws + WS_WFOUT + 22 * MiB, 5632, MP, 2048, 5632, 1, 0); }
    XCD_SYNC();
    if (DBG_STOP == 15) { DBG_DUMP_15; return; }
    ln_pass(nullptr, nullptr, XB, YP, a.in[15] + DM, a.in[16] + DM, a.out, nullptr, gw, NGW, lane);
#undef GEMM
}

extern "C" void kernel_launch(void* const* d_in, const int* in_sizes, int n_in, void* d_out, int out_size, void* d_ws, size_t ws_size, hipStream_t stream) {
    static int grid = 0;
    if (grid == 0) {
        if (n_in != 17 || ws_size < WS_END) { fprintf(stderr, "kernel_launch: needs 17 inputs and >= %zu bytes of workspace (got %d, %zu)\n", (size_t)WS_END, n_in, ws_size); grid = -1; return; }
        int dev = 0, cus = 0, per_cu = 0;
        if (hipGetDevice(&dev) != hipSuccess || hipDeviceGetAttribute(&cus, hipDeviceAttributeMultiprocessorCount, dev) != hipSuccess) { grid = -1; return; }
        if (hipFuncSetAttribute((const void*)fwd, hipFuncAttributeMaxDynamicSharedMemorySize, LDS_BYTES) != hipSuccess) { fprintf(stderr, "kernel_launch: hipFuncSetAttribute failed\n"); grid = -1; return; }
        if (hipOccupancyMaxActiveBlocksPerMultiprocessor(&per_cu, (const void*)fwd, NW * 64, LDS_BYTES) != hipSuccess || per_cu < 1) { fprintf(stderr, "kernel_launch: occupancy query reports %d workgroups per CU\n", per_cu); grid = -1; return; }
        grid = cus;
    }
    if (grid < 0) return;
    if (hipMemsetAsync((char*)d_ws + WS_CTL, 0, CTL_BYTES, stream) != hipSuccess) { fprintf(stderr, "kernel_launch: hipMemsetAsync failed\n"); return; }
    Args a{};
    for (int i = 0; i < 17; ++i) a.in[i] = (const float*)d_in[i];
    a.out = (float*)d_out; a.ws = (unsigned char*)d_ws;
    void* args[] = {&a};
    const hipError_t e = hipLaunchCooperativeKernel((const void*)fwd, dim3(grid), dim3(NW * 64), args, LDS_BYTES, stream);
    if (e != hipSuccess) fprintf(stderr, "kernel_launch: cooperative launch failed: %s (grid %d)\n", hipGetErrorString(e), grid);
}
```

```cpp
#ifndef DBL_GEMM
#define DBL_GEMM 0
#endif
#include <hip/hip_runtime.h>
#include <hip/hip_cooperative_groups.h>
#include <cstdio>
#include <cstdint>
namespace cg = cooperative_groups;

constexpr int DM = 2048, MP = 8192, MS = 1024, MT = MP + MS, FF = 5632, NQKVG = 12288, RV = 4096;
constexpr float ALPHA = 1.41421356237309515f;
constexpr float LN_EPS = 1e-5f, GN_EPS = 1e-6f;

namespace pg8 {
#define PG8_LAS __attribute__((address_space(3)))
typedef unsigned short bf16_t;
typedef short bf16x8 __attribute__((ext_vector_type(8)));
typedef float f32x4 __attribute__((ext_vector_type(4)));
typedef unsigned u32x4 __attribute__((ext_vector_type(4)));
constexpr int BM = 256, BK = 64, HALF = 128, HTB = HALF * BK * 2  , STAGE_BYTES = 8 * HTB, NXCD = 8, WGM = 4;

__host__ __device__ __forceinline__ int lds_byte(int r, int c) { const int st = (r >> 4) * 2 + (c >> 5), rr = r & 15, cc = c & 31, ob = rr * 64 + cc * 2; return st * 1024 + (ob ^ (((ob >> 9) & 1) << 5)); }
__host__ __device__ __forceinline__ void stage_rc(int b, int& R, int& C) { const int st = b / 1024, sb = b % 1024, swz = sb ^ (((sb >> 9) & 1) << 5); R = (st >> 1) * 16 + swz / 64; C = (st & 1) * 32 + (swz % 64) / 2; }
__host__ __device__ __forceinline__ int perm32(int rho) { const int n = rho >> 4, i = rho & 15; return 8 * (i >> 2) + 4 * n + (i & 3); }

struct Unit { int pm, pn, k0, nt, ks; };
struct Gemm { const bf16_t* A; const bf16_t* Bt; int ld; };

struct StaticOrder {
    int nM, nN, nwg, G, c;
    __host__ __device__ void init(int M, int N, int G_, int c_) { nM = M / BM; nN = N / BM; nwg = nM * nN; G = G_; c = c_; }
    __host__ __device__ __forceinline__ void tile(int L, int& pm_, int& pn_) const {
        int wgid = L; { const int q = nwg / NXCD, r = nwg % NXCD, xcd = wgid % NXCD, off = wgid / NXCD; wgid = (xcd < r ? xcd * (q + 1) : r * (q + 1) + (xcd - r) * q) + off; }
        const int nig = WGM * nN, gid = wgid / nig, fm = gid * WGM, gsz = (nM - fm) < WGM ? (nM - fm) : WGM;
        pm_ = fm + ((wgid % nig) % gsz); pn_ = (wgid % nig) / gsz;
    }
    __device__ __forceinline__ void a_ready(const Unit&) const {}
    __device__ __forceinline__ void done(const Unit&) const {}
};

typedef float f32x2_cv __attribute__((ext_vector_type(2))); typedef __bf16 bf16x2_cv __attribute__((ext_vector_type(2)));
__device__ __forceinline__ unsigned cvt_pk_bf16(float lo, float hi) { const f32x2_cv v = {lo, hi}; const bf16x2_cv b = __builtin_convertvector(v, bf16x2_cv); return __builtin_bit_cast(unsigned, b); }
typedef float f32x2 __attribute__((ext_vector_type(2)));
__device__ __forceinline__ f32x2 gelu_pk(f32x2 v) {
    const f32x2 av = __builtin_elementwise_abs(v), d = av * 0.2316418882f + 1.0f;
    f32x2 t; t.x = __builtin_amdgcn_rcpf(d.x); t.y = __builtin_amdgcn_rcpf(d.y);
    f32x2 q = t * 0.5307027145f + (-0.7265760135f); q = q * t + 0.7107068705f; q = q * t + (-0.142248368f); q = q * t + 0.127414796f; q = q * t;
    const f32x2 s = (v * v) * (-0.72134752044f);
    f32x2 e; e.x = __builtin_amdgcn_exp2f(s.x); e.y = __builtin_amdgcn_exp2f(s.y);
    const f32x2 m = v * (q * e), r = v - m;
    f32x2 o; o.x = v.x < 0.f ? m.x : r.x; o.y = v.y < 0.f ? m.y : r.y; return o;
}
struct Order {
    StaticOrder so; int G, c, n1c, ntk, split;
    __device__ __forceinline__ void init(int M1, int N, int K, int split_, int G_, int c_) { so.init(M1, N, G_, c_); G = G_; c = c_; ntk = K / BK; split = split_; n1c = (c < so.nwg) ? (so.nwg - c + G - 1) / G : 0; }
    __device__ __forceinline__ bool next(int i, Unit& u) const {
        const bool p1 = i < n1c; int pm1, pn1; so.tile(p1 ? i * G + c : 0, pm1, pn1);
        const int j = (i - n1c) * G + c; const bool p2 = !p1 && split != 0 && j < 256;
        const int ks = j & 7, jj = (j >> 3) & 31, b = (ntk >> 3) & ~1, rem2 = (ntk - 8 * b) >> 1;
        Unit r; r.pm = p1 ? pm1 : so.nM + (jj & 3); r.pn = p1 ? pn1 : (jj >> 2); r.k0 = p1 ? 0 : (ks * b + 2 * (ks < rem2 ? ks : rem2)) * BK; r.nt = p1 ? ntk : b + (ks < rem2 ? 2 : 0); r.ks = p1 ? -1 : ks;
        u = r; return p1 || p2;
    }
    __device__ __forceinline__ void a_ready(const Unit&) const {}
    __device__ __forceinline__ void done(const Unit&) const {}
};

__device__ __forceinline__ float silu_f(float x) { return x * __builtin_amdgcn_rcpf(1.0f + __builtin_amdgcn_exp2f(-1.4426950408889634f * x)); }

struct EpiPart {
    static constexpr bool PERM = true, AFTER_DRAIN = false;
    bf16_t* Yb; float* Ys;
    __device__ __forceinline__ void operator()(const f32x4 (&acc)[2][2][4][2], const Unit& u, int wr, int wc, int fr, int fq) const {
        const int row0 = u.pm * BM + wr * 64 + fr, col0 = u.pn * BM + wc * 32 + 8 * fq;
        if (u.ks < 0) {
#pragma unroll
            for (int ai = 0; ai < 2; ++ai)
#pragma unroll
                for (int m = 0; m < 4; ++m) { bf16_t* rowp = Yb + (size_t)(row0 + ai * HALF + m * 16) * 2048 + col0;
#pragma unroll
                    for (int bj = 0; bj < 2; ++bj) { const f32x4 v0 = acc[ai][bj][m][0], v1 = acc[ai][bj][m][1];
                        u32x4 w; w.x = cvt_pk_bf16(v0[0], v0[1]); w.y = cvt_pk_bf16(v0[2], v0[3]); w.z = cvt_pk_bf16(v1[0], v1[1]); w.w = cvt_pk_bf16(v1[2], v1[3]);
                        *(u32x4*)(rowp + bj * HALF) = w; } }
        } else {
#pragma unroll
            for (int ai = 0; ai < 2; ++ai)
#pragma unroll
                for (int m = 0; m < 4; ++m) { float* rowp = Ys + (size_t)(row0 - 8192 + u.ks * 1024 + ai * HALF + m * 16) * 2048 + col0;
#pragma unroll
                    for (int bj = 0; bj < 2; ++bj) { *(f32x4*)(rowp + bj * HALF) = acc[ai][bj][m][0]; *(f32x4*)(rowp + bj * HALF + 4) = acc[ai][bj][m][1]; } }
        }
    }
};
struct EpiGeluUV {
    static constexpr bool PERM = true, AFTER_DRAIN = false;
    bf16_t* U; bf16_t* V; f32x2* stat;
    __device__ __forceinline__ void operator()(const f32x4 (&acc)[2][2][4][2], const Unit& u, int wr, int wc, int fr, int fq) const {
        const bool isv = u.pn >= 8; bf16_t* O = isv ? V : U;
        const int row0 = u.pm * BM + wr * 64 + fr, col0 = (u.pn & 7) * BM + wc * 32 + 8 * fq;
#pragma unroll
        for (int ai = 0; ai < 2; ++ai)
#pragma unroll
            for (int m = 0; m < 4; ++m) { const int row = row0 + ai * HALF + m * 16; bf16_t* rowp = O + (size_t)row * 2048 + col0; float s = 0.f, q = 0.f;
#pragma unroll
                for (int bj = 0; bj < 2; ++bj) { const f32x4 v0 = acc[ai][bj][m][0], v1 = acc[ai][bj][m][1];
                    const f32x2 a = gelu_pk((f32x2){v0[0], v0[1]}), b = gelu_pk((f32x2){v0[2], v0[3]}), c = gelu_pk((f32x2){v1[0], v1[1]}), d = gelu_pk((f32x2){v1[2], v1[3]});
                    s += ((a.x + a.y) + (b.x + b.y)) + ((c.x + c.y) + (d.x + d.y));
                    q += ((a.x * a.x + a.y * a.y) + (b.x * b.x + b.y * b.y)) + ((c.x * c.x + c.y * c.y) + (d.x * d.x + d.y * d.y));
                    u32x4 w; w.x = cvt_pk_bf16(a.x, a.y); w.y = cvt_pk_bf16(b.x, b.y); w.z = cvt_pk_bf16(c.x, c.y); w.w = cvt_pk_bf16(d.x, d.y);
                    *(u32x4*)(rowp + bj * HALF) = w; }
                if (isv) { s += __shfl_xor(s, 16); s += __shfl_xor(s, 32); q += __shfl_xor(q, 16); q += __shfl_xor(q, 32);
                    if (fq == 0) stat[(size_t)row * 32 + (u.pn - 8) * 4 + wc] = (f32x2){s, q}; } }
    }
};
struct EpiSwiglu {
    static constexpr bool PERM = true, AFTER_DRAIN = false;
    bf16_t* H;
    __device__ __forceinline__ void operator()(const f32x4 (&acc)[2][2][4][2], const Unit& u, int wr, int wc, int fr, int fq) const {
        const int row0 = u.pm * BM + wr * 64 + fr, col0 = u.pn * HALF + wc * 32 + 8 * fq;
#pragma unroll
        for (int ai = 0; ai < 2; ++ai)
#pragma unroll
            for (int m = 0; m < 4; ++m) { bf16_t* rowp = H + (size_t)(row0 + ai * HALF + m * 16) * 5632 + col0;
                const f32x4 g0 = acc[ai][0][m][0], g1 = acc[ai][0][m][1], u0 = acc[ai][1][m][0], u1 = acc[ai][1][m][1];
                u32x4 w; w.x = cvt_pk_bf16(silu_f(g0[0]) * u0[0], silu_f(g0[1]) * u0[1]); w.y = cvt_pk_bf16(silu_f(g0[2]) * u0[2], silu_f(g0[3]) * u0[3]);
                w.z = cvt_pk_bf16(silu_f(g1[0]) * u1[0], silu_f(g1[1]) * u1[1]); w.w = cvt_pk_bf16(silu_f(g1[2]) * u1[2], silu_f(g1[3]) * u1[3]);
                *(u32x4*)rowp = w; }
    }
};
__device__ __forceinline__ float lg2gamma(int h) {
    const double x = 1.0 / (double)(32 << h); double p = x, s = 0.0;
    const double inv[8] = {1.0, 0.5, 1.0 / 3.0, 0.25, 0.2, 1.0 / 6.0, 1.0 / 7.0, 0.125};
#pragma unroll
    for (int k = 0; k < 8; ++k) { s -= p * inv[k]; p *= x; }
    return (float)(s * 1.4426950408889634);
}
struct EpiQKVG {
    static constexpr bool PERM = true, AFTER_DRAIN = false;
    bf16_t *QH, *KH, *VB, *GS; const float* ropec; const float* ropes;
    __device__ __forceinline__ void operator()(const f32x4 (&acc)[2][2][4][2], const Unit& u, int wr, int wc, int fr, int fq) const {
        const int row0 = u.pm * BM + wr * 64 + fr, cw = wc * 32 + 8 * fq;
        if (u.pn < 16) {
            const bool isq = u.pn < 8; const int head = u.pn & 7; bf16_t* O = (isq ? QH : KH) + head * 256 + cw;
            const float lg = lg2gamma(head) * (isq ? 1.f : -1.f), sc0 = isq ? 0.0625f : 1.f;
#pragma unroll
            for (int ai = 0; ai < 2; ++ai)
#pragma unroll
                for (int m = 0; m < 4; ++m) { const int row = row0 + ai * HALF + m * 16;
                    const int pidx = row < MP ? (row & 2047) : 2048 + ((row - MP) & 31), ib = row < MP ? (row & 63) : ((row - MP) & 31);
                    const float sc = sc0 * __builtin_amdgcn_exp2f(lg * (float)ib);
                    const f32x4 c0 = *(const f32x4*)(ropec + pidx * 128 + cw), c1 = *(const f32x4*)(ropec + pidx * 128 + cw + 4);
                    const f32x4 s0 = *(const f32x4*)(ropes + pidx * 128 + cw), s1 = *(const f32x4*)(ropes + pidx * 128 + cw + 4);
                    const f32x4 a0 = acc[ai][0][m][0], a1 = acc[ai][0][m][1], b0 = acc[ai][1][m][0], b1 = acc[ai][1][m][1];
                    const f32x4 o0 = (a0 * c0 - b0 * s0) * sc, o1 = (a1 * c1 - b1 * s1) * sc, p0 = (a0 * s0 + b0 * c0) * sc, p1 = (a1 * s1 + b1 * c1) * sc;
                    u32x4 w; w.x = cvt_pk_bf16(o0[0], o0[1]); w.y = cvt_pk_bf16(o0[2], o0[3]); w.z = cvt_pk_bf16(o1[0], o1[1]); w.w = cvt_pk_bf16(o1[2], o1[3]);
                    *(u32x4*)(O + (size_t)row * 2048) = w;
                    w.x = cvt_pk_bf16(p0[0], p0[1]); w.y = cvt_pk_bf16(p0[2], p0[3]); w.z = cvt_pk_bf16(p1[0], p1[1]); w.w = cvt_pk_bf16(p1[2], p1[3]);
                    *(u32x4*)(O + (size_t)row * 2048 + HALF) = w; }
        } else {
            const bool isg = u.pn >= 32; bf16_t* O = (isg ? GS : VB) + ((u.pn - 16) & 15) * BM + cw;
#pragma unroll
            for (int ai = 0; ai < 2; ++ai)
#pragma unroll
                for (int m = 0; m < 4; ++m) { bf16_t* rowp = O + (size_t)(row0 + ai * HALF + m * 16) * 4096;
#pragma unroll
                    for (int bj = 0; bj < 2; ++bj) { f32x4 v0 = acc[ai][bj][m][0], v1 = acc[ai][bj][m][1];
                        if (isg) { v0 = (f32x4){silu_f(v0[0]), silu_f(v0[1]), silu_f(v0[2]), silu_f(v0[3])}; v1 = (f32x4){silu_f(v1[0]), silu_f(v1[1]), silu_f(v1[2]), silu_f(v1[3])}; }
                        u32x4 w; w.x = cvt_pk_bf16(v0[0], v0[1]); w.y = cvt_pk_bf16(v0[2], v0[3]); w.z = cvt_pk_bf16(v1[0], v1[1]); w.w = cvt_pk_bf16(v1[2], v1[3]);
                        *(u32x4*)(rowp + bj * HALF) = w; } }
        }
    }
};
template <class Epi, class Sched, bool ALIGN_EPI = false, bool SP2 = false>
__device__ __forceinline__ void gemm_phase(PG8_LAS unsigned char* lds, const Gemm g, const Sched& S, const Epi& E) {
    int tid_ = threadIdx.x; asm volatile("" : "+v"(tid_));
    const int tid = tid_, wid = __builtin_amdgcn_readfirstlane(tid >> 6), lane = tid & 63, wr = wid >> 2, wc = wid & 3, fr = lane & 15, fq = lane >> 4;
    const int K = g.ld;
    unsigned voffA[2], voffB[2];
#pragma unroll
    for (int i = 0; i < 2; ++i) { int R, C; stage_rc(tid * 16 + i * 8192, R, C); const int Rb = Epi::PERM ? ((R & ~31) + perm32(R & 31)) : R;
        voffA[i] = (unsigned)(R * K + C) * 2u; voffB[i] = (unsigned)(Rb * K + C) * 2u; }
    const size_t kstep = (size_t)(BK * 2);
    const size_t hstep = (size_t)HALF * K * 2;
    const size_t tstep = 2 * hstep;
    const unsigned ldsw = (unsigned)wid * 1024u;
    const int aoff = lds_byte(wr * 64 + fr, fq * 8), boff = lds_byte(wc * 32 + fr, fq * 8);
#define PG8_SA(b, h) (((b) * 2 + (h)) * HTB)
#define PG8_SB(b, h) ((4 + (b) * 2 + (h)) * HTB)
#define PG8_STAGE(bufoff, gbase, voff) do { _Pragma("unroll") for (int _i = 0; _i < 2; ++_i) \
        __builtin_amdgcn_global_load_lds((const unsigned*)((const char*)(gbase) + (voff)[_i]), (PG8_LAS unsigned*)(lds + (bufoff) + ldsw + _i * 8192), 16, 0, 0); } while (0)
#define PG8_LDA(dst, b, h) do { _Pragma("unroll") for (int m = 0; m < 4; ++m) _Pragma("unroll") for (int k = 0; k < 2; ++k) dst[m][k] = *(const PG8_LAS bf16x8*)(lds + PG8_SA(b, h) + aoff + m * 2048 + k * 1024); } while (0)
#define PG8_LDB(dst, b, h) do { _Pragma("unroll") for (int n = 0; n < 2; ++n) _Pragma("unroll") for (int k = 0; k < 2; ++k) dst[n][k] = *(const PG8_LAS bf16x8*)(lds + PG8_SB(b, h) + boff + n * 2048 + k * 1024); } while (0)
#define PG8_MMA(ai, bj, At, Bt) do { __builtin_amdgcn_s_setprio(1); _Pragma("unroll") for (int m = 0; m < 4; ++m) _Pragma("unroll") for (int n = 0; n < 2; ++n) _Pragma("unroll") for (int k = 0; k < 2; ++k) \
        acc[ai][bj][m][n] = __builtin_amdgcn_mfma_f32_16x16x32_bf16(Bt[n][k], At[m][k], acc[ai][bj][m][n], 0, 0, 0); __builtin_amdgcn_s_setprio(0); } while (0)
#define PG8_WAIT_V(n) asm volatile("s_waitcnt vmcnt(" #n ")" ::: "memory")
#define PG8_WAIT_L(n) asm volatile("s_waitcnt lgkmcnt(" #n ")" ::: "memory")
#define PG8_BAR __builtin_amdgcn_s_barrier()
#define PG8_SCHED __builtin_amdgcn_sched_barrier(0)
    Unit cur, nxt; int ui = 0;
    if (!S.next(0, cur)) return;
    f32x4 acc[2][2][4][2];
#pragma unroll
    for (int a = 0; a < 2; ++a)
#pragma unroll
        for (int b = 0; b < 2; ++b)
#pragma unroll
            for (int m = 0; m < 4; ++m)
#pragma unroll
                for (int n = 0; n < 2; ++n) acc[a][b][m][n] = (f32x4){0.f, 0.f, 0.f, 0.f};
    bf16x8 At[4][2], B0[2][2], B1[2][2];
    const char* cA = (const char*)g.A + (size_t)cur.pm * tstep + (size_t)cur.k0 * 2; const char* cB = (const char*)g.Bt + (size_t)cur.pn * tstep + (size_t)cur.k0 * 2; int nt = cur.nt;
    S.a_ready(cur);
    if constexpr (SP2) {
        PG8_STAGE(PG8_SB(0, 0), cB, voffB); PG8_STAGE(PG8_SB(0, 1), cB + hstep, voffB); PG8_STAGE(PG8_SA(0, 0), cA, voffA); PG8_STAGE(PG8_SA(0, 1), cA + hstep, voffA);
        if (wr == 1) PG8_BAR;
        PG8_WAIT_V(2); PG8_BAR;
        PG8_STAGE(PG8_SB(1, 0), cB + kstep, voffB); PG8_STAGE(PG8_SA(1, 0), cA + kstep, voffA); PG8_STAGE(PG8_SB(1, 1), cB + hstep + kstep, voffB);
        PG8_WAIT_V(6); PG8_BAR;
    } else {
        PG8_STAGE(PG8_SB(0, 0), cB, voffB); PG8_STAGE(PG8_SA(0, 0), cA, voffA); PG8_STAGE(PG8_SB(0, 1), cB + hstep, voffB); PG8_STAGE(PG8_SA(0, 1), cA + hstep, voffA);
        if (wr == 1) PG8_BAR;
        PG8_WAIT_V(4); PG8_BAR;
        PG8_STAGE(PG8_SB(1, 0), cB + kstep, voffB); PG8_STAGE(PG8_SA(1, 0), cA + kstep, voffA); PG8_STAGE(PG8_SB(1, 1), cB + hstep + kstep, voffB);
        PG8_WAIT_V(6); PG8_BAR;
    }
    for (;;) {
        const bool has_next = S.next(ui + 1, nxt);
        const char* nA = has_next ? (const char*)g.A + (size_t)nxt.pm * tstep + (size_t)nxt.k0 * 2 : cA; const char* nB = has_next ? (const char*)g.Bt + (size_t)nxt.pn * tstep + (size_t)nxt.k0 * 2 : cB;
        for (int t = 0; t < nt; t += 2) {
            const bool last = (t == nt - 2);
            const char* a1 = cA + (size_t)(t + 1) * kstep;
            const char* a2 = last ? nA : cA + (size_t)(t + 2) * kstep; const char* b2 = last ? nB : cB + (size_t)(t + 2) * kstep;
            const char* a3 = a2 + kstep; const char* b3 = b2 + kstep;
            if (last && has_next) S.a_ready(nxt);
            if constexpr (SP2) {
            PG8_LDB(B0, 0, 0); PG8_LDB(B1, 0, 1); PG8_SCHED; PG8_LDA(At, 0, 0); PG8_STAGE(PG8_SA(1, 1), a1 + hstep, voffA);
            PG8_WAIT_V(8); PG8_WAIT_L(0); PG8_BAR; PG8_MMA(0, 0, At, B0); PG8_MMA(0, 1, At, B1); PG8_BAR; PG8_SCHED;
            PG8_LDA(At, 0, 1); PG8_STAGE(PG8_SB(0, 0), b2, voffB); PG8_STAGE(PG8_SB(0, 1), b2 + hstep, voffB); PG8_STAGE(PG8_SA(0, 0), a2, voffA);
            PG8_WAIT_V(8); PG8_WAIT_L(0); PG8_BAR; PG8_MMA(1, 0, At, B0); PG8_MMA(1, 1, At, B1); PG8_BAR; PG8_SCHED;
            PG8_LDB(B0, 1, 0); PG8_LDB(B1, 1, 1); PG8_SCHED; PG8_LDA(At, 1, 0); PG8_STAGE(PG8_SA(0, 1), a2 + hstep, voffA);
            PG8_WAIT_V(8); PG8_WAIT_L(0); PG8_BAR; PG8_MMA(0, 0, At, B0); PG8_MMA(0, 1, At, B1); PG8_BAR; PG8_SCHED;
            PG8_LDA(At, 1, 1); PG8_STAGE(PG8_SB(1, 0), b3, voffB); PG8_STAGE(PG8_SB(1, 1), b3 + hstep, voffB); PG8_STAGE(PG8_SA(1, 0), a3, voffA);
            PG8_WAIT_V(8); PG8_WAIT_L(0); PG8_BAR; PG8_MMA(1, 0, At, B0); PG8_MMA(1, 1, At, B1); PG8_BAR; PG8_SCHED;
            } else {
            PG8_LDB(B0, 0, 0); PG8_SCHED; PG8_LDA(At, 0, 0); PG8_STAGE(PG8_SA(1, 1), a1 + hstep, voffA);
            PG8_WAIT_L(8); PG8_BAR; PG8_WAIT_L(0); PG8_MMA(0, 0, At, B0); PG8_BAR; PG8_SCHED;
            PG8_LDB(B1, 0, 1); PG8_STAGE(PG8_SB(0, 0), b2, voffB);
            PG8_BAR; PG8_WAIT_L(0); PG8_MMA(0, 1, At, B1); PG8_BAR;
            PG8_LDA(At, 0, 1); PG8_STAGE(PG8_SA(0, 0), a2, voffA);
            PG8_BAR; PG8_WAIT_L(0); PG8_MMA(1, 0, At, B0); PG8_BAR; PG8_SCHED;
            PG8_STAGE(PG8_SB(0, 1), b2 + hstep, voffB);
            PG8_WAIT_V(6); PG8_BAR; PG8_MMA(1, 1, At, B1); PG8_BAR;
            PG8_LDB(B0, 1, 0); PG8_SCHED; PG8_LDA(At, 1, 0); PG8_STAGE(PG8_SA(0, 1), a2 + hstep, voffA);
            PG8_WAIT_L(8); PG8_BAR; PG8_WAIT_L(0); PG8_MMA(0, 0, At, B0); PG8_BAR; PG8_SCHED;
            PG8_LDB(B1, 1, 1); PG8_STAGE(PG8_SB(1, 0), b3, voffB);
            PG8_BAR; PG8_WAIT_L(0); PG8_MMA(0, 1, At, B1); PG8_BAR;
            PG8_LDA(At, 1, 1); PG8_STAGE(PG8_SA(1, 0), a3, voffA);
            PG8_BAR; PG8_WAIT_L(0); PG8_MMA(1, 0, At, B0); PG8_BAR; PG8_SCHED;
            PG8_STAGE(PG8_SB(1, 1), b3 + hstep, voffB);
            PG8_WAIT_V(6); PG8_BAR; PG8_MMA(1, 1, At, B1); PG8_BAR;
            }
        }
        if constexpr (ALIGN_EPI) { if (wr == 0) PG8_BAR; }
        if constexpr (!Epi::AFTER_DRAIN) { E(acc, cur, wr, wc, fr, fq); S.done(cur); }
        if (!has_next) break;
#pragma unroll
        for (int a = 0; a < 2; ++a)
#pragma unroll
            for (int b = 0; b < 2; ++b)
#pragma unroll
                for (int m = 0; m < 4; ++m)
#pragma unroll
                    for (int n = 0; n < 2; ++n) acc[a][b][m][n] = (f32x4){0.f, 0.f, 0.f, 0.f};
        cur = nxt; cA = nA; cB = nB; nt = cur.nt; ++ui;
        if constexpr (ALIGN_EPI) { if (wr == 1) PG8_BAR; }
    }
    PG8_WAIT_V(0);
    if constexpr (!ALIGN_EPI) { if (wr == 0) PG8_BAR; }
    PG8_BAR;
    if constexpr (Epi::AFTER_DRAIN) { E.fused(acc, cur, wr, wc, fr, fq, lds, wid, lane); S.done(cur); }
#undef PG8_SA
#undef PG8_SB
#undef PG8_STAGE
#undef PG8_LDA
#undef PG8_LDB
#undef PG8_MMA
#undef PG8_WAIT_V
#undef PG8_WAIT_L
#undef PG8_BAR
#undef PG8_SCHED
}
}
constexpr size_t MiB = 1u << 20;
constexpr size_t WS_WAIN = 0, WS_WAOUT = 16 * MiB, WS_WBIN = 24 * MiB, WS_WBOUT = 72 * MiB, WS_WFIN = 88 * MiB, WS_WFOUT = 176 * MiB;
constexpr size_t WS_XB = 220 * MiB;
constexpr size_t WS_STAT = 256 * MiB;
constexpr size_t WS_ROPE = 259 * MiB;
constexpr size_t WS_YP = 262 * MiB;
constexpr size_t WS_XF = 390 * MiB;
constexpr size_t WS_R1 = 462 * MiB;
constexpr size_t WS_CTL = 678 * MiB, CTL_BYTES = 16384;
constexpr size_t WS_END = 679 * MiB;
constexpr int MISC_OFF = 131072 + 320;
constexpr int LDS_BYTES = 147456;
constexpr int NW = 8;

#define LAS __attribute__((address_space(3)))
typedef unsigned short bf16;
typedef unsigned u32x4 __attribute__((ext_vector_type(4)));
typedef unsigned u32x2 __attribute__((ext_vector_type(2)));
typedef float f32x4 __attribute__((ext_vector_type(4)));
typedef float f32x2 __attribute__((ext_vector_type(2)));
typedef short bf16x8 __attribute__((ext_vector_type(8)));
typedef short s16x4 __attribute__((ext_vector_type(4)));
#define LDS_WAIT() asm volatile("s_waitcnt lgkmcnt(0)" ::: "memory")
__device__ __forceinline__ unsigned pk2(float lo, float hi) { return pg8::cvt_pk_bf16(lo, hi); }
__device__ __forceinline__ float bf_lo(unsigned w) { return __uint_as_float(w << 16); }
__device__ __forceinline__ float bf_hi(unsigned w) { return __uint_as_float(w & 0xffff0000u); }
__device__ __forceinline__ float wave_sum(float v) {
#pragma unroll
    for (int o = 1; o < 64; o <<= 1) v += __shfl_xor(v, o);
    return v;
}

struct Args { const float* in[17]; float* out; unsigned char* ws; };

template <int MAPMODE>
__device__ __forceinline__ void p0_transpose_item(const float* W, int K, int N, bf16* WT, LAS float* scr, int item, int lane) {
    const int nblk = N / 32, kb = item / nblk, nb = item % nblk, k0 = 64 * kb, n0 = 32 * nb;
#pragma unroll 8
    for (int i = 0; i < 32; ++i) { const int kk = 2 * i + (lane >> 5); scr[kk * 33 + (lane & 31)] = W[(size_t)(k0 + kk) * N + n0 + (lane & 31)]; }
    LDS_WAIT(); asm volatile("" ::: "memory");
    int r0 = n0;
    if (MAPMODE == 1) { const int up = n0 >= FF ? 1 : 0, c = n0 - up * FF; r0 = 256 * (c >> 7) + (c & 127) + 128 * up; }
    const int c8 = lane & 7;
#pragma unroll
    for (int j = 0; j < 4; ++j) { const int n = (lane >> 3) + 8 * j; const LAS float* s = scr + (8 * c8) * 33 + n;
        u32x4 o; o.x = pk2(s[0 * 33], s[1 * 33]); o.y = pk2(s[2 * 33], s[3 * 33]); o.z = pk2(s[4 * 33], s[5 * 33]); o.w = pk2(s[6 * 33], s[7 * 33]);
        *(u32x4*)(WT + (size_t)(r0 + n) * K + k0 + 8 * c8) = o; }
    LDS_WAIT(); asm volatile("" ::: "memory");
}
__device__ __forceinline__ void convert_list(const Args& a, LAS unsigned char* lds, int list, int w, int nw, int wave, int lane) {
    LAS float* scr = (LAS float*)(lds + wave * 16384);
    unsigned char* ws = a.ws;
    constexpr int I0 = 32 * 128, I1 = 32 * 64, I2 = 32 * 384, I3 = 64 * 64, I4 = 32 * 352, I5 = 88 * 64;
    if (list == 0) {
        for (int r = w; r < I0; r += nw) p0_transpose_item<0>(a.in[3], 2048, 4096, (bf16*)(ws + WS_WAIN), scr, r, lane);
    } else if (list == 1) {
        for (int it = w; it < I1 + I4 + I5; it += nw) { int r = it;
            if (r < I1) { p0_transpose_item<0>(a.in[8], 2048, 2048, (bf16*)(ws + WS_WAOUT), scr, r, lane); continue; } r -= I1;
            if (r < I4) { p0_transpose_item<1>(a.in[11], 2048, 11264, (bf16*)(ws + WS_WFIN), scr, r, lane); continue; } r -= I4;
            p0_transpose_item<0>(a.in[12], 5632, 2048, (bf16*)(ws + WS_WFOUT), scr, r, lane); }
    } else if (list == 2) {
        for (int it = w; it < I2 + I4; it += nw) { int r = it;
            if (r < I2) { p0_transpose_item<0>(a.in[9], 2048, 12288, (bf16*)(ws + WS_WBIN), scr, r, lane); continue; } r -= I2;
            p0_transpose_item<1>(a.in[11] + (size_t)2048 * 11264, 2048, 11264, (bf16*)(ws + WS_WFIN + 44 * MiB), scr, r, lane); }
    } else if (list == 3) {
        for (int r = w; r < I3; r += nw) p0_transpose_item<0>(a.in[10], 4096, 2048, (bf16*)(ws + WS_WBOUT), scr, r, lane);
    } else {
        for (int r = w; r < I5; r += nw) p0_transpose_item<0>(a.in[12] + (size_t)5632 * 2048, 5632, 2048, (bf16*)(ws + WS_WFOUT + 22 * MiB), scr, r, lane);
    }
}
__device__ __forceinline__ void p0_prologue(const Args& a, LAS unsigned char* lds, int gw, int NGW, int wave, int lane) {
    unsigned char* ws = a.ws;
    convert_list(a, lds, 0, gw, NGW, wave, lane);
    bf16* XB = (bf16*)(ws + WS_XB);
    for (int m = gw; m < MT; m += NGW) {
        const f32x4* xr = (const f32x4*)(m < MP ? a.in[0] + (size_t)m * DM : a.in[1] + (size_t)(m - MP) * DM) + lane;
        u32x2* o = (u32x2*)(XB + (size_t)m * DM) + lane;
#pragma unroll
        for (int j = 0; j < 8; ++j) { const f32x4 v = xr[64 * j]; u32x2 w; w.x = pk2(v[0], v[1]); w.y = pk2(v[2], v[3]); o[64 * j] = w; }
    }
    float* rc = (float*)(ws + WS_ROPE); float* rs = rc + 2080 * 128;
    for (int e = gw * 64 + lane; e < 2080 * 128; e += NGW * 64) {
        const int p = e >> 7, d = e & 127; const float pos = (float)(p < 2048 ? p : 4096 + (p - 2048));
        const float inv = __builtin_amdgcn_exp2f(-(float)d * (13.287712379549449f / 128.0f));
        const double rev = (double)(pos * inv) * 0.15915494309189535; const float fr = (float)(rev - __builtin_floor(rev));
        rc[e] = __builtin_amdgcn_cosf(fr); rs[e] = __builtin_amdgcn_sinf(fr);
    }
}

struct LnIO { const float* xres_p; const float* xres_s; const bf16* xb; const float* YP; const float* g; const float* b; float* outf; bf16* outb; };
__device__ __forceinline__ void ln_load(const LnIO& io, f32x4 (&v)[8], int row, int lane) {
    if (io.xres_p) { const f32x4* xr = (const f32x4*)(row < MP ? io.xres_p + (size_t)row * DM : io.xres_s + (size_t)(row - MP) * DM) + lane;
#pragma unroll
        for (int j = 0; j < 8; ++j) v[j] = xr[64 * j] * ALPHA;
    } else { const u32x2* xr = (const u32x2*)(io.xb + (size_t)row * DM) + lane;
#pragma unroll
        for (int j = 0; j < 8; ++j) { const u32x2 w = xr[64 * j]; v[j] = (f32x4){bf_lo(w.x), bf_hi(w.x), bf_lo(w.y), bf_hi(w.y)} * ALPHA; } }
    if (row < MP) { const u32x2* y = (const u32x2*)((const bf16*)io.YP + (size_t)row * DM) + lane;
#pragma unroll
        for (int j = 0; j < 8; ++j) { const u32x2 w = y[64 * j]; v[j] += (f32x4){bf_lo(w.x), bf_hi(w.x), bf_lo(w.y), bf_hi(w.y)}; }
    } else {
#pragma unroll 2
        for (int ks = 0; ks < 8; ++ks) { const f32x4* y = (const f32x4*)(io.YP + (size_t)(MP + ks * MS + (row - MP)) * DM) + lane;
#pragma unroll
            for (int j = 0; j < 8; ++j) v[j] += y[64 * j]; }
    }
}
__device__ __forceinline__ void ln_finish(const LnIO& io, f32x4 (&v)[8], int row, int lane) {
    float s = 0.f;
#pragma unroll
    for (int j = 0; j < 8; ++j) s += (v[j][0] + v[j][1]) + (v[j][2] + v[j][3]);
    const float mean = wave_sum(s) * (1.f / DM); float q = 0.f;
#pragma unroll
    for (int j = 0; j < 8; ++j) { v[j] = v[j] - mean; q += (v[j][0] * v[j][0] + v[j][1] * v[j][1]) + (v[j][2] * v[j][2] + v[j][3] * v[j][3]); }
    const float rstd = 1.0f / sqrtf(wave_sum(q) * (1.f / DM) + LN_EPS);
#pragma unroll
    for (int j = 0; j < 8; ++j) { const f32x4 gg = ((const f32x4*)io.g)[lane + 64 * j], bb = ((const f32x4*)io.b)[lane + 64 * j]; const f32x4 o = v[j] * rstd * gg + bb;
        if (io.outf) ((f32x4*)(io.outf + (size_t)row * DM) + lane)[64 * j] = o;
        if (io.outb) { u32x2 w; w.x = pk2(o[0], o[1]); w.y = pk2(o[2], o[3]); ((u32x2*)(io.outb + (size_t)row * DM) + lane)[64 * j] = w; } }
}
__device__ __forceinline__ void ln_pair(const LnIO& io, int r0, int r1, int lane) { f32x4 va[8], vb[8]; ln_load(io, va, r0, lane); ln_load(io, vb, r1, lane); ln_finish(io, va, r0, lane); ln_finish(io, vb, r1, lane); }
__device__ __forceinline__ void ln_one(const LnIO& io, int r0, int lane) { f32x4 va[8]; ln_load(io, va, r0, lane); ln_finish(io, va, r0, lane); }
__device__ __forceinline__ void ln_pass(const float* xres_p, const float* xres_s, const bf16* xb, const float* YP, const float* g, const float* b, float* outf, bf16* outb, int gw, int NGW, int lane) {
    const LnIO io{xres_p, xres_s, xb, YP, g, b, outf, outb};
    if (NGW == 2048) {
        if (gw < 1024) { ln_one(io, MP + gw, lane); ln_pair(io, gw, gw + 1024, lane); }
        else { const int r = 2048 + (gw - 1024); ln_pair(io, r, r + 1024, lane); ln_pair(io, r + 2048, r + 3072, lane); ln_pair(io, r + 4096, r + 5120, lane); }
    } else {
        for (int row = gw; row < MT; row += NGW) ln_one(io, row, lane);
    }
}

__device__ __forceinline__ bf16x8 frag_plain(const LAS bf16* X, int ld, int r0, int k0, int lane) { return *(const LAS bf16x8*)(X + (r0 + (lane & 15)) * ld + k0 + 8 * (lane >> 4)); }
typedef short v4i16_t __attribute__((ext_vector_type(4)));
__device__ __forceinline__ bf16x8 frag_tr(const LAS bf16* Y, int ld, int kr0, int c0, int lane) {
    const int i = lane & 15, g4 = lane >> 4; const LAS bf16* p = Y + (kr0 + 8 * g4 + (i >> 2)) * ld + c0 + 4 * (i & 3);
    const v4i16_t lo = __builtin_amdgcn_ds_read_tr16_b64_v4i16((LAS v4i16_t*)p), hi = __builtin_amdgcn_ds_read_tr16_b64_v4i16((LAS v4i16_t*)(p + 4 * ld));
    return (bf16x8){lo[0], lo[1], lo[2], lo[3], hi[0], hi[1], hi[2], hi[3]};
}
#define MFMA16(a, b, c) __builtin_amdgcn_mfma_f32_16x16x32_bf16((a), (b), (c), 0, 0, 0)

template <int Q>
__device__ __forceinline__ void mix_item(const Args& a, LAS unsigned char* lds, int rb, int g, int cq, int wave, int lane) {
    constexpr int NCT = 16 / Q, NV = 8 / Q;
    const int tid = threadIdx.x;
    LAS bf16* Wm = (LAS bf16*)lds;
    LAS bf16* vn = (LAS bf16*)(lds + 34816);
    LAS f32x2* mr = (LAS f32x2*)(lds + 34816 + 67584);
    const bf16* U = (const bf16*)(a.ws + WS_R1); const bf16* V = U + (size_t)MT * DM; bf16* SB = (bf16*)(a.ws + WS_R1 + 72 * MiB);
    const f32x2* stat = (const f32x2*)(a.ws + WS_STAT);
    const float* lng = a.in[4]; const float* lnb = a.in[5]; const float* aws = a.in[6]; const float* abs_ = a.in[7];
    float* gv = a.out + (size_t)MT * DM + (size_t)(4 + 32) * 8 * 256 * 512;
    const int row0 = rb * 128, cbase = g * 256 + cq * (256 / Q); const bool smp = rb >= 64;
    const int wt = tid >> 2, ws0 = (tid & 3) * 32, wtw = smp ? (wt & 31) : wt;
    f32x4 wreg[8];
#pragma unroll
    for (int k = 0; k < 4; ++k) { const int sw = smp ? ((ws0 + 8 * k) & 31) : (ws0 + 8 * k); const float* wp = aws + ((size_t)g * 128 + wtw) * 128 + sw; wreg[2 * k] = *(const f32x4*)wp; wreg[2 * k + 1] = *(const f32x4*)(wp + 4); }
    const int vs_ = tid >> 2, vcb = (tid & 3) * (64 / Q); const bf16* vp = V + (size_t)(row0 + vs_) * DM + cbase + vcb;
    u32x4 vreg[NV];
#pragma unroll
    for (int k = 0; k < NV; ++k) vreg[k] = *(const u32x4*)(vp + 8 * k);
    const int t0 = 16 * wave, i = lane & 15, g4 = lane >> 4, t = t0 + i, row = row0 + t;
    u32x2 ureg[NCT];
#pragma unroll
    for (int ct = 0; ct < NCT; ++ct) ureg[ct] = *(const u32x2*)(U + (size_t)row * DM + cbase + 16 * ct + 4 * g4);
    const float bias = abs_[g * 128 + (smp ? (t & 31) : t)];
    if (tid < 128) { const f32x4* sp = (const f32x4*)(stat + (size_t)(row0 + tid) * 32); float s_ = 0.f, q_ = 0.f;
#pragma unroll
        for (int k = 0; k < 16; ++k) { const f32x4 v = sp[k]; s_ += v[0] + v[2]; q_ += v[1] + v[3]; }
        const float mean = s_ * (1.f / 2048.f), var = q_ * (1.f / 2048.f) - mean * mean; mr[tid] = (f32x2){mean, 1.0f / sqrtf(var + LN_EPS)}; }
#pragma unroll
    for (int k = 0; k < 4; ++k) { const int s0 = ws0 + 8 * k; const f32x4 w0 = wreg[2 * k], w1 = wreg[2 * k + 1];
        float w[8] = {w0[0], w0[1], w0[2], w0[3], w1[0], w1[1], w1[2], w1[3]};
#pragma unroll
        for (int e = 0; e < 8; ++e) { const int ss = s0 + e; const bool ok = smp ? ((ss >> 5) == (wt >> 5) && (ss & 31) <= (wt & 31)) : (ss <= wt); w[e] = ok ? w[e] : 0.f; }
        u32x4 o; o.x = pk2(w[0], w[1]); o.y = pk2(w[2], w[3]); o.z = pk2(w[4], w[5]); o.w = pk2(w[6], w[7]);
        *(LAS u32x4*)(Wm + wt * 136 + s0) = o; }
    __syncthreads();
    { const f32x2 m = mr[vs_];
#pragma unroll
        for (int k = 0; k < NV; ++k) { const u32x4 w = vreg[k]; const int c = cbase + vcb + 8 * k;
            const f32x4 g0 = *(const f32x4*)(lng + c), g1 = *(const f32x4*)(lng + c + 4), b0 = *(const f32x4*)(lnb + c), b1 = *(const f32x4*)(lnb + c + 4);
            f32x4 x0 = (f32x4){bf_lo(w.x), bf_hi(w.x), bf_lo(w.y), bf_hi(w.y)}, x1 = (f32x4){bf_lo(w.z), bf_hi(w.z), bf_lo(w.w), bf_hi(w.w)};
            x0 = (x0 - m.x) * m.y * g0 + b0; x1 = (x1 - m.x) * m.y * g1 + b1;
            u32x4 o; o.x = pk2(x0[0], x0[1]); o.y = pk2(x0[2], x0[3]); o.z = pk2(x1[0], x1[1]); o.w = pk2(x1[2], x1[3]);
            *(LAS u32x4*)(vn + vs_ * 264 + vcb + 8 * k) = o;
            if (smp) { float* op = gv + (size_t)(row0 + vs_ - MP) * DM + c; *(f32x4*)op = x0; *(f32x4*)(op + 4) = x1; } } }
    __syncthreads();
    {
        f32x4 acc[NCT];
#pragma unroll
        for (int ct = 0; ct < NCT; ++ct) acc[ct] = (f32x4){0.f, 0.f, 0.f, 0.f};
        const int kmax = (t0 + 15) >> 5;
        for (int kk = 0; kk <= kmax; ++kk) { const bf16x8 bw = frag_plain(Wm, 136, t0, 32 * kk, lane);
#pragma unroll
            for (int ct = 0; ct < NCT; ++ct) { const bf16x8 av = frag_tr(vn, 264, 32 * kk, 16 * ct, lane); acc[ct] = MFMA16(av, bw, acc[ct]); } }
#pragma unroll
        for (int ct = 0; ct < NCT; ++ct) { const size_t off = (size_t)row * DM + cbase + 16 * ct + 4 * g4; const u32x2 uu = ureg[ct];
            u32x2 o; o.x = pk2(bf_lo(uu.x) * (acc[ct][0] + bias), bf_hi(uu.x) * (acc[ct][1] + bias)); o.y = pk2(bf_lo(uu.y) * (acc[ct][2] + bias), bf_hi(uu.y) * (acc[ct][3] + bias));
            *(u32x2*)(SB + off) = o; }
    }
    __syncthreads();
}
__device__ __forceinline__ void mix_phase(const Args& a, LAS unsigned char* lds, int wave, int lane) {
    for (int item = blockIdx.x; item < 64 * 8; item += gridDim.x) mix_item<1>(a, lds, item >> 3, item & 7, 0, wave, lane);
    for (int item = blockIdx.x; item < 8 * 8 * 4; item += gridDim.x) mix_item<4>(a, lds, 64 + (item >> 5), (item >> 2) & 7, item & 3, wave, lane);
}
constexpr int R_QS = 0, R_KS = 33792, R_VS = 67584, R_PS = 76800, R_RT = 86016, R_OS = 119808;
template <int L>
__device__ __forceinline__ void ret_run(LAS unsigned char* lds, const bf16* QH, const bf16* KH, const bf16* VB, bf16* OB, int grow0, int nblk, int h, int slice, const float* S0, float* Sout, int wave, int lane) {
    const int tid = threadIdx.x, i = lane & 15, g4 = lane >> 4;
    LAS bf16* qs = (LAS bf16*)(lds + R_QS); LAS bf16* ks = (LAS bf16*)(lds + R_KS); LAS bf16* vs = (LAS bf16*)(lds + R_VS);
    LAS bf16* ps = (LAS bf16*)(lds + R_PS); LAS bf16* rts = (LAS bf16*)(lds + R_RT); LAS bf16* os = (LAS bf16*)(lds + R_OS);
    const float lg = pg8::lg2gamma(h);
    const float gL = __builtin_amdgcn_exp2f(lg * (float)L), gLm1 = __builtin_amdgcn_exp2f(lg * (float)(L - 1)), gLm1i = __builtin_amdgcn_exp2f(-lg * (float)(L - 1));
    constexpr int NQ = L / 16, NT = L / 32, NKK = L / 32;
    const bool vthr = (L == 64) || tid < 256;
    u32x4 pq[NQ], pk[NQ], pv;
#define RET_GLOAD(blk) do { const int r0_ = grow0 + (blk) * L; _Pragma("unroll") for (int k_ = 0; k_ < NQ; ++k_) { const int e_ = tid + 512 * k_, row_ = e_ >> 5, ch_ = e_ & 31; \
        pq[k_] = *(const u32x4*)(QH + (size_t)(r0_ + row_) * 2048 + h * 256 + ch_ * 8); pk[k_] = *(const u32x4*)(KH + (size_t)(r0_ + row_) * 2048 + h * 256 + ch_ * 8); } \
        if (vthr) pv = *(const u32x4*)(VB + (size_t)(r0_ + (tid >> 3)) * 4096 + h * 512 + slice * 64 + (tid & 7) * 8); } while (0)
#define RET_LSTORE() do { _Pragma("unroll") for (int k_ = 0; k_ < NQ; ++k_) { const int e_ = tid + 512 * k_, row_ = e_ >> 5, ch_ = e_ & 31; \
        *(LAS u32x4*)(qs + row_ * 264 + ch_ * 8) = pq[k_]; *(LAS u32x4*)(ks + row_ * 264 + ch_ * 8) = pk[k_]; } \
        if (vthr) *(LAS u32x4*)(vs + (tid >> 3) * 72 + (tid & 7) * 8) = pv; } while (0)
    f32x4 R[2][4];
    RET_GLOAD(0);
#pragma unroll
    for (int a2 = 0; a2 < 2; ++a2)
#pragma unroll
        for (int d = 0; d < 4; ++d) {
            if (S0) {
#pragma unroll
                for (int e = 0; e < 4; ++e) R[a2][d][e] = S0[(size_t)(32 * wave + 16 * a2 + 4 * g4 + e) * 512 + slice * 64 + 16 * d + i] * gLm1i;
            } else R[a2][d] = (f32x4){0.f, 0.f, 0.f, 0.f};
            u32x2 w; w.x = pk2(R[a2][d][0], R[a2][d][1]); w.y = pk2(R[a2][d][2], R[a2][d][3]);
            *(LAS u32x2*)(rts + (16 * d + i) * 264 + 32 * wave + 16 * a2 + 4 * g4) = w; }
    RET_LSTORE();
    __syncthreads();
    const int it = (L == 64) ? (wave >> 1) : (wave >> 2);
    for (int n = 0; n < nblk; ++n) {
        if (n + 1 < nblk) RET_GLOAD(n + 1);
        bf16x8 qf[8];
#pragma unroll
        for (int kk = 0; kk < 8; ++kk) qf[kk] = frag_plain(qs, 264, 16 * it, 32 * kk, lane);
        if (L == 64 || wave < 4) {
#pragma unroll
            for (int tp = 0; tp < NT; ++tp) { const int i0 = 16 * (wave >> 1), j0 = (L == 64) ? 16 * (2 * (wave & 1) + tp) : 16 * (wave & 1);
                f32x4 acc = (f32x4){0.f, 0.f, 0.f, 0.f};
#pragma unroll
                for (int kk = 0; kk < 8; ++kk) acc = MFMA16(frag_plain(ks, 264, j0, 32 * kk, lane), (L == 64) ? qf[kk] : frag_plain(qs, 264, i0, 32 * kk, lane), acc);
#pragma unroll
                for (int e = 0; e < 4; ++e) acc[e] = (j0 + 4 * g4 + e <= i0 + i) ? acc[e] : 0.f;
                u32x2 w; w.x = pk2(acc[0], acc[1]); w.y = pk2(acc[2], acc[3]); *(LAS u32x2*)(ps + (i0 + i) * 72 + j0 + 4 * g4) = w; }
        }
        f32x4 oacc[NT];
#pragma unroll
        for (int tp = 0; tp < NT; ++tp) { const int dv0 = (L == 64) ? 16 * (2 * (wave & 1) + tp) : 16 * (wave & 3);
            f32x4 acc = (f32x4){0.f, 0.f, 0.f, 0.f};
#pragma unroll
            for (int kk = 0; kk < 8; ++kk) acc = MFMA16(frag_plain(rts, 264, dv0, 32 * kk, lane), qf[kk], acc);
            oacc[tp] = acc * gL; }
        __syncthreads();
#pragma unroll
        for (int tp = 0; tp < NT; ++tp) { const int dv0 = (L == 64) ? 16 * (2 * (wave & 1) + tp) : 16 * (wave & 3);
#pragma unroll
            for (int kk = 0; kk < NKK; ++kk) oacc[tp] = MFMA16(frag_tr(vs, 72, 32 * kk, dv0, lane), frag_plain(ps, 72, 16 * it, 32 * kk, lane), oacc[tp]);
            u32x2 w; w.x = pk2(oacc[tp][0], oacc[tp][1]); w.y = pk2(oacc[tp][2], oacc[tp][3]); *(LAS u32x2*)(os + (16 * it + i) * 72 + dv0 + 4 * g4) = w; }
#pragma unroll
        for (int a2 = 0; a2 < 2; ++a2)
#pragma unroll
            for (int d = 0; d < 4; ++d) R[a2][d] = R[a2][d] * gL;
#pragma unroll
        for (int kk = 0; kk < NKK; ++kk) { bf16x8 bv[4];
#pragma unroll
            for (int d = 0; d < 4; ++d) bv[d] = frag_tr(vs, 72, 32 * kk, 16 * d, lane);
#pragma unroll
            for (int a2 = 0; a2 < 2; ++a2) { const bf16x8 av = frag_tr(ks, 264, 32 * kk, 32 * wave + 16 * a2, lane);
#pragma unroll
                for (int d = 0; d < 4; ++d) R[a2][d] = MFMA16(av, bv[d], R[a2][d]); } }
        __syncthreads();
#pragma unroll
        for (int a2 = 0; a2 < 2; ++a2)
#pragma unroll
            for (int d = 0; d < 4; ++d) { u32x2 w; w.x = pk2(R[a2][d][0], R[a2][d][1]); w.y = pk2(R[a2][d][2], R[a2][d][3]);
                *(LAS u32x2*)(rts + (16 * d + i) * 264 + 32 * wave + 16 * a2 + 4 * g4) = w; }
        if (vthr) *(u32x4*)(OB + (size_t)(grow0 + n * L + (tid >> 3)) * 4096 + h * 512 + slice * 64 + (tid & 7) * 8) = *(const LAS u32x4*)(os + (tid >> 3) * 72 + (tid & 7) * 8);
        if (n + 1 < nblk) RET_LSTORE();
        __syncthreads();
    }
#pragma unroll
    for (int a2 = 0; a2 < 2; ++a2)
#pragma unroll
        for (int d = 0; d < 4; ++d)
#pragma unroll
            for (int e = 0; e < 4; ++e) Sout[(size_t)(32 * wave + 16 * a2 + 4 * g4 + e) * 512 + slice * 64 + 16 * d + i] = R[a2][d][e] * gLm1;
#undef RET_GLOAD
#undef RET_LSTORE
}

constexpr int S_QS = 0, S_KS = 16896, S_PS = 33792, S_RT = 38400, S_VS = 105984, S_OS = 115200;
__device__ __forceinline__ void ret_sample(LAS unsigned char* lds, const bf16* QH, const bf16* KH, const bf16* VB, bf16* OB, int grow0, int h, const float* S0, float* Sout, int wave, int lane) {
    const int tid = threadIdx.x, i = lane & 15, g4 = lane >> 4;
    LAS bf16* qs = (LAS bf16*)(lds + S_QS); LAS bf16* ks = (LAS bf16*)(lds + S_KS); LAS bf16* ps = (LAS bf16*)(lds + S_PS);
    const float lg = pg8::lg2gamma(h);
    const float gL = __builtin_amdgcn_exp2f(lg * 32.f), gLm1 = __builtin_amdgcn_exp2f(lg * 31.f), gLm1i = __builtin_amdgcn_exp2f(-lg * 31.f);
    const bool vthr = tid < 256;
#pragma unroll
    for (int k = 0; k < 2; ++k) { const int e = tid + 512 * k, row = e >> 5, ch = e & 31;
        *(LAS u32x4*)(qs + row * 264 + ch * 8) = *(const u32x4*)(QH + (size_t)(grow0 + row) * 2048 + h * 256 + ch * 8);
        *(LAS u32x4*)(ks + row * 264 + ch * 8) = *(const u32x4*)(KH + (size_t)(grow0 + row) * 2048 + h * 256 + ch * 8); }
    f32x4 Rn[2][4]; u32x4 vn = (u32x4){0u, 0u, 0u, 0u};
#define SMP_PREFETCH(sl) do { _Pragma("unroll") for (int a2 = 0; a2 < 2; ++a2) _Pragma("unroll") for (int d = 0; d < 4; ++d) _Pragma("unroll") for (int e = 0; e < 4; ++e) \
        Rn[a2][d][e] = S0[(size_t)(32 * wave + 16 * a2 + 4 * g4 + e) * 512 + (sl) * 64 + 16 * d + i]; \
        if (vthr) vn = *(const u32x4*)(VB + (size_t)(grow0 + (tid >> 3)) * 4096 + h * 512 + (sl) * 64 + (tid & 7) * 8); } while (0)
    SMP_PREFETCH(0);
    __syncthreads();
    if (wave < 4) {
        const int i0 = 16 * (wave >> 1), j0 = 16 * (wave & 1); f32x4 acc = (f32x4){0.f, 0.f, 0.f, 0.f};
#pragma unroll
        for (int kk = 0; kk < 8; ++kk) acc = MFMA16(frag_plain(ks, 264, j0, 32 * kk, lane), frag_plain(qs, 264, i0, 32 * kk, lane), acc);
#pragma unroll
        for (int e = 0; e < 4; ++e) acc[e] = (j0 + 4 * g4 + e <= i0 + i) ? acc[e] : 0.f;
        u32x2 w; w.x = pk2(acc[0], acc[1]); w.y = pk2(acc[2], acc[3]); *(LAS u32x2*)(ps + (i0 + i) * 72 + j0 + 4 * g4) = w;
    }
    const int it = wave >> 2, dv0 = 16 * (wave & 3);
    bf16x8 qf[8], av[2];
#pragma unroll
    for (int kk = 0; kk < 8; ++kk) qf[kk] = frag_plain(qs, 264, 16 * it, 32 * kk, lane);
#pragma unroll
    for (int a2 = 0; a2 < 2; ++a2) av[a2] = frag_tr(ks, 264, 0, 32 * wave + 16 * a2, lane);
    __syncthreads();
    const bf16x8 pf = frag_plain(ps, 72, 16 * it, 0, lane);
    for (int sl = 0; sl < 8; ++sl) {
        LAS bf16* rts = (LAS bf16*)(lds + S_RT + (sl & 1) * 33792); LAS bf16* vs = (LAS bf16*)(lds + S_VS + (sl & 1) * 4608); LAS bf16* os = (LAS bf16*)(lds + S_OS + (sl & 1) * 4608);
        f32x4 R[2][4];
#pragma unroll
        for (int a2 = 0; a2 < 2; ++a2)
#pragma unroll
            for (int d = 0; d < 4; ++d) { R[a2][d] = Rn[a2][d] * gLm1i; u32x2 w; w.x = pk2(R[a2][d][0], R[a2][d][1]); w.y = pk2(R[a2][d][2], R[a2][d][3]);
                *(LAS u32x2*)(rts + (16 * d + i) * 264 + 32 * wave + 16 * a2 + 4 * g4) = w; }
        if (vthr) *(LAS u32x4*)(vs + (tid >> 3) * 72 + (tid & 7) * 8) = vn;
        if (sl + 1 < 8) SMP_PREFETCH(sl + 1);
        __syncthreads();
        if (sl > 0 && vthr) *(u32x4*)(OB + (size_t)(grow0 + (tid >> 3)) * 4096 + h * 512 + (sl - 1) * 64 + (tid & 7) * 8) = *(const LAS u32x4*)((LAS bf16*)(lds + S_OS + ((sl - 1) & 1) * 4608) + (tid >> 3) * 72 + (tid & 7) * 8);
        f32x4 acc = (f32x4){0.f, 0.f, 0.f, 0.f};
#pragma unroll
        for (int kk = 0; kk < 8; ++kk) acc = MFMA16(frag_plain(rts, 264, dv0, 32 * kk, lane), qf[kk], acc);
        acc = acc * gL;
        acc = MFMA16(frag_tr(vs, 72, 0, dv0, lane), pf, acc);
        { u32x2 w; w.x = pk2(acc[0], acc[1]); w.y = pk2(acc[2], acc[3]); *(LAS u32x2*)(os + (16 * it + i) * 72 + dv0 + 4 * g4) = w; }
        bf16x8 bv[4];
#pragma unroll
        for (int d = 0; d < 4; ++d) bv[d] = frag_tr(vs, 72, 0, 16 * d, lane);
#pragma unroll
        for (int a2 = 0; a2 < 2; ++a2)
#pragma unroll
            for (int d = 0; d < 4; ++d) { R[a2][d] = MFMA16(av[a2], bv[d], R[a2][d] * gL);
#pragma unroll
                for (int e = 0; e < 4; ++e) Sout[(size_t)(32 * wave + 16 * a2 + 4 * g4 + e) * 512 + sl * 64 + 16 * d + i] = R[a2][d][e] * gLm1; }
    }
    __syncthreads();
    if (vthr) *(u32x4*)(OB + (size_t)(grow0 + (tid >> 3)) * 4096 + h * 512 + 7 * 64 + (tid & 7) * 8) = *(const LAS u32x4*)((LAS bf16*)(lds + S_OS + 4608) + (tid >> 3) * 72 + (tid & 7) * 8);
    __syncthreads();
#undef SMP_PREFETCH
}
__device__ __forceinline__ void ret_phase(const Args& a, LAS unsigned char* lds, int wave, int lane) {
    const bf16* QH = (const bf16*)(a.ws + WS_R1); const bf16* KH = QH + (size_t)MT * DM; const bf16* VB = (const bf16*)(a.ws + WS_R1 + 72 * MiB); bf16* OB = (bf16*)(a.ws + WS_YP);
    float* sp = a.out + (size_t)MT * DM; float* ss = sp + (size_t)4 * 8 * 256 * 512;
    for (int item = blockIdx.x; item < 256; item += gridDim.x) {
        const int x = item & 7, j = item >> 3, bh = x * 4 + (j >> 3), slice = j & 7, b = bh >> 3, h = bh & 7;
        ret_run<64>(lds, QH, KH, VB, OB, b * 2048, 32, h, slice, nullptr, sp + (size_t)bh * 256 * 512, wave, lane);
    }
    for (int pair = blockIdx.x; pair < 256; pair += gridDim.x) {
        const int b = pair >> 3, h = pair & 7;
        ret_sample(lds, QH, KH, VB, OB, MP + b * 32, h, a.in[2] + (size_t)pair * 256 * 512, ss + (size_t)pair * 256 * 512, wave, lane);
    }
}
__device__ __forceinline__ void gn_gate(const Args& a, int gw, int NGW, int lane) {
    const bf16* O = (const bf16*)(a.ws + WS_YP); bf16* GS = (bf16*)(a.ws + WS_R1 + 144 * MiB);
    for (int row = gw; row < MT; row += NGW) {
        const size_t off = (size_t)row * 4096 + 8 * lane;
        u32x4 ow[8], gv[8];
#pragma unroll
        for (int h = 0; h < 8; ++h) { ow[h] = *(const u32x4*)(O + off + h * 512); gv[h] = *(const u32x4*)(GS + off + h * 512); }
#pragma unroll
        for (int h = 0; h < 8; ++h) {
            float o[8] = {bf_lo(ow[h].x), bf_hi(ow[h].x), bf_lo(ow[h].y), bf_hi(ow[h].y), bf_lo(ow[h].z), bf_hi(ow[h].z), bf_lo(ow[h].w), bf_hi(ow[h].w)};
            const float g[8] = {bf_lo(gv[h].x), bf_hi(gv[h].x), bf_lo(gv[h].y), bf_hi(gv[h].y), bf_lo(gv[h].z), bf_hi(gv[h].z), bf_lo(gv[h].w), bf_hi(gv[h].w)};
            float s = 0.f;
#pragma unroll
            for (int e = 0; e < 8; ++e) s += o[e];
            const float mean = wave_sum(s) * (1.f / 512.f); float q = 0.f;
#pragma unroll
            for (int e = 0; e < 8; ++e) { o[e] -= mean; q += o[e] * o[e]; }
            const float rstd = 1.0f / sqrtf(wave_sum(q) * (1.f / 512.f) + GN_EPS);
            u32x4 w; w.x = pk2(g[0] * o[0] * rstd, g[1] * o[1] * rstd); w.y = pk2(g[2] * o[2] * rstd, g[3] * o[3] * rstd); w.z = pk2(g[4] * o[4] * rstd, g[5] * o[5] * rstd); w.w = pk2(g[6] * o[6] * rstd, g[7] * o[7] * rstd);
            *(u32x4*)(GS + off + h * 512) = w;
        }
    }
}

#ifndef DBG_STOP
#define DBG_STOP 0
#endif
__device__ __forceinline__ void dbg_dump(const Args& a, const bf16* src, size_t n_el) {
    const size_t T = (size_t)gridDim.x * 512, t = (size_t)blockIdx.x * 512 + threadIdx.x, total = 58720256;
    for (size_t i = t; i < total; i += T) { float v = 0.f; if (i < n_el / 2) { const unsigned w = ((const unsigned*)src)[i]; v = bf_lo(w) + bf_hi(w); } a.out[i] = v; }
}
__device__ __forceinline__ void dbg_dump_f32(const Args& a, const float* src, size_t n_el) {
    const size_t T = (size_t)gridDim.x * 512, t = (size_t)blockIdx.x * 512 + threadIdx.x, total = 58720256;
    for (size_t i = t; i < total; i += T) a.out[i] = i < n_el ? src[i] : 0.f;
}
#define XB_TMO      128
#define XB_XCNT(j)  (256  + 64 * (j))
#define XB_XSUB(j)  (1280 + 64 * (j))
#define XB_XGEN(j)  (2304 + 64 * (j))
#define XB_TOP      3328
#define XB_TOPGEN   3392
#define XCD_BAR_WORDS 3456
#define XB_SPIN_CAP (1u << 18)

__device__ __forceinline__ unsigned xb_ld(unsigned* p)              { return __hip_atomic_load(p, __ATOMIC_RELAXED, __HIP_MEMORY_SCOPE_AGENT); }
__device__ __forceinline__ unsigned xb_add(unsigned* p, unsigned v) { return __hip_atomic_fetch_add(p, v, __ATOMIC_RELAXED, __HIP_MEMORY_SCOPE_AGENT); }
__device__ __forceinline__ unsigned xb_xcc_id() { return (unsigned)__builtin_amdgcn_s_getreg((3 << 11) | 20) & 0xFu; }
#define XB_SPIN(cond, bar) do { unsigned _sp = 0; while (cond) { __builtin_amdgcn_s_sleep(1); \
    if ((++_sp & 255u) == 0u) { if (xb_ld(&(bar)[XB_TMO])) break; if (_sp > XB_SPIN_CAP) { atomicAdd(&(bar)[XB_TMO], 1u); break; } } } } while (0)

struct XcdBarrier {
    unsigned* bar; unsigned x;
    volatile LAS unsigned* st;
};

__device__ __forceinline__ XcdBarrier xcd_barrier_post(unsigned* bar, volatile LAS unsigned* st) {
    XcdBarrier b; b.bar = bar; b.x = xb_xcc_id(); b.st = st;
    if (threadIdx.x == 0) (void)xb_add(&bar[XB_XCNT(b.x)], 1u);
    return b;
}
__device__ __forceinline__ void xcd_barrier_complete(unsigned* bar, unsigned x, unsigned& nloc, unsigned& nx) {
    const unsigned G = gridDim.x * gridDim.y * gridDim.z;
    unsigned sum, cnt, mine, sp = 0u;
    for (;;) {
        sum = 0u; cnt = 0u; mine = 0u;
#pragma unroll
        for (unsigned j = 0; j < 16; ++j) { const unsigned c = xb_ld(&bar[XB_XCNT(j)]); sum += c; cnt += (c > 0u) ? 1u : 0u; mine = (j == x) ? c : mine; }
        if (sum == G) break;
        __builtin_amdgcn_s_sleep(1);
        if ((++sp & 255u) == 0u) { if (xb_ld(&bar[XB_TMO])) break; if (sp > XB_SPIN_CAP) { atomicAdd(&bar[XB_TMO], 1u); break; } }
    }
    nloc = mine > 0u ? mine : 1u; nx = cnt > 0u ? cnt : 1u;
}

__device__ __forceinline__ void xcd_barrier(const XcdBarrier& b) {
    asm volatile("s_waitcnt vmcnt(0)" ::: "memory");
    __syncthreads();
    if (threadIdx.x == 0) {
        unsigned* bar = b.bar;
        __builtin_amdgcn_s_waitcnt(0);
        unsigned nloc = b.st[0], nx = b.st[1];
        if (nloc == 0u) { xcd_barrier_complete(bar, b.x, nloc, nx); b.st[0] = nloc; b.st[1] = nx; }
        const unsigned old = xb_add(&bar[XB_XSUB(b.x)], 1u);
        const unsigned gen = old / nloc;
        if (old + 1u == (gen + 1u) * nloc) {
            __builtin_amdgcn_fence(__ATOMIC_RELEASE, "agent");
            asm volatile("s_waitcnt vmcnt(0)" ::: "memory");
            const unsigned og = xb_add(&bar[XB_TOP], 1u);
            const unsigned tg = og / nx;
            if (og + 1u == (tg + 1u) * nx) xb_add(&bar[XB_TOPGEN], 1u);
            else XB_SPIN(xb_ld(&bar[XB_TOPGEN]) == tg, bar);
            __builtin_amdgcn_fence(__ATOMIC_ACQUIRE, "agent");
            xb_add(&bar[XB_XGEN(b.x)], 1u);
            asm volatile("s_waitcnt vmcnt(0)" ::: "memory");
        } else {
            XB_SPIN(xb_ld(&bar[XB_XGEN(b.x)]) == gen, bar);
            __builtin_amdgcn_fence(__ATOMIC_ACQUIRE, "agent");
            asm volatile("s_waitcnt vmcnt(0)" ::: "memory");
        }
    }
    __syncthreads();
}

__global__ void __launch_bounds__(512, 2) fwd(Args a) {
    extern __shared__ __attribute__((aligned(16))) unsigned char lds_raw[];
    cg::grid_group grid = cg::this_grid();
    LAS unsigned char* lds = (LAS unsigned char*)lds_raw;
    const int tid = threadIdx.x, lane = tid & 63, wave = __builtin_amdgcn_readfirstlane(tid >> 6);
    const int G = gridDim.x, c = blockIdx.x, vcu = (G % 8 == 0) ? (c % 8) * (G / 8) + c / 8 : c, gw = vcu * NW + wave, NGW = G * NW;
    unsigned char* ws = a.ws;
    { volatile LAS unsigned* misc = (volatile LAS unsigned*)(lds + MISC_OFF); if (tid < 32) misc[tid] = 0u; }
    __syncthreads();
    XcdBarrier bar = xcd_barrier_post((unsigned*)(ws + WS_CTL), (volatile LAS unsigned*)(lds + MISC_OFF) + 8);
    bf16* XB = (bf16*)(ws + WS_XB); float* YP = (float*)(ws + WS_YP);
    bf16* R1 = (bf16*)(ws + WS_R1);
#define GEMM(EPI, E, Ap, Bp, LD, M1, N, K, SPLIT, CLIST) do { pg8::Gemm g_{(const pg8::bf16_t*)(Ap), (const pg8::bf16_t*)(Bp), (LD)}; pg8::Order S_; S_.init((M1), (N), (K), (SPLIT), G, c); \
        pg8::gemm_phase<EPI, pg8::Order, true, true>(lds, g_, S_, E); if (DBL_GEMM) pg8::gemm_phase<EPI, pg8::Order, true, true>(lds, g_, S_, E); \
        if ((CLIST) > 0) { const int nbusy_ = S_.so.nwg % G;   \
            if (nbusy_ == 0) convert_list(a, lds, (CLIST), gw, NGW, wave, lane); else if (c >= nbusy_) convert_list(a, lds, (CLIST), (c - nbusy_) * NW + wave, (G - nbusy_) * NW, wave, lane); } } while (0)

#define GRID_SYNC() do { asm volatile("s_waitcnt vmcnt(0) lgkmcnt(0)" ::: "memory"); grid.sync(); } while (0)
#define XCD_SYNC() xcd_barrier(bar)

#define DBG_DUMP_1 dbg_dump(a, XB, (size_t)MT * DM)
#define DBG_DUMP_2 dbg_dump(a, R1, (size_t)2 * MT * DM)
#define DBG_DUMP_3 dbg_dump(a, R1 + (size_t)2 * MT * DM, (size_t)MT * DM)
#define DBG_DUMP_4 dbg_dump(a, (const bf16*)YP, (size_t)MP * DM)
#define DBG_DUMP_5 dbg_dump(a, XB, (size_t)MT * DM)
#define DBG_DUMP_6 dbg_dump(a, R1, (size_t)MT * FF)
#define DBG_DUMP_7 dbg_dump(a, (const bf16*)YP, (size_t)MP * DM)
#define DBG_DUMP_8 dbg_dump(a, XB, (size_t)MT * DM)
#define DBG_DUMP_9 dbg_dump(a, R1, (size_t)6 * MT * DM)
#define DBG_DUMP_10 dbg_dump(a, (const bf16*)YP, (size_t)2 * MT * DM)
#define DBG_DUMP_11 dbg_dump(a, R1 + (size_t)4 * MT * DM, (size_t)2 * MT * DM)
#define DBG_DUMP_12 dbg_dump(a, (const bf16*)YP, (size_t)MP * DM)
#define DBG_DUMP_13 dbg_dump(a, XB, (size_t)MT * DM)
#define DBG_DUMP_14 dbg_dump(a, R1, (size_t)MT * FF)
#define DBG_DUMP_15 dbg_dump(a, (const bf16*)YP, (size_t)MP * DM)
    p0_prologue(a, lds, gw, NGW, wave, lane);
    if (a.out == nullptr) GRID_SYNC();
    XCD_SYNC();
    if (DBG_STOP == 1) { DBG_DUMP_1; return; }
    { pg8::EpiGeluUV E{R1, R1 + (size_t)MT * DM, (pg8::f32x2*)(ws + WS_STAT)}; GEMM(pg8::EpiGeluUV, E, XB, ws + WS_WAIN, 2048, MT, 4096, 2048, 0, 1); }
    XCD_SYNC();
    if (DBG_STOP == 2) { DBG_DUMP_2; return; }
    mix_phase(a, lds, wave, lane);
    XCD_SYNC();
    if (DBG_STOP == 3) { DBG_DUMP_3; return; }
    { pg8::EpiPart E{(pg8::bf16_t*)YP, YP + (size_t)MP * DM}; GEMM(pg8::EpiPart, E, ws + WS_R1 + 72 * MiB, ws + WS_WAOUT, 2048, MP, 2048, 2048, 1, 0); }
    XCD_SYNC();
    if (DBG_STOP == 4) { DBG_DUMP_4; return; }
    ln_pass(a.in[0], a.in[1], nullptr, YP, a.in[13], a.in[14], nullptr, XB, gw, NGW, lane);
    XCD_SYNC();
    if (DBG_STOP == 5) { DBG_DUMP_5; return; }
    { pg8::EpiSwiglu E{R1}; GEMM(pg8::EpiSwiglu, E, XB, ws + WS_WFIN, 2048, MT, 11264, 2048, 0, 2); }
    XCD_SYNC();
    if (DBG_STOP == 6) { DBG_DUMP_6; return; }
    { pg8::EpiPart E{(pg8::bf16_t*)YP, YP + (size_t)MP * DM}; GEMM(pg8::EpiPart, E, R1, ws + WS_WFOUT, 5632, MP, 2048, 5632, 1, 0); }
    XCD_SYNC();
    if (DBG_STOP == 7) { DBG_DUMP_7; return; }
    ln_pass(nullptr, nullptr, XB, YP, a.in[15], a.in[16], nullptr, XB, gw, NGW, lane);
    XCD_SYNC();
    if (DBG_STOP == 8) { DBG_DUMP_8; return; }
    { pg8::EpiQKVG E{R1, R1 + (size_t)MT * DM, (pg8::bf16_t*)(ws + WS_R1 + 72 * MiB), (pg8::bf16_t*)(ws + WS_R1 + 144 * MiB), (const float*)(ws + WS_ROPE), (const float*)(ws + WS_ROPE) + 2080 * 128};
      GEMM(pg8::EpiQKVG, E, XB, ws + WS_WBIN, 2048, MT, 12288, 2048, 0, 3); }
    XCD_SYNC();
    if (DBG_STOP == 9) { DBG_DUMP_9; return; }
    ret_phase(a, lds, wave, lane);
    XCD_SYNC();
    if (DBG_STOP == 10) { DBG_DUMP_10; return; }
    gn_gate(a, gw, NGW, lane);
    XCD_SYNC();
    if (DBG_STOP == 11) { DBG_DUMP_11; return; }
    { pg8::EpiPart E{(pg8::bf16_t*)YP, YP + (size_t)MP * DM}; GEMM(pg8::EpiPart, E, ws + WS_R1 + 144 * MiB, ws + WS_WBOUT, 4096, MP, 2048, 4096, 1, 0); }
    XCD_SYNC();
    if (DBG_STOP == 12) { DBG_DUMP_12; return; }
    ln_pass(nullptr, nullptr, XB, YP, a.in[13] + DM, a.in[14] + DM, nullptr, XB, gw, NGW, lane);
    XCD_SYNC();
    if (DBG_STOP == 13) { DBG_DUMP_13; return; }
    { pg8::EpiSwiglu E{R1}; GEMM(pg8::EpiSwiglu, E, XB, ws + WS_WFIN + 44 * MiB, 2048, MT, 11264, 2048, 0, 4); }
    XCD_SYNC();
    if (DBG_STOP == 14) { DBG_DUMP_14; return; }
    { pg8::EpiPart E{(pg8::bf16_t*)YP, YP + (size_t)MP * DM}; GEMM(pg8::EpiPart, E, R1, ws + WS_WFOUT + 22 * MiB, 5632, MP, 2048, 5632, 1, 0); }
    XCD_SYNC();
    if (DBG_STOP == 15) { DBG_DUMP_15; return; }
    ln_pass(nullptr, nullptr, XB, YP, a.in[15] + DM, a.in[16] + DM, a.out, nullptr, gw, NGW, lane);
#undef GEMM
}

extern "C" void kernel_launch(void* const* d_in, const int* in_sizes, int n_in, void* d_out, int out_size, void* d_ws, size_t ws_size, hipStream_t stream) {
    static int grid = 0;
    if (grid == 0) {
        if (n_in != 17 || ws_size < WS_END) { fprintf(stderr, "kernel_launch: needs 17 inputs and >= %zu bytes of workspace (got %d, %zu)\n", (size_t)WS_END, n_in, ws_size); grid = -1; return; }
        int dev = 0, cus = 0, per_cu = 0;
        if (hipGetDevice(&dev) != hipSuccess || hipDeviceGetAttribute(&cus, hipDeviceAttributeMultiprocessorCount, dev) != hipSuccess) { grid = -1; return; }
        if (hipFuncSetAttribute((const void*)fwd, hipFuncAttributeMaxDynamicSharedMemorySize, LDS_BYTES) != hipSuccess) { fprintf(stderr, "kernel_launch: hipFuncSetAttribute failed\n"); grid = -1; return; }
        if (hipOccupancyMaxActiveBlocksPerMultiprocessor(&per_cu, (const void*)fwd, NW * 64, LDS_BYTES) != hipSuccess || per_cu < 1) { fprintf(stderr, "kernel_launch: occupancy query reports %d workgroups per CU\n", per_cu); grid = -1; return; }
        grid = cus;
    }
    if (grid < 0) return;
    if (hipMemsetAsync((char*)d_ws + WS_CTL, 0, CTL_BYTES, stream) != hipSuccess) { fprintf(stderr, "kernel_launch: hipMemsetAsync failed\n"); return; }
    Args a{};
    for (int i = 0; i < 17; ++i) a.in[i] = (const float*)d_in[i];
    a.out = (float*)d_out; a.ws = (unsigned char*)d_ws;
    void* args[] = {&a};
    const hipError_t e = hipLaunchCooperativeKernel((const void*)fwd, dim3(grid), dim3(NW * 64), args, LDS_BYTES, stream);
    if (e != hipSuccess) fprintf(stderr, "kernel_launch: cooperative launch failed: %s (grid %d)\n", hipGetErrorString(e), grid);
}
```

```cpp
#ifndef DBL_GEMM
#define DBL_GEMM 0
#endif
#include <hip/hip_runtime.h>
#include <hip/hip_cooperative_groups.h>
#include <cstdio>
#include <cstdint>
namespace cg = cooperative_groups;

constexpr int DM = 2048, MP = 8192, MS = 1024, MT = MP + MS, FF = 5632, NQKVG = 12288, RV = 4096;
constexpr float ALPHA = 1.41421356237309515f;
constexpr float LN_EPS = 1e-5f, GN_EPS = 1e-6f;

namespace pg8 {
#define PG8_LAS __attribute__((address_space(3)))
typedef unsigned short bf16_t;
typedef short bf16x8 __attribute__((ext_vector_type(8)));
typedef float f32x4 __attribute__((ext_vector_type(4)));
typedef unsigned u32x4 __attribute__((ext_vector_type(4)));
constexpr int BM = 256, BK = 64, HALF = 128, HTB = HALF * BK * 2  , STAGE_BYTES = 8 * HTB, NXCD = 8, WGM = 4;

__host__ __device__ __forceinline__ int lds_byte(int r, int c) { const int st = (r >> 4) * 2 + (c >> 5), rr = r & 15, cc = c & 31, ob = rr * 64 + cc * 2; return st * 1024 + (ob ^ (((ob >> 9) & 1) << 5)); }
__host__ __device__ __forceinline__ void stage_rc(int b, int& R, int& C) { const int st = b / 1024, sb = b % 1024, swz = sb ^ (((sb >> 9) & 1) << 5); R = (st >> 1) * 16 + swz / 64; C = (st & 1) * 32 + (swz % 64) / 2; }
__host__ __device__ __forceinline__ int perm32(int rho) { const int n = rho >> 4, i = rho & 15; return 8 * (i >> 2) + 4 * n + (i & 3); }

struct Unit { int pm, pn, k0, nt, ks; };
struct Gemm { const bf16_t* A; const bf16_t* Bt; int ld; };

struct StaticOrder {
    int nM, nN, nwg, G, c;
    __host__ __device__ void init(int M, int N, int G_, int c_) { nM = M / BM; nN = N / BM; nwg = nM * nN; G = G_; c = c_; }
    __host__ __device__ __forceinline__ void tile(int L, int& pm_, int& pn_) const {
        int wgid = L; { const int q = nwg / NXCD, r = nwg % NXCD, xcd = wgid % NXCD, off = wgid / NXCD; wgid = (xcd < r ? xcd * (q + 1) : r * (q + 1) + (xcd - r) * q) + off; }
        const int nig = WGM * nN, gid = wgid / nig, fm = gid * WGM, gsz = (nM - fm) < WGM ? (nM - fm) : WGM;
        pm_ = fm + ((wgid % nig) % gsz); pn_ = (wgid % nig) / gsz;
    }
    __device__ __forceinline__ void a_ready(const Unit&) const {}
    __device__ __forceinline__ void done(const Unit&) const {}
};

typedef float f32x2_cv __attribute__((ext_vector_type(2))); typedef __bf16 bf16x2_cv __attribute__((ext_vector_type(2)));
__device__ __forceinline__ unsigned cvt_pk_bf16(float lo, float hi) { const f32x2_cv v = {lo, hi}; const bf16x2_cv b = __builtin_convertvector(v, bf16x2_cv); return __builtin_bit_cast(unsigned, b); }
typedef float f32x2 __attribute__((ext_vector_type(2)));
__device__ __forceinline__ f32x2 gelu_pk(f32x2 v) {
    const f32x2 av = __builtin_elementwise_abs(v), d = av * 0.2316418882f + 1.0f;
    f32x2 t; t.x = __builtin_amdgcn_rcpf(d.x); t.y = __builtin_amdgcn_rcpf(d.y);
    f32x2 q = t * 0.5307027145f + (-0.7265760135f); q = q * t + 0.7107068705f; q = q * t + (-0.142248368f); q = q * t + 0.127414796f; q = q * t;
    const f32x2 s = (v * v) * (-0.72134752044f);
    f32x2 e; e.x = __builtin_amdgcn_exp2f(s.x); e.y = __builtin_amdgcn_exp2f(s.y);
    const f32x2 m = v * (q * e), r = v - m;
    f32x2 o; o.x = v.x < 0.f ? m.x : r.x; o.y = v.y < 0.f ? m.y : r.y; return o;
}
struct Order {
    StaticOrder so; int G, c, n1c, ntk, split;
    __device__ __forceinline__ void init(int M1, int N, int K, int split_, int G_, int c_) { so.init(M1, N, G_, c_); G = G_; c = c_; ntk = K / BK; split = split_; n1c = (c < so.nwg) ? (so.nwg - c + G - 1) / G : 0; }
    __device__ __forceinline__ bool next(int i, Unit& u) const {
        const bool p1 = i < n1c; int pm1, pn1; so.tile(p1 ? i * G + c : 0, pm1, pn1);
        const int j = (i - n1c) * G + c; const bool p2 = !p1 && split != 0 && j < 256;
        const int ks = j & 7, jj = (j >> 3) & 31, b = (ntk >> 3) & ~1, rem2 = (ntk - 8 * b) >> 1;
        Unit r; r.pm = p1 ? pm1 : so.nM + (jj & 3); r.pn = p1 ? pn1 : (jj >> 2); r.k0 = p1 ? 0 : (ks * b + 2 * (ks < rem2 ? ks : rem2)) * BK; r.nt = p1 ? ntk : b + (ks < rem2 ? 2 : 0); r.ks = p1 ? -1 : ks;
        u = r; return p1 || p2;
    }
    __device__ __forceinline__ void a_ready(const Unit&) const {}
    __device__ __forceinline__ void done(const Unit&) const {}
};

__device__ __forceinline__ float silu_f(float x) { return x * __builtin_amdgcn_rcpf(1.0f + __builtin_amdgcn_exp2f(-1.4426950408889634f * x)); }

struct EpiPart {
    static constexpr bool PERM = true, AFTER_DRAIN = false;
    bf16_t* Yb; float* Ys;
    __device__ __forceinline__ void operator()(const f32x4 (&acc)[2][2][4][2], const Unit& u, int wr, int wc, int fr, int fq) const {
        const int row0 = u.pm * BM + wr * 64 + fr, col0 = u.pn * BM + wc * 32 + 8 * fq;
        if (u.ks < 0) {
#pragma unroll
            for (int ai = 0; ai < 2; ++ai)
#pragma unroll
                for (int m = 0; m < 4; ++m) { bf16_t* rowp = Yb + (size_t)(row0 + ai * HALF + m * 16) * 2048 + col0;
#pragma unroll
                    for (int bj = 0; bj < 2; ++bj) { const f32x4 v0 = acc[ai][bj][m][0], v1 = acc[ai][bj][m][1];
                        u32x4 w; w.x = cvt_pk_bf16(v0[0], v0[1]); w.y = cvt_pk_bf16(v0[2], v0[3]); w.z = cvt_pk_bf16(v1[0], v1[1]); w.w = cvt_pk_bf16(v1[2], v1[3]);
                        *(u32x4*)(rowp + bj * HALF) = w; } }
        } else {
#pragma unroll
            for (int ai = 0; ai < 2; ++ai)
#pragma unroll
                for (int m = 0; m < 4; ++m) { float* rowp = Ys + (size_t)(row0 - 8192 + u.ks * 1024 + ai * HALF + m * 16) * 2048 + col0;
#pragma unroll
                    for (int bj = 0; bj < 2; ++bj) { *(f32x4*)(rowp + bj * HALF) = acc[ai][bj][m][0]; *(f32x4*)(rowp + bj * HALF + 4) = acc[ai][bj][m][1]; } }
        }
    }
};
struct EpiGeluUV {
    static constexpr bool PERM = true, AFTER_DRAIN = false;
    bf16_t* U; bf16_t* V; f32x2* stat;
    __device__ __forceinline__ void operator()(const f32x4 (&acc)[2][2][4][2], const Unit& u, int wr, int wc, int fr, int fq) const {
        const bool isv = u.pn >= 8; bf16_t* O = isv ? V : U;
        const int row0 = u.pm * BM + wr * 64 + fr, col0 = (u.pn & 7) * BM + wc * 32 + 8 * fq;
#pragma unroll
        for (int ai = 0; ai < 2; ++ai)
#pragma unroll
            for (int m = 0; m < 4; ++m) { const int row = row0 + ai * HALF + m * 16; bf16_t* rowp = O + (size_t)row * 2048 + col0; float s = 0.f, q = 0.f;
#pragma unroll
                for (int bj = 0; bj < 2; ++bj) { const f32x4 v0 = acc[ai][bj][m][0], v1 = acc[ai][bj][m][1];
                    const f32x2 a = gelu_pk((f32x2){v0[0], v0[1]}), b = gelu_pk((f32x2){v0[2], v0[3]}), c = gelu_pk((f32x2){v1[0], v1[1]}), d = gelu_pk((f32x2){v1[2], v1[3]});
                    s += ((a.x + a.y) + (b.x + b.y)) + ((c.x + c.y) + (d.x + d.y));
                    q += ((a.x * a.x + a.y * a.y) + (b.x * b.x + b.y * b.y)) + ((c.x * c.x + c.y * c.y) + (d.x * d.x + d.y * d.y));
                    u32x4 w; w.x = cvt_pk_bf16(a.x, a.y); w.y = cvt_pk_bf16(b.x, b.y); w.z = cvt_pk_bf16(c.x, c.y); w.w = cvt_pk_bf16(d.x, d.y);
                    *(u32x4*)(rowp + bj * HALF) = w; }
                if (isv) { s += __shfl_xor(s, 16); s += __shfl_xor(s, 32); q += __shfl_xor(q, 16); q += __shfl_xor(q, 32);
                    if (fq == 0) stat[(size_t)row * 32 + (u.pn - 8) * 4 + wc] = (f32x2){s, q}; } }
    }
};
struct EpiSwiglu {
    static constexpr bool PERM = true, AFTER_DRAIN = false;
    bf16_t* H;
    __device__ __forceinline__ void operator()(const f32x4 (&acc)[2][2][4][2], const Unit& u, int wr, int wc, int fr, int fq) const {
        const int row0 = u.pm * BM + wr * 64 + fr, col0 = u.pn * HALF + wc * 32 + 8 * fq;
#pragma unroll
        for (int ai = 0; ai < 2; ++ai)
#pragma unroll
            for (int m = 0; m < 4; ++m) { bf16_t* rowp = H + (size_t)(row0 + ai * HALF + m * 16) * 5632 + col0;
                const f32x4 g0 = acc[ai][0][m][0], g1 = acc[ai][0][m][1], u0 = acc[ai][1][m][0], u1 = acc[ai][1][m][1];
                u32x4 w; w.x = cvt_pk_bf16(silu_f(g0[0]) * u0[0], silu_f(g0[1]) * u0[1]); w.y = cvt_pk_bf16(silu_f(g0[2]) * u0[2], silu_f(g0[3]) * u0[3]);
                w.z = cvt_pk_bf16(silu_f(g1[0]) * u1[0], silu_f(g1[1]) * u1[1]); w.w = cvt_pk_bf16(silu_f(g1[2]) * u1[2], silu_f(g1[3]) * u1[3]);
                *(u32x4*)rowp = w; }
    }
};
__device__ __forceinline__ float lg2gamma(int h) {
    const double x = 1.0 / (double)(32 << h); double p = x, s = 0.0;
    const double inv[8] = {1.0, 0.5, 1.0 / 3.0, 0.25, 0.2, 1.0 / 6.0, 1.0 / 7.0, 0.125};
#pragma unroll
    for (int k = 0; k < 8; ++k) { s -= p * inv[k]; p *= x; }
    return (float)(s * 1.4426950408889634);
}
struct EpiQKVG {
    static constexpr bool PERM = true, AFTER_DRAIN = false;
    bf16_t *QH, *KH, *VB, *GS; const float* ropec; const float* ropes;
    __device__ __forceinline__ void operator()(const f32x4 (&acc)[2][2][4][2], const Unit& u, int wr, int wc, int fr, int fq) const {
        const int row0 = u.pm * BM + wr * 64 + fr, cw = wc * 32 + 8 * fq;
        if (u.pn < 16) {
            const bool isq = u.pn < 8; const int head = u.pn & 7; bf16_t* O = (isq ? QH : KH) + head * 256 + cw;
            const float lg = lg2gamma(head) * (isq ? 1.f : -1.f), sc0 = isq ? 0.0625f : 1.f;
#pragma unroll
            for (int ai = 0; ai < 2; ++ai)
#pragma unroll
                for (int m = 0; m < 4; ++m) { const int row = row0 + ai * HALF + m * 16;
                    const int pidx = row < MP ? (row & 2047) : 2048 + ((row - MP) & 31), ib = row < MP ? (row & 63) : ((row - MP) & 31);
                    const float sc = sc0 * __builtin_amdgcn_exp2f(lg * (float)ib);
                    const f32x4 c0 = *(const f32x4*)(ropec + pidx * 128 + cw), c1 = *(const f32x4*)(ropec + pidx * 128 + cw + 4);
                    const f32x4 s0 = *(const f32x4*)(ropes + pidx * 128 + cw), s1 = *(const f32x4*)(ropes + pidx * 128 + cw + 4);
                    const f32x4 a0 = acc[ai][0][m][0], a1 = acc[ai][0][m][1], b0 = acc[ai][1][m][0], b1 = acc[ai][1][m][1];
                    const f32x4 o0 = (a0 * c0 - b0 * s0) * sc, o1 = (a1 * c1 - b1 * s1) * sc, p0 = (a0 * s0 + b0 * c0) * sc, p1 = (a1 * s1 + b1 * c1) * sc;
                    u32x4 w; w.x = cvt_pk_bf16(o0[0], o0[1]); w.y = cvt_pk_bf16(o0[2], o0[3]); w.z = cvt_pk_bf16(o1[0], o1[1]); w.w = cvt_pk_bf16(o1[2], o1[3]);
                    *(u32x4*)(O + (size_t)row * 2048) = w;
                    w.x = cvt_pk_bf16(p0[0], p0[1]); w.y = cvt_pk_bf16(p0[2], p0[3]); w.z = cvt_pk_bf16(p1[0], p1[1]); w.w = cvt_pk_bf16(p1[2], p1[3]);
                    *(u32x4*)(O + (size_t)row * 2048 + HALF) = w; }
        } else {
            const bool isg = u.pn >= 32; bf16_t* O = (isg ? GS : VB) + ((u.pn - 16) & 15) * BM + cw;
#pragma unroll
            for (int ai = 0; ai < 2; ++ai)
#pragma unroll
                for (int m = 0; m < 4; ++m) { bf16_t* rowp = O + (size_t)(row0 + ai * HALF + m * 16) * 4096;
#pragma unroll
                    for (int bj = 0; bj < 2; ++bj) { f32x4 v0 = acc[ai][bj][m][0], v1 = acc[ai][bj][m][1];
                        if (isg) { v0 = (f32x4){silu_f(v0[0]), silu_f(v0[1]), silu_f(v0[2]), silu_f(v0[3])}; v1 = (f32x4){silu_f(v1[0]), silu_f(v1[1]), silu_f(v1[2]), silu_f(v1[3])}; }
                        u32x4 w; w.x = cvt_pk_bf16(v0[0], v0[1]); w.y = cvt_pk_bf16(v0[2], v0[3]); w.z = cvt_pk_bf16(v1[0], v1[1]); w.w = cvt_pk_bf16(v1[2], v1[3]);
                        *(u32x4*)(rowp + bj * HALF) = w; } }
        }
    }
};
template <class Epi, class Sched, bool ALIGN_EPI = false, bool SP2 = false>
__device__ __forceinline__ void gemm_phase(PG8_LAS unsigned char* lds, const Gemm g, const Sched& S, const Epi& E) {
    int tid_ = threadIdx.x; asm volatile("" : "+v"(tid_));
    const int tid = tid_, wid = __builtin_amdgcn_readfirstlane(tid >> 6), lane = tid & 63, wr = wid >> 2, wc = wid & 3, fr = lane & 15, fq = lane >> 4;
    const int K = g.ld;
    unsigned voffA[2], voffB[2];
#pragma unroll
    for (int i = 0; i < 2; ++i) { int R, C; stage_rc(tid * 16 + i * 8192, R, C); const int Rb = Epi::PERM ? ((R & ~31) + perm32(R & 31)) : R;
        voffA[i] = (unsigned)(R * K + C) * 2u; voffB[i] = (unsigned)(Rb * K + C) * 2u; }
    const size_t kstep = (size_t)(BK * 2);
    const size_t hstep = (size_t)HALF * K * 2;
    const size_t tstep = 2 * hstep;
    const unsigned ldsw = (unsigned)wid * 1024u;
    const int aoff = lds_byte(wr * 64 + fr, fq * 8), boff = lds_byte(wc * 32 + fr, fq * 8);
#define PG8_SA(b, h) (((b) * 2 + (h)) * HTB)
#define PG8_SB(b, h) ((4 + (b) * 2 + (h)) * HTB)
#define PG8_STAGE(bufoff, gbase, voff) do { _Pragma("unroll") for (int _i = 0; _i < 2; ++_i) \
        __builtin_amdgcn_global_load_lds((const unsigned*)((const char*)(gbase) + (voff)[_i]), (PG8_LAS unsigned*)(lds + (bufoff) + ldsw + _i * 8192), 16, 0, 0); } while (0)
#define PG8_LDA(dst, b, h) do { _Pragma("unroll") for (int m = 0; m < 4; ++m) _Pragma("unroll") for (int k = 0; k < 2; ++k) dst[m][k] = *(const PG8_LAS bf16x8*)(lds + PG8_SA(b, h) + aoff + m * 2048 + k * 1024); } while (0)
#define PG8_LDB(dst, b, h) do { _Pragma("unroll") for (int n = 0; n < 2; ++n) _Pragma("unroll") for (int k = 0; k < 2; ++k) dst[n][k] = *(const PG8_LAS bf16x8*)(lds + PG8_SB(b, h) + boff + n * 2048 + k * 1024); } while (0)
#define PG8_MMA(ai, bj, At, Bt) do { __builtin_amdgcn_s_setprio(1); _Pragma("unroll") for (int m = 0; m < 4; ++m) _Pragma("unroll") for (int n = 0; n < 2; ++n) _Pragma("unroll") for (int k = 0; k < 2; ++k) \
        acc[ai][bj][m][n] = __builtin_amdgcn_mfma_f32_16x16x32_bf16(Bt[n][k], At[m][k], acc[ai][bj][m][n], 0, 0, 0); __builtin_amdgcn_s_setprio(0); } while (0)
#define PG8_WAIT_V(n) asm volatile("s_waitcnt vmcnt(" #n ")" ::: "memory")
#define PG8_WAIT_L(n) asm volatile("s_waitcnt lgkmcnt(" #n ")" ::: "memory")
#define PG8_BAR __builtin_amdgcn_s_barrier()
#define PG8_SCHED __builtin_amdgcn_sched_barrier(0)
    Unit cur, nxt; int ui = 0;
    if (!S.next(0, cur)) return;
    f32x4 acc[2][2][4][2];
#pragma unroll
    for (int a = 0; a < 2; ++a)
#pragma unroll
        for (int b = 0; b < 2; ++b)
#pragma unroll
            for (int m = 0; m < 4; ++m)
#pragma unroll
                for (int n = 0; n < 2; ++n) acc[a][b][m][n] = (f32x4){0.f, 0.f, 0.f, 0.f};
    bf16x8 At[4][2], B0[2][2], B1[2][2];
    const char* cA = (const char*)g.A + (size_t)cur.pm * tstep + (size_t)cur.k0 * 2; const char* cB = (const char*)g.Bt + (size_t)cur.pn * tstep + (size_t)cur.k0 * 2; int nt = cur.nt;
    S.a_ready(cur);
    if constexpr (SP2) {
        PG8_STAGE(PG8_SB(0, 0), cB, voffB); PG8_STAGE(PG8_SB(0, 1), cB + hstep, voffB); PG8_STAGE(PG8_SA(0, 0), cA, voffA); PG8_STAGE(PG8_SA(0, 1), cA + hstep, voffA);
        if (wr == 1) PG8_BAR;
        PG8_WAIT_V(2); PG8_BAR;
        PG8_STAGE(PG8_SB(1, 0), cB + kstep, voffB); PG8_STAGE(PG8_SA(1, 0), cA + kstep, voffA); PG8_STAGE(PG8_SB(1, 1), cB + hstep + kstep, voffB);
        PG8_WAIT_V(6); PG8_BAR;
    } else {
        PG8_STAGE(PG8_SB(0, 0), cB, voffB); PG8_STAGE(PG8_SA(0, 0), cA, voffA); PG8_STAGE(PG8_SB(0, 1), cB + hstep, voffB); PG8_STAGE(PG8_SA(0, 1), cA + hstep, voffA);
        if (wr == 1) PG8_BAR;
        PG8_WAIT_V(4); PG8_BAR;
        PG8_STAGE(PG8_SB(1, 0), cB + kstep, voffB); PG8_STAGE(PG8_SA(1, 0), cA + kstep, voffA); PG8_STAGE(PG8_SB(1, 1), cB + hstep + kstep, voffB);
        PG8_WAIT_V(6); PG8_BAR;
    }
    for (;;) {
        const bool has_next = S.next(ui + 1, nxt);
        const char* nA = has_next ? (const char*)g.A + (size_t)nxt.pm * tstep + (size_t)nxt.k0 * 2 : cA; const char* nB = has_next ? (const char*)g.Bt + (size_t)nxt.pn * tstep + (size_t)nxt.k0 * 2 : cB;
        for (int t = 0; t < nt; t += 2) {
            const bool last = (t == nt - 2);
            const char* a1 = cA + (size_t)(t + 1) * kstep;
            const char* a2 = last ? nA : cA + (size_t)(t + 2) * kstep; const char* b2 = last ? nB : cB + (size_t)(t + 2) * kstep;
            const char* a3 = a2 + kstep; const char* b3 = b2 + kstep;
            if (last && has_next) S.a_ready(nxt);
            if constexpr (SP2) {
            PG8_LDB(B0, 0, 0); PG8_LDB(B1, 0, 1); PG8_SCHED; PG8_LDA(At, 0, 0); PG8_STAGE(PG8_SA(1, 1), a1 + hstep, voffA);
            PG8_WAIT_V(8); PG8_WAIT_L(0); PG8_BAR; PG8_MMA(0, 0, At, B0); PG8_MMA(0, 1, At, B1); PG8_BAR; PG8_SCHED;
            PG8_LDA(At, 0, 1); PG8_STAGE(PG8_SB(0, 0), b2, voffB); PG8_STAGE(PG8_SB(0, 1), b2 + hstep, voffB); PG8_STAGE(PG8_SA(0, 0), a2, voffA);
            PG8_WAIT_V(8); PG8_WAIT_L(0); PG8_BAR; PG8_MMA(1, 0, At, B0); PG8_MMA(1, 1, At, B1); PG8_BAR; PG8_SCHED;
            PG8_LDB(B0, 1, 0); PG8_LDB(B1, 1, 1); PG8_SCHED; PG8_LDA(At, 1, 0); PG8_STAGE(PG8_SA(0, 1), a2 + hstep, voffA);
            PG8_WAIT_V(8); PG8_WAIT_L(0); PG8_BAR; PG8_MMA(0, 0, At, B0); PG8_MMA(0, 1, At, B1); PG8_BAR; PG8_SCHED;
            PG8_LDA(At, 1, 1); PG8_STAGE(PG8_SB(1, 0), b3, voffB); PG8_STAGE(PG8_SB(1, 1), b3 + hstep, voffB); PG8_STAGE(PG8_SA(1, 0), a3, voffA);
            PG8_WAIT_V(8); PG8_WAIT_L(0); PG8_BAR; PG8_MMA(1, 0, At, B0); PG8_MMA(1, 1, At, B1); PG8_BAR; PG8_SCHED;
            } else {
            PG8_LDB(B0, 0, 0); PG8_SCHED; PG8_LDA(At, 0, 0); PG8_STAGE(PG8_SA(1, 1), a1 + hstep, voffA);
            PG8_WAIT_L(8); PG8_BAR; PG8_WAIT_L(0); PG8_MMA(0, 0, At, B0); PG8_BAR; PG8_SCHED;
            PG8_LDB(B1, 0, 1); PG8_STAGE(PG8_SB(0, 0), b2, voffB);
            PG8_BAR; PG8_WAIT_L(0); PG8_MMA(0, 1, At, B1); PG8_BAR;
            PG8_LDA(At, 0, 1); PG8_STAGE(PG8_SA(0, 0), a2, voffA);
            PG8_BAR; PG8_WAIT_L(0); PG8_MMA(1, 0, At, B0); PG8_BAR; PG8_SCHED;
            PG8_STAGE(PG8_SB(0, 1), b2 + hstep, voffB);
            PG8_WAIT_V(6); PG8_BAR; PG8_MMA(1, 1, At, B1); PG8_BAR;
            PG8_LDB(B0, 1, 0); PG8_SCHED; PG8_LDA(At, 1, 0); PG8_STAGE(PG8_SA(0, 1), a2 + hstep, voffA);
            PG8_WAIT_L(8); PG8_BAR; PG8_WAIT_L(0); PG8_MMA(0, 0, At, B0); PG8_BAR; PG8_SCHED;
            PG8_LDB(B1, 1, 1); PG8_STAGE(PG8_SB(1, 0), b3, voffB);
            PG8_BAR; PG8_WAIT_L(0); PG8_MMA(0, 1, At, B1); PG8_BAR;
            PG8_LDA(At, 1, 1); PG8_STAGE(PG8_SA(1, 0), a3, voffA);
            PG8_BAR; PG8_WAIT_L(0); PG8_MMA(1, 0, At, B0); PG8_BAR; PG8_SCHED;
            PG8_STAGE(PG8_SB(1, 1), b3 + hstep, voffB);
            PG8_WAIT_V(6); PG8_BAR; PG8_MMA(1, 1, At, B1); PG8_BAR;
            }
        }
        if constexpr (ALIGN_EPI) { if (wr == 0) PG8_BAR; }
        if constexpr (!Epi::AFTER_DRAIN) { E(acc, cur, wr, wc, fr, fq); S.done(cur); }
        if (!has_next) break;
#pragma unroll
        for (int a = 0; a < 2; ++a)
#pragma unroll
            for (int b = 0; b < 2; ++b)
#pragma unroll
                for (int m = 0; m < 4; ++m)
#pragma unroll
                    for (int n = 0; n < 2; ++n) acc[a][b][m][n] = (f32x4){0.f, 0.f, 0.f, 0.f};
        cur = nxt; cA = nA; cB = nB; nt = cur.nt; ++ui;
        if constexpr (ALIGN_EPI) { if (wr == 1) PG8_BAR; }
    }
    PG8_WAIT_V(0);
    if constexpr (!ALIGN_EPI) { if (wr == 0) PG8_BAR; }
    PG8_BAR;
    if constexpr (Epi::AFTER_DRAIN) { E.fused(acc, cur, wr, wc, fr, fq, lds, wid, lane); S.done(cur); }
#undef PG8_SA
#undef PG8_SB
#undef PG8_STAGE
#undef PG8_LDA
#undef PG8_LDB
#undef PG8_MMA
#undef PG8_WAIT_V
#undef PG8_WAIT_L
#undef PG8_BAR
#undef PG8_SCHED
}
}
constexpr size_t MiB = 1u << 20;
constexpr size_t WS_WAIN = 0, WS_WAOUT = 16 * MiB, WS_WBIN = 24 * MiB, WS_WBOUT = 72 * MiB, WS_WFIN = 88 * MiB, WS_WFOUT = 176 * MiB;
constexpr size_t WS_XB = 220 * MiB;
constexpr size_t WS_STAT = 256 * MiB;
constexpr size_t WS_ROPE = 259 * MiB;
constexpr size_t WS_YP = 262 * MiB;
constexpr size_t WS_XF = 390 * MiB;
constexpr size_t WS_R1 = 462 * MiB;
constexpr size_t WS_CTL = 678 * MiB, CTL_BYTES = 16384;
constexpr size_t WS_END = 679 * MiB;
constexpr int MISC_OFF = 131072 + 320;
constexpr int LDS_BYTES = 147456;
constexpr int NW = 8;

#define LAS __attribute__((address_space(3)))
typedef unsigned short bf16;
typedef unsigned u32x4 __attribute__((ext_vector_type(4)));
typedef unsigned u32x2 __attribute__((ext_vector_type(2)));
typedef float f32x4 __attribute__((ext_vector_type(4)));
typedef float f32x2 __attribute__((ext_vector_type(2)));
typedef short bf16x8 __attribute__((ext_vector_type(8)));
typedef short s16x4 __attribute__((ext_vector_type(4)));
#define LDS_WAIT() asm volatile("s_waitcnt lgkmcnt(0)" ::: "memory")
__device__ __forceinline__ unsigned pk2(float lo, float hi) { return pg8::cvt_pk_bf16(lo, hi); }
__device__ __forceinline__ float bf_lo(unsigned w) { return __uint_as_float(w << 16); }
__device__ __forceinline__ float bf_hi(unsigned w) { return __uint_as_float(w & 0xffff0000u); }
__device__ __forceinline__ float wave_sum(float v) {
#pragma unroll
    for (int o = 1; o < 64; o <<= 1) v += __shfl_xor(v, o);
    return v;
}

struct Args { const float* in[17]; float* out; unsigned char* ws; };

template <int MAPMODE>
__device__ __forceinline__ void p0_transpose_item(const float* W, int K, int N, bf16* WT, LAS float* scr, int item, int lane) {
    const int nblk = N / 32, kb = item / nblk, nb = item % nblk, k0 = 64 * kb, n0 = 32 * nb;
#pragma unroll 8
    for (int i = 0; i < 32; ++i) { const int kk = 2 * i + (lane >> 5); scr[kk * 33 + (lane & 31)] = __builtin_nontemporal_load(W + (size_t)(k0 + kk) * N + n0 + (lane & 31)); }
    LDS_WAIT(); asm volatile("" ::: "memory");
    int r0 = n0;
    if (MAPMODE == 1) { const int up = n0 >= FF ? 1 : 0, c = n0 - up * FF; r0 = 256 * (c >> 7) + (c & 127) + 128 * up; }
    const int c8 = lane & 7;
#pragma unroll
    for (int j = 0; j < 4; ++j) { const int n = (lane >> 3) + 8 * j; const LAS float* s = scr + (8 * c8) * 33 + n;
        u32x4 o; o.x = pk2(s[0 * 33], s[1 * 33]); o.y = pk2(s[2 * 33], s[3 * 33]); o.z = pk2(s[4 * 33], s[5 * 33]); o.w = pk2(s[6 * 33], s[7 * 33]);
        *(u32x4*)(WT + (size_t)(r0 + n) * K + k0 + 8 * c8) = o; }
    LDS_WAIT(); asm volatile("" ::: "memory");
}
__device__ __forceinline__ void convert_list(const Args& a, LAS unsigned char* lds, int list, int w, int nw, int wave, int lane) {
    LAS float* scr = (LAS float*)(lds + wave * 16384);
    unsigned char* ws = a.ws;
    constexpr int I0 = 32 * 128, I1 = 32 * 64, I2 = 32 * 384, I3 = 64 * 64, I4 = 32 * 352, I5 = 88 * 64;
    if (list == 0) {
        for (int r = w; r < I0; r += nw) p0_transpose_item<0>(a.in[3], 2048, 4096, (bf16*)(ws + WS_WAIN), scr, r, lane);
    } else if (list == 1) {
        for (int it = w; it < I1 + I4 + I5; it += nw) { int r = it;
            if (r < I1) { p0_transpose_item<0>(a.in[8], 2048, 2048, (bf16*)(ws + WS_WAOUT), scr, r, lane); continue; } r -= I1;
            if (r < I4) { p0_transpose_item<1>(a.in[11], 2048, 11264, (bf16*)(ws + WS_WFIN), scr, r, lane); continue; } r -= I4;
            p0_transpose_item<0>(a.in[12], 5632, 2048, (bf16*)(ws + WS_WFOUT), scr, r, lane); }
    } else if (list == 2) {
        for (int it = w; it < I2 + I4; it += nw) { int r = it;
            if (r < I2) { p0_transpose_item<0>(a.in[9], 2048, 12288, (bf16*)(ws + WS_WBIN), scr, r, lane); continue; } r -= I2;
            p0_transpose_item<1>(a.in[11] + (size_t)2048 * 11264, 2048, 11264, (bf16*)(ws + WS_WFIN + 44 * MiB), scr, r, lane); }
    } else if (list == 3) {
        for (int r = w; r < I3; r += nw) p0_transpose_item<0>(a.in[10], 4096, 2048, (bf16*)(ws + WS_WBOUT), scr, r, lane);
    } else {
        for (int r = w; r < I5; r += nw) p0_transpose_item<0>(a.in[12] + (size_t)5632 * 2048, 5632, 2048, (bf16*)(ws + WS_WFOUT + 22 * MiB), scr, r, lane);
    }
}
__device__ __forceinline__ void p0_prologue(const Args& a, LAS unsigned char* lds, int gw, int NGW, int wave, int lane) {
    unsigned char* ws = a.ws;
    convert_list(a, lds, 0, gw, NGW, wave, lane);
    bf16* XB = (bf16*)(ws + WS_XB);
    for (int m = gw; m < MT; m += NGW) {
        const f32x4* xr = (const f32x4*)(m < MP ? a.in[0] + (size_t)m * DM : a.in[1] + (size_t)(m - MP) * DM) + lane;
        u32x2* o = (u32x2*)(XB + (size_t)m * DM) + lane;
#pragma unroll
        for (int j = 0; j < 8; ++j) { const f32x4 v = xr[64 * j]; u32x2 w; w.x = pk2(v[0], v[1]); w.y = pk2(v[2], v[3]); o[64 * j] = w; }
    }
    float* rc = (float*)(ws + WS_ROPE); float* rs = rc + 2080 * 128;
    for (int e = gw * 64 + lane; e < 2080 * 128; e += NGW * 64) {
        const int p = e >> 7, d = e & 127; const float pos = (float)(p < 2048 ? p : 4096 + (p - 2048));
        const float inv = __builtin_amdgcn_exp2f(-(float)d * (13.287712379549449f / 128.0f));
        const double rev = (double)(pos * inv) * 0.15915494309189535; const float fr = (float)(rev - __builtin_floor(rev));
        rc[e] = __builtin_amdgcn_cosf(fr); rs[e] = __builtin_amdgcn_sinf(fr);
    }
}

struct LnIO { const float* xres_p; const float* xres_s; const bf16* xb; const float* YP; const float* g; const float* b; float* outf; bf16* outb; };
__device__ __forceinline__ void ln_load(const LnIO& io, f32x4 (&v)[8], int row, int lane) {
    if (io.xres_p) { const f32x4* xr = (const f32x4*)(row < MP ? io.xres_p + (size_t)row * DM : io.xres_s + (size_t)(row - MP) * DM) + lane;
#pragma unroll
        for (int j = 0; j < 8; ++j) v[j] = xr[64 * j] * ALPHA;
    } else { const u32x2* xr = (const u32x2*)(io.xb + (size_t)row * DM) + lane;
#pragma unroll
        for (int j = 0; j < 8; ++j) { const u32x2 w = xr[64 * j]; v[j] = (f32x4){bf_lo(w.x), bf_hi(w.x), bf_lo(w.y), bf_hi(w.y)} * ALPHA; } }
    if (row < MP) { const u32x2* y = (const u32x2*)((const bf16*)io.YP + (size_t)row * DM) + lane;
#pragma unroll
        for (int j = 0; j < 8; ++j) { const u32x2 w = y[64 * j]; v[j] += (f32x4){bf_lo(w.x), bf_hi(w.x), bf_lo(w.y), bf_hi(w.y)}; }
    } else {
#pragma unroll 2
        for (int ks = 0; ks < 8; ++ks) { const f32x4* y = (const f32x4*)(io.YP + (size_t)(MP + ks * MS + (row - MP)) * DM) + lane;
#pragma unroll
            for (int j = 0; j < 8; ++j) v[j] += y[64 * j]; }
    }
}
__device__ __forceinline__ void ln_finish(const LnIO& io, f32x4 (&v)[8], int row, int lane) {
    float s = 0.f;
#pragma unroll
    for (int j = 0; j < 8; ++j) s += (v[j][0] + v[j][1]) + (v[j][2] + v[j][3]);
    const float mean = wave_sum(s) * (1.f / DM); float q = 0.f;
#pragma unroll
    for (int j = 0; j < 8; ++j) { v[j] = v[j] - mean; q += (v[j][0] * v[j][0] + v[j][1] * v[j][1]) + (v[j][2] * v[j][2] + v[j][3] * v[j][3]); }
    const float rstd = 1.0f / sqrtf(wave_sum(q) * (1.f / DM) + LN_EPS);
#pragma unroll
    for (int j = 0; j < 8; ++j) { const f32x4 gg = ((const f32x4*)io.g)[lane + 64 * j], bb = ((const f32x4*)io.b)[lane + 64 * j]; const f32x4 o = v[j] * rstd * gg + bb;
        if (io.outf) __builtin_nontemporal_store(o, (f32x4*)(io.outf + (size_t)row * DM) + lane + 64 * j);
        if (io.outb) { u32x2 w; w.x = pk2(o[0], o[1]); w.y = pk2(o[2], o[3]); ((u32x2*)(io.outb + (size_t)row * DM) + lane)[64 * j] = w; } }
}
__device__ __forceinline__ void ln_pair(const LnIO& io, int r0, int r1, int lane) { f32x4 va[8], vb[8]; ln_load(io, va, r0, lane); ln_load(io, vb, r1, lane); ln_finish(io, va, r0, lane); ln_finish(io, vb, r1, lane); }
__device__ __forceinline__ void ln_one(const LnIO& io, int r0, int lane) { f32x4 va[8]; ln_load(io, va, r0, lane); ln_finish(io, va, r0, lane); }
__device__ __forceinline__ void ln_pass(const float* xres_p, const float* xres_s, const bf16* xb, const float* YP, const float* g, const float* b, float* outf, bf16* outb, int gw, int NGW, int lane) {
    const LnIO io{xres_p, xres_s, xb, YP, g, b, outf, outb};
    if (NGW == 2048) {
        if (gw < 1024) { ln_one(io, MP + gw, lane); ln_pair(io, gw, gw + 1024, lane); }
        else { const int r = 2048 + (gw - 1024); ln_pair(io, r, r + 1024, lane); ln_pair(io, r + 2048, r + 3072, lane); ln_pair(io, r + 4096, r + 5120, lane); }
    } else {
        for (int row = gw; row < MT; row += NGW) ln_one(io, row, lane);
    }
}

__device__ __forceinline__ bf16x8 frag_plain(const LAS bf16* X, int ld, int r0, int k0, int lane) { return *(const LAS bf16x8*)(X + (r0 + (lane & 15)) * ld + k0 + 8 * (lane >> 4)); }
typedef short v4i16_t __attribute__((ext_vector_type(4)));
__device__ __forceinline__ bf16x8 frag_tr(const LAS bf16* Y, int ld, int kr0, int c0, int lane) {
    const int i = lane & 15, g4 = lane >> 4; const LAS bf16* p = Y + (kr0 + 8 * g4 + (i >> 2)) * ld + c0 + 4 * (i & 3);
    const v4i16_t lo = __builtin_amdgcn_ds_read_tr16_b64_v4i16((LAS v4i16_t*)p), hi = __builtin_amdgcn_ds_read_tr16_b64_v4i16((LAS v4i16_t*)(p + 4 * ld));
    return (bf16x8){lo[0], lo[1], lo[2], lo[3], hi[0], hi[1], hi[2], hi[3]};
}
#define MFMA16(a, b, c) __builtin_amdgcn_mfma_f32_16x16x32_bf16((a), (b), (c), 0, 0, 0)

template <int Q>
__device__ __forceinline__ void mix_item(const Args& a, LAS unsigned char* lds, int rb, int g, int cq, int wave, int lane) {
    constexpr int NCT = 16 / Q, NV = 8 / Q;
    const int tid = threadIdx.x;
    LAS bf16* Wm = (LAS bf16*)lds;
    LAS bf16* vn = (LAS bf16*)(lds + 34816);
    LAS f32x2* mr = (LAS f32x2*)(lds + 34816 + 67584);
    const bf16* U = (const bf16*)(a.ws + WS_R1); const bf16* V = U + (size_t)MT * DM; bf16* SB = (bf16*)(a.ws + WS_R1 + 72 * MiB);
    const f32x2* stat = (const f32x2*)(a.ws + WS_STAT);
    const float* lng = a.in[4]; const float* lnb = a.in[5]; const float* aws = a.in[6]; const float* abs_ = a.in[7];
    float* gv = a.out + (size_t)MT * DM + (size_t)(4 + 32) * 8 * 256 * 512;
    const int row0 = rb * 128, cbase = g * 256 + cq * (256 / Q); const bool smp = rb >= 64;
    const int wt = tid >> 2, ws0 = (tid & 3) * 32, wtw = smp ? (wt & 31) : wt;
    f32x4 wreg[8];
#pragma unroll
    for (int k = 0; k < 4; ++k) { const int sw = smp ? ((ws0 + 8 * k) & 31) : (ws0 + 8 * k); const float* wp = aws + ((size_t)g * 128 + wtw) * 128 + sw; wreg[2 * k] = *(const f32x4*)wp; wreg[2 * k + 1] = *(const f32x4*)(wp + 4); }
    const int vs_ = tid >> 2, vcb = (tid & 3) * (64 / Q); const bf16* vp = V + (size_t)(row0 + vs_) * DM + cbase + vcb;
    u32x4 vreg[NV];
#pragma unroll
    for (int k = 0; k < NV; ++k) vreg[k] = *(const u32x4*)(vp + 8 * k);
    const int t0 = 16 * wave, i = lane & 15, g4 = lane >> 4, t = t0 + i, row = row0 + t;
    u32x2 ureg[NCT];
#pragma unroll
    for (int ct = 0; ct < NCT; ++ct) ureg[ct] = *(const u32x2*)(U + (size_t)row * DM + cbase + 16 * ct + 4 * g4);
    const float bias = abs_[g * 128 + (smp ? (t & 31) : t)];
    if (tid < 128) { const f32x4* sp = (const f32x4*)(stat + (size_t)(row0 + tid) * 32); float s_ = 0.f, q_ = 0.f;
#pragma unroll
        for (int k = 0; k < 16; ++k) { const f32x4 v = sp[k]; s_ += v[0] + v[2]; q_ += v[1] + v[3]; }
        const float mean = s_ * (1.f / 2048.f), var = q_ * (1.f / 2048.f) - mean * mean; mr[tid] = (f32x2){mean, 1.0f / sqrtf(var + LN_EPS)}; }
#pragma unroll
    for (int k = 0; k < 4; ++k) { const int s0 = ws0 + 8 * k; const f32x4 w0 = wreg[2 * k], w1 = wreg[2 * k + 1];
        float w[8] = {w0[0], w0[1], w0[2], w0[3], w1[0], w1[1], w1[2], w1[3]};
#pragma unroll
        for (int e = 0; e < 8; ++e) { const int ss = s0 + e; const bool ok = smp ? ((ss >> 5) == (wt >> 5) && (ss & 31) <= (wt & 31)) : (ss <= wt); w[e] = ok ? w[e] : 0.f; }
        u32x4 o; o.x = pk2(w[0], w[1]); o.y = pk2(w[2], w[3]); o.z = pk2(w[4], w[5]); o.w = pk2(w[6], w[7]);
        *(LAS u32x4*)(Wm + wt * 136 + s0) = o; }
    __syncthreads();
    { const f32x2 m = mr[vs_];
#pragma unroll
        for (int k = 0; k < NV; ++k) { const u32x4 w = vreg[k]; const int c = cbase + vcb + 8 * k;
            const f32x4 g0 = *(const f32x4*)(lng + c), g1 = *(const f32x4*)(lng + c + 4), b0 = *(const f32x4*)(lnb + c), b1 = *(const f32x4*)(lnb + c + 4);
            f32x4 x0 = (f32x4){bf_lo(w.x), bf_hi(w.x), bf_lo(w.y), bf_hi(w.y)}, x1 = (f32x4){bf_lo(w.z), bf_hi(w.z), bf_lo(w.w), bf_hi(w.w)};
            x0 = (x0 - m.x) * m.y * g0 + b0; x1 = (x1 - m.x) * m.y * g1 + b1;
            u32x4 o; o.x = pk2(x0[0], x0[1]); o.y = pk2(x0[2], x0[3]); o.z = pk2(x1[0], x1[1]); o.w = pk2(x1[2], x1[3]);
            *(LAS u32x4*)(vn + vs_ * 264 + vcb + 8 * k) = o;
            if (smp) { float* op = gv + (size_t)(row0 + vs_ - MP) * DM + c; __builtin_nontemporal_store(x0, (f32x4*)op); __builtin_nontemporal_store(x1, (f32x4*)(op + 4)); } } }
    __syncthreads();
    {
        f32x4 acc[NCT];
#pragma unroll
        for (int ct = 0; ct < NCT; ++ct) acc[ct] = (f32x4){0.f, 0.f, 0.f, 0.f};
        const int kmax = (t0 + 15) >> 5;
        for (int kk = 0; kk <= kmax; ++kk) { const bf16x8 bw = frag_plain(Wm, 136, t0, 32 * kk, lane);
#pragma unroll
            for (int ct = 0; ct < NCT; ++ct) { const bf16x8 av = frag_tr(vn, 264, 32 * kk, 16 * ct, lane); acc[ct] = MFMA16(av, bw, acc[ct]); } }
#pragma unroll
        for (int ct = 0; ct < NCT; ++ct) { const size_t off = (size_t)row * DM + cbase + 16 * ct + 4 * g4; const u32x2 uu = ureg[ct];
            u32x2 o; o.x = pk2(bf_lo(uu.x) * (acc[ct][0] + bias), bf_hi(uu.x) * (acc[ct][1] + bias)); o.y = pk2(bf_lo(uu.y) * (acc[ct][2] + bias), bf_hi(uu.y) * (acc[ct][3] + bias));
            *(u32x2*)(SB + off) = o; }
    }
    __syncthreads();
}
__device__ __forceinline__ void mix_phase(const Args& a, LAS unsigned char* lds, int wave, int lane) {
    for (int item = blockIdx.x; item < 64 * 8; item += gridDim.x) mix_item<1>(a, lds, item >> 3, item & 7, 0, wave, lane);
    for (int item = blockIdx.x; item < 8 * 8 * 4; item += gridDim.x) mix_item<4>(a, lds, 64 + (item >> 5), (item >> 2) & 7, item & 3, wave, lane);
}
constexpr int R_QS = 0, R_KS = 33792, R_VS = 67584, R_PS = 76800, R_RT = 86016, R_OS = 119808;
template <int L>
__device__ __forceinline__ void ret_run(LAS unsigned char* lds, const bf16* QH, const bf16* KH, const bf16* VB, bf16* OB, int grow0, int nblk, int h, int slice, const float* S0, float* Sout, int wave, int lane) {
    const int tid = threadIdx.x, i = lane & 15, g4 = lane >> 4;
    LAS bf16* qs = (LAS bf16*)(lds + R_QS); LAS bf16* ks = (LAS bf16*)(lds + R_KS); LAS bf16* vs = (LAS bf16*)(lds + R_VS);
    LAS bf16* ps = (LAS bf16*)(lds + R_PS); LAS bf16* rts = (LAS bf16*)(lds + R_RT); LAS bf16* os = (LAS bf16*)(lds + R_OS);
    const float lg = pg8::lg2gamma(h);
    const float gL = __builtin_amdgcn_exp2f(lg * (float)L), gLm1 = __builtin_amdgcn_exp2f(lg * (float)(L - 1)), gLm1i = __builtin_amdgcn_exp2f(-lg * (float)(L - 1));
    constexpr int NQ = L / 16, NT = L / 32, NKK = L / 32;
    const bool vthr = (L == 64) || tid < 256;
    u32x4 pq[NQ], pk[NQ], pv;
#define RET_GLOAD(blk) do { const int r0_ = grow0 + (blk) * L; _Pragma("unroll") for (int k_ = 0; k_ < NQ; ++k_) { const int e_ = tid + 512 * k_, row_ = e_ >> 5, ch_ = e_ & 31; \
        pq[k_] = *(const u32x4*)(QH + (size_t)(r0_ + row_) * 2048 + h * 256 + ch_ * 8); pk[k_] = *(const u32x4*)(KH + (size_t)(r0_ + row_) * 2048 + h * 256 + ch_ * 8); } \
        if (vthr) pv = *(const u32x4*)(VB + (size_t)(r0_ + (tid >> 3)) * 4096 + h * 512 + slice * 64 + (tid & 7) * 8); } while (0)
#define RET_LSTORE() do { _Pragma("unroll") for (int k_ = 0; k_ < NQ; ++k_) { const int e_ = tid + 512 * k_, row_ = e_ >> 5, ch_ = e_ & 31; \
        *(LAS u32x4*)(qs + row_ * 264 + ch_ * 8) = pq[k_]; *(LAS u32x4*)(ks + row_ * 264 + ch_ * 8) = pk[k_]; } \
        if (vthr) *(LAS u32x4*)(vs + (tid >> 3) * 72 + (tid & 7) * 8) = pv; } while (0)
    f32x4 R[2][4];
    RET_GLOAD(0);
#pragma unroll
    for (int a2 = 0; a2 < 2; ++a2)
#pragma unroll
        for (int d = 0; d < 4; ++d) {
            if (S0) {
#pragma unroll
                for (int e = 0; e < 4; ++e) R[a2][d][e] = S0[(size_t)(32 * wave + 16 * a2 + 4 * g4 + e) * 512 + slice * 64 + 16 * d + i] * gLm1i;
            } else R[a2][d] = (f32x4){0.f, 0.f, 0.f, 0.f};
            u32x2 w; w.x = pk2(R[a2][d][0], R[a2][d][1]); w.y = pk2(R[a2][d][2], R[a2][d][3]);
            *(LAS u32x2*)(rts + (16 * d + i) * 264 + 32 * wave + 16 * a2 + 4 * g4) = w; }
    RET_LSTORE();
    __syncthreads();
    const int it = (L == 64) ? (wave >> 1) : (wave >> 2);
    for (int n = 0; n < nblk; ++n) {
        if (n + 1 < nblk) RET_GLOAD(n + 1);
        bf16x8 qf[8];
#pragma unroll
        for (int kk = 0; kk < 8; ++kk) qf[kk] = frag_plain(qs, 264, 16 * it, 32 * kk, lane);
        if (L == 64 || wave < 4) {
#pragma unroll
            for (int tp = 0; tp < NT; ++tp) { const int i0 = 16 * (wave >> 1), j0 = (L == 64) ? 16 * (2 * (wave & 1) + tp) : 16 * (wave & 1);
                f32x4 acc = (f32x4){0.f, 0.f, 0.f, 0.f};
#pragma unroll
                for (int kk = 0; kk < 8; ++kk) acc = MFMA16(frag_plain(ks, 264, j0, 32 * kk, lane), (L == 64) ? qf[kk] : frag_plain(qs, 264, i0, 32 * kk, lane), acc);
#pragma unroll
                for (int e = 0; e < 4; ++e) acc[e] = (j0 + 4 * g4 + e <= i0 + i) ? acc[e] : 0.f;
                u32x2 w; w.x = pk2(acc[0], acc[1]); w.y = pk2(acc[2], acc[3]); *(LAS u32x2*)(ps + (i0 + i) * 72 + j0 + 4 * g4) = w; }
        }
        f32x4 oacc[NT];
#pragma unroll
        for (int tp = 0; tp < NT; ++tp) { const int dv0 = (L == 64) ? 16 * (2 * (wave & 1) + tp) : 16 * (wave & 3);
            f32x4 acc = (f32x4){0.f, 0.f, 0.f, 0.f};
#pragma unroll
            for (int kk = 0; kk < 8; ++kk) acc = MFMA16(frag_plain(rts, 264, dv0, 32 * kk, lane), qf[kk], acc);
            oacc[tp] = acc * gL; }
        __syncthreads();
#pragma unroll
        for (int tp = 0; tp < NT; ++tp) { const int dv0 = (L == 64) ? 16 * (2 * (wave & 1) + tp) : 16 * (wave & 3);
#pragma unroll
            for (int kk = 0; kk < NKK; ++kk) oacc[tp] = MFMA16(frag_tr(vs, 72, 32 * kk, dv0, lane), frag_plain(ps, 72, 16 * it, 32 * kk, lane), oacc[tp]);
            u32x2 w; w.x = pk2(oacc[tp][0], oacc[tp][1]); w.y = pk2(oacc[tp][2], oacc[tp][3]); *(LAS u32x2*)(os + (16 * it + i) * 72 + dv0 + 4 * g4) = w; }
#pragma unroll
        for (int a2 = 0; a2 < 2; ++a2)
#pragma unroll
            for (int d = 0; d < 4; ++d) R[a2][d] = R[a2][d] * gL;
#pragma unroll
        for (int kk = 0; kk < NKK; ++kk) { bf16x8 bv[4];
#pragma unroll
            for (int d = 0; d < 4; ++d) bv[d] = frag_tr(vs, 72, 32 * kk, 16 * d, lane);
#pragma unroll
            for (int a2 = 0; a2 < 2; ++a2) { const bf16x8 av = frag_tr(ks, 264, 32 * kk, 32 * wave + 16 * a2, lane);
#pragma unroll
                for (int d = 0; d < 4; ++d) R[a2][d] = MFMA16(av, bv[d], R[a2][d]); } }
        __syncthreads();
#pragma unroll
        for (int a2 = 0; a2 < 2; ++a2)
#pragma unroll
            for (int d = 0; d < 4; ++d) { u32x2 w; w.x = pk2(R[a2][d][0], R[a2][d][1]); w.y = pk2(R[a2][d][2], R[a2][d][3]);
                *(LAS u32x2*)(rts + (16 * d + i) * 264 + 32 * wave + 16 * a2 + 4 * g4) = w; }
        if (vthr) *(u32x4*)(OB + (size_t)(grow0 + n * L + (tid >> 3)) * 4096 + h * 512 + slice * 64 + (tid & 7) * 8) = *(const LAS u32x4*)(os + (tid >> 3) * 72 + (tid & 7) * 8);
        if (n + 1 < nblk) RET_LSTORE();
        __syncthreads();
    }
#pragma unroll
    for (int a2 = 0; a2 < 2; ++a2)
#pragma unroll
        for (int d = 0; d < 4; ++d)
#pragma unroll
            for (int e = 0; e < 4; ++e) __builtin_nontemporal_store(R[a2][d][e] * gLm1, Sout + (size_t)(32 * wave + 16 * a2 + 4 * g4 + e) * 512 + slice * 64 + 16 * d + i);
#undef RET_GLOAD
#undef RET_LSTORE
}

constexpr int S_QS = 0, S_KS = 16896, S_PS = 33792, S_RT = 38400, S_VS = 105984, S_OS = 115200;
__device__ __forceinline__ void ret_sample(LAS unsigned char* lds, const bf16* QH, const bf16* KH, const bf16* VB, bf16* OB, int grow0, int h, const float* S0, float* Sout, int wave, int lane) {
    const int tid = threadIdx.x, i = lane & 15, g4 = lane >> 4;
    LAS bf16* qs = (LAS bf16*)(lds + S_QS); LAS bf16* ks = (LAS bf16*)(lds + S_KS); LAS bf16* ps = (LAS bf16*)(lds + S_PS);
    const float lg = pg8::lg2gamma(h);
    const float gL = __builtin_amdgcn_exp2f(lg * 32.f), gLm1 = __builtin_amdgcn_exp2f(lg * 31.f), gLm1i = __builtin_amdgcn_exp2f(-lg * 31.f);
    const bool vthr = tid < 256;
#pragma unroll
    for (int k = 0; k < 2; ++k) { const int e = tid + 512 * k, row = e >> 5, ch = e & 31;
        *(LAS u32x4*)(qs + row * 264 + ch * 8) = *(const u32x4*)(QH + (size_t)(grow0 + row) * 2048 + h * 256 + ch * 8);
        *(LAS u32x4*)(ks + row * 264 + ch * 8) = *(const u32x4*)(KH + (size_t)(grow0 + row) * 2048 + h * 256 + ch * 8); }
    f32x4 Rn[2][4]; u32x4 vn = (u32x4){0u, 0u, 0u, 0u};
#define SMP_PREFETCH(sl) do { _Pragma("unroll") for (int a2 = 0; a2 < 2; ++a2) _Pragma("unroll") for (int d = 0; d < 4; ++d) _Pragma("unroll") for (int e = 0; e < 4; ++e) \
        Rn[a2][d][e] = __builtin_nontemporal_load(S0 + (size_t)(32 * wave + 16 * a2 + 4 * g4 + e) * 512 + (sl) * 64 + 16 * d + i); \
        if (vthr) vn = *(const u32x4*)(VB + (size_t)(grow0 + (tid >> 3)) * 4096 + h * 512 + (sl) * 64 + (tid & 7) * 8); } while (0)
    SMP_PREFETCH(0);
    __syncthreads();
    if (wave < 4) {
        const int i0 = 16 * (wave >> 1), j0 = 16 * (wave & 1); f32x4 acc = (f32x4){0.f, 0.f, 0.f, 0.f};
#pragma unroll
        for (int kk = 0; kk < 8; ++kk) acc = MFMA16(frag_plain(ks, 264, j0, 32 * kk, lane), frag_plain(qs, 264, i0, 32 * kk, lane), acc);
#pragma unroll
        for (int e = 0; e < 4; ++e) acc[e] = (j0 + 4 * g4 + e <= i0 + i) ? acc[e] : 0.f;
        u32x2 w; w.x = pk2(acc[0], acc[1]); w.y = pk2(acc[2], acc[3]); *(LAS u32x2*)(ps + (i0 + i) * 72 + j0 + 4 * g4) = w;
    }
    const int it = wave >> 2, dv0 = 16 * (wave & 3);
    bf16x8 qf[8], av[2];
#pragma unroll
    for (int kk = 0; kk < 8; ++kk) qf[kk] = frag_plain(qs, 264, 16 * it, 32 * kk, lane);
#pragma unroll
    for (int a2 = 0; a2 < 2; ++a2) av[a2] = frag_tr(ks, 264, 0, 32 * wave + 16 * a2, lane);
    __syncthreads();
    const bf16x8 pf = frag_plain(ps, 72, 16 * it, 0, lane);
    for (int sl = 0; sl < 8; ++sl) {
        LAS bf16* rts = (LAS bf16*)(lds + S_RT + (sl & 1) * 33792); LAS bf16* vs = (LAS bf16*)(lds + S_VS + (sl & 1) * 4608); LAS bf16* os = (LAS bf16*)(lds + S_OS + (sl & 1) * 4608);
        f32x4 R[2][4];
#pragma unroll
        for (int a2 = 0; a2 < 2; ++a2)
#pragma unroll
            for (int d = 0; d < 4; ++d) { R[a2][d] = Rn[a2][d] * gLm1i; u32x2 w; w.x = pk2(R[a2][d][0], R[a2][d][1]); w.y = pk2(R[a2][d][2], R[a2][d][3]);
                *(LAS u32x2*)(rts + (16 * d + i) * 264 + 32 * wave + 16 * a2 + 4 * g4) = w; }
        if (vthr) *(LAS u32x4*)(vs + (tid >> 3) * 72 + (tid & 7) * 8) = vn;
        if (sl + 1 < 8) SMP_PREFETCH(sl + 1);
        __syncthreads();
        if (sl > 0 && vthr) *(u32x4*)(OB + (size_t)(grow0 + (tid >> 3)) * 4096 + h * 512 + (sl - 1) * 64 + (tid & 7) * 8) = *(const LAS u32x4*)((LAS bf16*)(lds + S_OS + ((sl - 1) & 1) * 4608) + (tid >> 3) * 72 + (tid & 7) * 8);
        f32x4 acc = (f32x4){0.f, 0.f, 0.f, 0.f};
#pragma unroll
        for (int kk = 0; kk < 8; ++kk) acc = MFMA16(frag_plain(rts, 264, dv0, 32 * kk, lane), qf[kk], acc);
        acc = acc * gL;
        acc = MFMA16(frag_tr(vs, 72, 0, dv0, lane), pf, acc);
        { u32x2 w; w.x = pk2(acc[0], acc[1]); w.y = pk2(acc[2], acc[3]); *(LAS u32x2*)(os + (16 * it + i) * 72 + dv0 + 4 * g4) = w; }
        bf16x8 bv[4];
#pragma unroll
        for (int d = 0; d < 4; ++d) bv[d] = frag_tr(vs, 72, 0, 16 * d, lane);
#pragma unroll
        for (int a2 = 0; a2 < 2; ++a2)
#pragma unroll
            for (int d = 0; d < 4; ++d) { R[a2][d] = MFMA16(av[a2], bv[d], R[a2][d] * gL);
#pragma unroll
                for (int e = 0; e < 4; ++e) __builtin_nontemporal_store(R[a2][d][e] * gLm1, Sout + (size_t)(32 * wave + 16 * a2 + 4 * g4 + e) * 512 + sl * 64 + 16 * d + i); }
    }
    __syncthreads();
    if (vthr) *(u32x4*)(OB + (size_t)(grow0 + (tid >> 3)) * 4096 + h * 512 + 7 * 64 + (tid & 7) * 8) = *(const LAS u32x4*)((LAS bf16*)(lds + S_OS + 4608) + (tid >> 3) * 72 + (tid & 7) * 8);
    __syncthreads();
#undef SMP_PREFETCH
}
__device__ __forceinline__ void ret_phase(const Args& a, LAS unsigned char* lds, int wave, int lane) {
    const bf16* QH = (const bf16*)(a.ws + WS_R1); const bf16* KH = QH + (size_t)MT * DM; const bf16* VB = (const bf16*)(a.ws + WS_R1 + 72 * MiB); bf16* OB = (bf16*)(a.ws + WS_YP);
    float* sp = a.out + (size_t)MT * DM; float* ss = sp + (size_t)4 * 8 * 256 * 512;
    for (int item = blockIdx.x; item < 256; item += gridDim.x) {
        const int x = item & 7, j = item >> 3, bh = x * 4 + (j >> 3), slice = j & 7, b = bh >> 3, h = bh & 7;
        ret_run<64>(lds, QH, KH, VB, OB, b * 2048, 32, h, slice, nullptr, sp + (size_t)bh * 256 * 512, wave, lane);
    }
    for (int pair = blockIdx.x; pair < 256; pair += gridDim.x) {
        const int b = pair >> 3, h = pair & 7;
        ret_sample(lds, QH, KH, VB, OB, MP + b * 32, h, a.in[2] + (size_t)pair * 256 * 512, ss + (size_t)pair * 256 * 512, wave, lane);
    }
}
__device__ __forceinline__ void gn_gate(const Args& a, int gw, int NGW, int lane) {
    const bf16* O = (const bf16*)(a.ws + WS_YP); bf16* GS = (bf16*)(a.ws + WS_R1 + 144 * MiB);
    for (int row = gw; row < MT; row += NGW) {
        const size_t off = (size_t)row * 4096 + 8 * lane;
        u32x4 ow[8], gv[8];
#pragma unroll
        for (int h = 0; h < 8; ++h) { ow[h] = *(const u32x4*)(O + off + h * 512); gv[h] = *(const u32x4*)(GS + off + h * 512); }
#pragma unroll
        for (int h = 0; h < 8; ++h) {
            float o[8] = {bf_lo(ow[h].x), bf_hi(ow[h].x), bf_lo(ow[h].y), bf_hi(ow[h].y), bf_lo(ow[h].z), bf_hi(ow[h].z), bf_lo(ow[h].w), bf_hi(ow[h].w)};
            const float g[8] = {bf_lo(gv[h].x), bf_hi(gv[h].x), bf_lo(gv[h].y), bf_hi(gv[h].y), bf_lo(gv[h].z), bf_hi(gv[h].z), bf_lo(gv[h].w), bf_hi(gv[h].w)};
            float s = 0.f;
#pragma unroll
            for (int e = 0; e < 8; ++e) s += o[e];
            const float mean = wave_sum(s) * (1.f / 512.f); float q = 0.f;
#pragma unroll
            for (int e = 0; e < 8; ++e) { o[e] -= mean; q += o[e] * o[e]; }
            const float rstd = 1.0f / sqrtf(wave_sum(q) * (1.f / 512.f) + GN_EPS);
            u32x4 w; w.x = pk2(g[0] * o[0] * rstd, g[1] * o[1] * rstd); w.y = pk2(g[2] * o[2] * rstd, g[3] * o[3] * rstd); w.z = pk2(g[4] * o[4] * rstd, g[5] * o[5] * rstd); w.w = pk2(g[6] * o[6] * rstd, g[7] * o[7] * rstd);
            *(u32x4*)(GS + off + h * 512) = w;
        }
    }
}

#ifndef DBG_STOP
#define DBG_STOP 0
#endif
__device__ __forceinline__ void dbg_dump(const Args& a, const bf16* src, size_t n_el) {
    const size_t T = (size_t)gridDim.x * 512, t = (size_t)blockIdx.x * 512 + threadIdx.x, total = 58720256;
    for (size_t i = t; i < total; i += T) { float v = 0.f; if (i < n_el / 2) { const unsigned w = ((const unsigned*)src)[i]; v = bf_lo(w) + bf_hi(w); } a.out[i] = v; }
}
__device__ __forceinline__ void dbg_dump_f32(const Args& a, const float* src, size_t n_el) {
    const size_t T = (size_t)gridDim.x * 512, t = (size_t)blockIdx.x * 512 + threadIdx.x, total = 58720256;
    for (size_t i = t; i < total; i += T) a.out[i] = i < n_el ? src[i] : 0.f;
}
#define XB_TMO      128
#define XB_XCNT(j)  (256  + 64 * (j))
#define XB_XSUB(j)  (1280 + 64 * (j))
#define XB_XGEN(j)  (2304 + 64 * (j))
#define XB_TOP      3328
#define XB_TOPGEN   3392
#define XCD_BAR_WORDS 3456
#define XB_SPIN_CAP (1u << 18)

__device__ __forceinline__ unsigned xb_ld(unsigned* p)              { return __hip_atomic_load(p, __ATOMIC_RELAXED, __HIP_MEMORY_SCOPE_AGENT); }
__device__ __forceinline__ unsigned xb_add(unsigned* p, unsigned v) { return __hip_atomic_fetch_add(p, v, __ATOMIC_RELAXED, __HIP_MEMORY_SCOPE_AGENT); }
__device__ __forceinline__ unsigned xb_xcc_id() { return (unsigned)__builtin_amdgcn_s_getreg((3 << 11) | 20) & 0xFu; }
#define XB_SPIN(cond, bar) do { unsigned _sp = 0; while (cond) { __builtin_amdgcn_s_sleep(1); \
    if ((++_sp & 255u) == 0u) { if (xb_ld(&(bar)[XB_TMO])) break; if (_sp > XB_SPIN_CAP) { atomicAdd(&(bar)[XB_TMO], 1u); break; } } } } while (0)

struct XcdBarrier {
    unsigned* bar; unsigned x;
    volatile LAS unsigned* st;
};

__device__ __forceinline__ XcdBarrier xcd_barrier_post(unsigned* bar, volatile LAS unsigned* st) {
    XcdBarrier b; b.bar = bar; b.x = xb_xcc_id(); b.st = st;
    if (threadIdx.x == 0) (void)xb_add(&bar[XB_XCNT(b.x)], 1u);
    return b;
}
__device__ __forceinline__ void xcd_barrier_complete(unsigned* bar, unsigned x, unsigned& nloc, unsigned& nx) {
    const unsigned G = gridDim.x * gridDim.y * gridDim.z;
    unsigned sum, cnt, mine, sp = 0u;
    for (;;) {
        sum = 0u; cnt = 0u; mine = 0u;
#pragma unroll
        for (unsigned j = 0; j < 16; ++j) { const unsigned c = xb_ld(&bar[XB_XCNT(j)]); sum += c; cnt += (c > 0u) ? 1u : 0u; mine = (j == x) ? c : mine; }
        if (sum == G) break;
        __builtin_amdgcn_s_sleep(1);
        if ((++sp & 255u) == 0u) { if (xb_ld(&bar[XB_TMO])) break; if (sp > XB_SPIN_CAP) { atomicAdd(&bar[XB_TMO], 1u); break; } }
    }
    nloc = mine > 0u ? mine : 1u; nx = cnt > 0u ? cnt : 1u;
}

__device__ __forceinline__ void xcd_barrier(const XcdBarrier& b) {
    asm volatile("s_waitcnt vmcnt(0)" ::: "memory");
    __syncthreads();
    if (threadIdx.x == 0) {
        unsigned* bar = b.bar;
        __builtin_amdgcn_s_waitcnt(0);
        unsigned nloc = b.st[0], nx = b.st[1];
        if (nloc == 0u) { xcd_barrier_complete(bar, b.x, nloc, nx); b.st[0] = nloc; b.st[1] = nx; }
        const unsigned old = xb_add(&bar[XB_XSUB(b.x)], 1u);
        const unsigned gen = old / nloc;
        if (old + 1u == (gen + 1u) * nloc) {
            __builtin_amdgcn_fence(__ATOMIC_RELEASE, "agent");
            asm volatile("s_waitcnt vmcnt(0)" ::: "memory");
            const unsigned og = xb_add(&bar[XB_TOP], 1u);
            const unsigned tg = og / nx;
            if (og + 1u == (tg + 1u) * nx) xb_add(&bar[XB_TOPGEN], 1u);
            else XB_SPIN(xb_ld(&bar[XB_TOPGEN]) == tg, bar);
            __builtin_amdgcn_fence(__ATOMIC_ACQUIRE, "agent");
            xb_add(&bar[XB_XGEN(b.x)], 1u);
            asm volatile("s_waitcnt vmcnt(0)" ::: "memory");
        } else {
            XB_SPIN(xb_ld(&bar[XB_XGEN(b.x)]) == gen, bar);
            __builtin_amdgcn_fence(__ATOMIC_ACQUIRE, "agent");
            asm volatile("s_waitcnt vmcnt(0)" ::: "memory");
        }
    }
    __syncthreads();
}

__global__ void __launch_bounds__(512, 2) fwd(Args a) {
    extern __shared__ __attribute__((aligned(16))) unsigned char lds_raw[];
    cg::grid_group grid = cg::this_grid();
    LAS unsigned char* lds = (LAS unsigned char*)lds_raw;
    const int tid = threadIdx.x, lane = tid & 63, wave = __builtin_amdgcn_readfirstlane(tid >> 6);
    const int G = gridDim.x, c = blockIdx.x, vcu = (G % 8 == 0) ? (c % 8) * (G / 8) + c / 8 : c, gw = vcu * NW + wave, NGW = G * NW;
    unsigned char* ws = a.ws;
    { volatile LAS unsigned* misc = (volatile LAS unsigned*)(lds + MISC_OFF); if (tid < 32) misc[tid] = 0u; }
    __syncthreads();
    XcdBarrier bar = xcd_barrier_post((unsigned*)(ws + WS_CTL), (volatile LAS unsigned*)(lds + MISC_OFF) + 8);
    bf16* XB = (bf16*)(ws + WS_XB); float* YP = (float*)(ws + WS_YP);
    bf16* R1 = (bf16*)(ws + WS_R1);
#define GEMM(EPI, E, Ap, Bp, LD, M1, N, K, SPLIT, CLIST) do { pg8::Gemm g_{(const pg8::bf16_t*)(Ap), (const pg8::bf16_t*)(Bp), (LD)}; pg8::Order S_; S_.init((M1), (N), (K), (SPLIT), G, c); \
        pg8::gemm_phase<EPI, pg8::Order, true, true>(lds, g_, S_, E); if (DBL_GEMM) pg8::gemm_phase<EPI, pg8::Order, true, true>(lds, g_, S_, E); \
        if ((CLIST) > 0) { const int nbusy_ = S_.so.nwg % G;   \
            if (nbusy_ == 0) convert_list(a, lds, (CLIST), gw, NGW, wave, lane); else if (c >= nbusy_) convert_list(a, lds, (CLIST), (c - nbusy_) * NW + wave, (G - nbusy_) * NW, wave, lane); } } while (0)

#define GRID_SYNC() do { asm volatile("s_waitcnt vmcnt(0) lgkmcnt(0)" ::: "memory"); grid.sync(); } while (0)
#define XCD_SYNC() xcd_barrier(bar)

#define DBG_DUMP_1 dbg_dump(a, XB, (size_t)MT * DM)
#define DBG_DUMP_2 dbg_dump(a, R1, (size_t)2 * MT * DM)
#define DBG_DUMP_3 dbg_dump(a, R1 + (size_t)2 * MT * DM, (size_t)MT * DM)
#define DBG_DUMP_4 dbg_dump(a, (const bf16*)YP, (size_t)MP * DM)
#define DBG_DUMP_5 dbg_dump(a, XB, (size_t)MT * DM)
#define DBG_DUMP_6 dbg_dump(a, R1, (size_t)MT * FF)
#define DBG_DUMP_7 dbg_dump(a, (const bf16*)YP, (size_t)MP * DM)
#define DBG_DUMP_8 dbg_dump(a, XB, (size_t)MT * DM)
#define DBG_DUMP_9 dbg_dump(a, R1, (size_t)6 * MT * DM)
#define DBG_DUMP_10 dbg_dump(a, (const bf16*)YP, (size_t)2 * MT * DM)
#define DBG_DUMP_11 dbg_dump(a, R1 + (size_t)4 * MT * DM, (size_t)2 * MT * DM)
#define DBG_DUMP_12 dbg_dump(a, (const bf16*)YP, (size_t)MP * DM)
#define DBG_DUMP_13 dbg_dump(a, XB, (size_t)MT * DM)
#define DBG_DUMP_14 dbg_dump(a, R1, (size_t)MT * FF)
#define DBG_DUMP_15 dbg_dump(a, (const bf16*)YP, (size_t)MP * DM)
    p0_prologue(a, lds, gw, NGW, wave, lane);
    if (a.out == nullptr) GRID_SYNC();
    XCD_SYNC();
    if (DBG_STOP == 1) { DBG_DUMP_1; return; }
    { pg8::EpiGeluUV E{R1, R1 + (size_t)MT * DM, (pg8::f32x2*)(ws + WS_STAT)}; GEMM(pg8::EpiGeluUV, E, XB, ws + WS_WAIN, 2048, MT, 4096, 2048, 0, 1); }
    XCD_SYNC();
    if (DBG_STOP == 2) { DBG_DUMP_2; return; }
    mix_phase(a, lds, wave, lane);
    XCD_SYNC();
    if (DBG_STOP == 3) { DBG_DUMP_3; return; }
    { pg8::EpiPart E{(pg8::bf16_t*)YP, YP + (size_t)MP * DM}; GEMM(pg8::EpiPart, E, ws + WS_R1 + 72 * MiB, ws + WS_WAOUT, 2048, MP, 2048, 2048, 1, 0); }
    XCD_SYNC();
    if (DBG_STOP == 4) { DBG_DUMP_4; return; }
    ln_pass(a.in[0], a.in[1], nullptr, YP, a.in[13], a.in[14], nullptr, XB, gw, NGW, lane);
    XCD_SYNC();
    if (DBG_STOP == 5) { DBG_DUMP_5; return; }
    { pg8::EpiSwiglu E{R1}; GEMM(pg8::EpiSwiglu, E, XB, ws + WS_WFIN, 2048, MT, 11264, 2048, 0, 2); }
    XCD_SYNC();
    if (DBG_STOP == 6) { DBG_DUMP_6; return; }
    { pg8::EpiPart E{(pg8::bf16_t*)YP, YP + (size_t)MP * DM}; GEMM(pg8::EpiPart, E, R1, ws + WS_WFOUT, 5632, MP, 2048, 5632, 1, 0); }
    XCD_SYNC();
    if (DBG_STOP == 7) { DBG_DUMP_7; return; }
    ln_pass(nullptr, nullptr, XB, YP, a.in[15], a.in[16], nullptr, XB, gw, NGW, lane);
    XCD_SYNC();
    if (DBG_STOP == 8) { DBG_DUMP_8; return; }
    { pg8::EpiQKVG E{R1, R1 + (size_t)MT * DM, (pg8::bf16_t*)(ws + WS_R1 + 72 * MiB), (pg8::bf16_t*)(ws + WS_R1 + 144 * MiB), (const float*)(ws + WS_ROPE), (const float*)(ws + WS_ROPE) + 2080 * 128};
      GEMM(pg8::EpiQKVG, E, XB, ws + WS_WBIN, 2048, MT, 12288, 2048, 0, 3); }
    XCD_SYNC();
    if (DBG_STOP == 9) { DBG_DUMP_9; return; }
    ret_phase(a, lds, wave, lane);
    XCD_SYNC();
    if (DBG_STOP == 10) { DBG_DUMP_10; return; }
    gn_gate(a, gw, NGW, lane);
    XCD_SYNC();
    if (DBG_STOP == 11) { DBG_DUMP_11; return; }
    { pg8::EpiPart E{(pg8::bf16_t*)YP, YP + (size_t)MP * DM}; GEMM(pg8::EpiPart, E, ws + WS_R1 + 144 * MiB, ws + WS_WBOUT, 4096, MP, 2048, 4096, 1, 0); }
    XCD_SYNC();
    if (DBG_STOP == 12) { DBG_DUMP_12; return; }
    ln_pass(nullptr, nullptr, XB, YP, a.in[13] + DM, a.in[14] + DM, nullptr, XB, gw, NGW, lane);
    XCD_SYNC();
    if (DBG_STOP == 13) { DBG_DUMP_13; return; }
    { pg8::EpiSwiglu E{R1}; GEMM(pg8::EpiSwiglu, E, XB, ws + WS_WFIN + 44 * MiB, 2048, MT, 11264, 2048, 0, 4); }
    XCD_SYNC();
    if (DBG_STOP == 14) { DBG_DUMP_14; return; }
    { pg8::EpiPart E{(pg8::bf16_t*)YP, YP + (size_t)MP * DM}; GEMM(pg8::EpiPart, E, R1, ws + WS_WFOUT + 22 * MiB, 5632, MP, 2048, 5632, 1, 0); }
    XCD_SYNC();
    if (DBG_STOP == 15) { DBG_DUMP_15; return; }
    ln_pass(nullptr, nullptr, XB, YP, a.in[15] + DM, a.in[16] + DM, a.out, nullptr, gw, NGW, lane);
#undef GEMM
}

extern "C" void kernel_launch(void* const* d_in, const int* in_sizes, int n_in, void* d_out, int out_size, void* d_ws, size_t ws_size, hipStream_t stream) {
    static int grid = 0;
    if (grid == 0) {
        if (n_in != 17 || ws_size < WS_END) { fprintf(stderr, "kernel_launch: needs 17 inputs and >= %zu bytes of workspace (got %d, %zu)\n", (size_t)WS_END, n_in, ws_size); grid = -1; return; }
        int dev = 0, cus = 0, per_cu = 0;
        if (hipGetDevice(&dev) != hipSuccess || hipDeviceGetAttribute(&cus, hipDeviceAttributeMultiprocessorCount, dev) != hipSuccess) { grid = -1; return; }
        if (hipFuncSetAttribute((const void*)fwd, hipFuncAttributeMaxDynamicSharedMemorySize, LDS_BYTES) != hipSuccess) { fprintf(stderr, "kernel_launch: hipFuncSetAttribute failed\n"); grid = -1; return; }
        if (hipOccupancyMaxActiveBlocksPerMultiprocessor(&per_cu, (const void*)fwd, NW * 64, LDS_BYTES) != hipSuccess || per_cu < 1) { fprintf(stderr, "kernel_launch: occupancy query reports %d workgroups per CU\n", per_cu); grid = -1; return; }
        grid = cus;
    }
    if (grid < 0) return;
    if (hipMemsetAsync((char*)d_ws + WS_CTL, 0, CTL_BYTES, stream) != hipSuccess) { fprintf(stderr, "kernel_launch: hipMemsetAsync failed\n"); return; }
    Args a{};
    for (int i = 0; i < 17; ++i) a.in[i] = (const float*)d_in[i];
    a.out = (float*)d_out; a.ws = (unsigned char*)d_ws;
    void* args[] = {&a};
    const hipError_t e = hipLaunchCooperativeKernel((const void*)fwd, dim3(grid), dim3(NW * 64), args, LDS_BYTES, stream);
    if (e != hipSuccess) fprintf(stderr, "kernel_launch: cooperative launch failed: %s (grid %d)\n", hipGetErrorString(e), grid);
}
```

```cpp
#ifndef DBL_GEMM
#define DBL_GEMM 0
#endif
#include <hip/hip_runtime.h>
#include <hip/hip_cooperative_groups.h>
#include <cstdio>
#include <cstdint>
namespace cg = cooperative_groups;

constexpr int DM = 2048, MP = 8192, MS = 1024, MT = MP + MS, FF = 5632, NQKVG = 12288, RV = 4096;
constexpr float ALPHA = 1.41421356237309515f;
constexpr float LN_EPS = 1e-5f, GN_EPS = 1e-6f;

namespace pg8 {
#define PG8_LAS __attribute__((address_space(3)))
typedef unsigned short bf16_t;
typedef short bf16x8 __attribute__((ext_vector_type(8)));
typedef float f32x4 __attribute__((ext_vector_type(4)));
typedef unsigned u32x4 __attribute__((ext_vector_type(4)));
constexpr int BM = 256, BK = 64, HALF = 128, HTB = HALF * BK * 2  , STAGE_BYTES = 8 * HTB, NXCD = 8, WGM = 4;

__host__ __device__ __forceinline__ int lds_byte(int r, int c) { const int st = (r >> 4) * 2 + (c >> 5), rr = r & 15, cc = c & 31, ob = rr * 64 + cc * 2; return st * 1024 + (ob ^ (((ob >> 9) & 1) << 5)); }
__host__ __device__ __forceinline__ void stage_rc(int b, int& R, int& C) { const int st = b / 1024, sb = b % 1024, swz = sb ^ (((sb >> 9) & 1) << 5); R = (st >> 1) * 16 + swz / 64; C = (st & 1) * 32 + (swz % 64) / 2; }
__host__ __device__ __forceinline__ int perm32(int rho) { const int n = rho >> 4, i = rho & 15; return 8 * (i >> 2) + 4 * n + (i & 3); }

struct Unit { int pm, pn, k0, nt, ks; };
struct Gemm { const bf16_t* A; const bf16_t* Bt; int ld; };

struct StaticOrder {
    int nM, nN, nwg, G, c;
    __host__ __device__ void init(int M, int N, int G_, int c_) { nM = M / BM; nN = N / BM; nwg = nM * nN; G = G_; c = c_; }
    __host__ __device__ __forceinline__ void tile(int L, int& pm_, int& pn_) const {
        int wgid = L; { const int q = nwg / NXCD, r = nwg % NXCD, xcd = wgid % NXCD, off = wgid / NXCD; wgid = (xcd < r ? xcd * (q + 1) : r * (q + 1) + (xcd - r) * q) + off; }
        const int nig = WGM * nN, gid = wgid / nig, fm = gid * WGM, gsz = (nM - fm) < WGM ? (nM - fm) : WGM;
        pm_ = fm + ((wgid % nig) % gsz); pn_ = (wgid % nig) / gsz;
    }
    __device__ __forceinline__ void a_ready(const Unit&) const {}
    __device__ __forceinline__ void done(const Unit&) const {}
};

typedef float f32x2_cv __attribute__((ext_vector_type(2))); typedef __bf16 bf16x2_cv __attribute__((ext_vector_type(2)));
__device__ __forceinline__ unsigned cvt_pk_bf16(float lo, float hi) { const f32x2_cv v = {lo, hi}; const bf16x2_cv b = __builtin_convertvector(v, bf16x2_cv); return __builtin_bit_cast(unsigned, b); }
typedef float f32x2 __attribute__((ext_vector_type(2)));
__device__ __forceinline__ f32x2 gelu_pk(f32x2 v) {
    const f32x2 av = __builtin_elementwise_abs(v), d = av * 0.2316418882f + 1.0f;
    f32x2 t; t.x = __builtin_amdgcn_rcpf(d.x); t.y = __builtin_amdgcn_rcpf(d.y);
    f32x2 q = t * 0.5307027145f + (-0.7265760135f); q = q * t + 0.7107068705f; q = q * t + (-0.142248368f); q = q * t + 0.127414796f; q = q * t;
    const f32x2 s = (v * v) * (-0.72134752044f);
    f32x2 e; e.x = __builtin_amdgcn_exp2f(s.x); e.y = __builtin_amdgcn_exp2f(s.y);
    const f32x2 m = v * (q * e), r = v - m;
    f32x2 o; o.x = v.x < 0.f ? m.x : r.x; o.y = v.y < 0.f ? m.y : r.y; return o;
}
struct Order {
    StaticOrder so; int G, c, n1c, ntk, split;
    __device__ __forceinline__ void init(int M1, int N, int K, int split_, int G_, int c_) { so.init(M1, N, G_, c_); G = G_; c = c_; ntk = K / BK; split = split_; n1c = (c < so.nwg) ? (so.nwg - c + G - 1) / G : 0; }
    __device__ __forceinline__ bool next(int i, Unit& u) const {
        const bool p1 = i < n1c; int pm1, pn1; so.tile(p1 ? i * G + c : 0, pm1, pn1);
        const int j = (i - n1c) * G + c; const bool p2 = !p1 && split != 0 && j < 256;
        const int ks = j & 7, jj = (j >> 3) & 31, b = (ntk >> 3) & ~1, rem2 = (ntk - 8 * b) >> 1;
        Unit r; r.pm = p1 ? pm1 : so.nM + (jj & 3); r.pn = p1 ? pn1 : (jj >> 2); r.k0 = p1 ? 0 : (ks * b + 2 * (ks < rem2 ? ks : rem2)) * BK; r.nt = p1 ? ntk : b + (ks < rem2 ? 2 : 0); r.ks = p1 ? -1 : ks;
        u = r; return p1 || p2;
    }
    __device__ __forceinline__ void a_ready(const Unit&) const {}
    __device__ __forceinline__ void done(const Unit&) const {}
};

__device__ __forceinline__ float silu_f(float x) { return x * __builtin_amdgcn_rcpf(1.0f + __builtin_amdgcn_exp2f(-1.4426950408889634f * x)); }

struct EpiPart {
    static constexpr bool PERM = true, AFTER_DRAIN = false;
    bf16_t* Yb;
    __device__ __forceinline__ void operator()(const f32x4 (&acc)[2][2][4][2], const Unit& u, int wr, int wc, int fr, int fq) const {
        const int row0 = u.pm * BM + wr * 64 + fr + (u.ks > 0 ? u.ks * 1024 : 0), col0 = u.pn * BM + wc * 32 + 8 * fq;
#pragma unroll
        for (int ai = 0; ai < 2; ++ai)
#pragma unroll
            for (int m = 0; m < 4; ++m) { bf16_t* rowp = Yb + (size_t)(row0 + ai * HALF + m * 16) * 2048 + col0;
#pragma unroll
                for (int bj = 0; bj < 2; ++bj) { const f32x4 v0 = acc[ai][bj][m][0], v1 = acc[ai][bj][m][1];
                    u32x4 w; w.x = cvt_pk_bf16(v0[0], v0[1]); w.y = cvt_pk_bf16(v0[2], v0[3]); w.z = cvt_pk_bf16(v1[0], v1[1]); w.w = cvt_pk_bf16(v1[2], v1[3]);
                    *(u32x4*)(rowp + bj * HALF) = w; } }
    }
};
struct EpiGeluUV {
    static constexpr bool PERM = true, AFTER_DRAIN = false;
    bf16_t* U; bf16_t* V; f32x2* stat;
    __device__ __forceinline__ void operator()(const f32x4 (&acc)[2][2][4][2], const Unit& u, int wr, int wc, int fr, int fq) const {
        const bool isv = u.pn >= 8; bf16_t* O = isv ? V : U;
        const int row0 = u.pm * BM + wr * 64 + fr, col0 = (u.pn & 7) * BM + wc * 32 + 8 * fq;
#pragma unroll
        for (int ai = 0; ai < 2; ++ai)
#pragma unroll
            for (int m = 0; m < 4; ++m) { const int row = row0 + ai * HALF + m * 16; bf16_t* rowp = O + (size_t)row * 2048 + col0; float s = 0.f, q = 0.f;
#pragma unroll
                for (int bj = 0; bj < 2; ++bj) { const f32x4 v0 = acc[ai][bj][m][0], v1 = acc[ai][bj][m][1];
                    const f32x2 a = gelu_pk((f32x2){v0[0], v0[1]}), b = gelu_pk((f32x2){v0[2], v0[3]}), c = gelu_pk((f32x2){v1[0], v1[1]}), d = gelu_pk((f32x2){v1[2], v1[3]});
                    s += ((a.x + a.y) + (b.x + b.y)) + ((c.x + c.y) + (d.x + d.y));
                    q += ((a.x * a.x + a.y * a.y) + (b.x * b.x + b.y * b.y)) + ((c.x * c.x + c.y * c.y) + (d.x * d.x + d.y * d.y));
                    u32x4 w; w.x = cvt_pk_bf16(a.x, a.y); w.y = cvt_pk_bf16(b.x, b.y); w.z = cvt_pk_bf16(c.x, c.y); w.w = cvt_pk_bf16(d.x, d.y);
                    *(u32x4*)(rowp + bj * HALF) = w; }
                if (isv) { s += __shfl_xor(s, 16); s += __shfl_xor(s, 32); q += __shfl_xor(q, 16); q += __shfl_xor(q, 32);
                    if (fq == 0) stat[(size_t)row * 32 + (u.pn - 8) * 4 + wc] = (f32x2){s, q}; } }
    }
};
struct EpiSwiglu {
    static constexpr bool PERM = true, AFTER_DRAIN = false;
    bf16_t* H;
    __device__ __forceinline__ void operator()(const f32x4 (&acc)[2][2][4][2], const Unit& u, int wr, int wc, int fr, int fq) const {
        const int row0 = u.pm * BM + wr * 64 + fr, col0 = u.pn * HALF + wc * 32 + 8 * fq;
#pragma unroll
        for (int ai = 0; ai < 2; ++ai)
#pragma unroll
            for (int m = 0; m < 4; ++m) { bf16_t* rowp = H + (size_t)(row0 + ai * HALF + m * 16) * 5632 + col0;
                const f32x4 g0 = acc[ai][0][m][0], g1 = acc[ai][0][m][1], u0 = acc[ai][1][m][0], u1 = acc[ai][1][m][1];
                u32x4 w; w.x = cvt_pk_bf16(silu_f(g0[0]) * u0[0], silu_f(g0[1]) * u0[1]); w.y = cvt_pk_bf16(silu_f(g0[2]) * u0[2], silu_f(g0[3]) * u0[3]);
                w.z = cvt_pk_bf16(silu_f(g1[0]) * u1[0], silu_f(g1[1]) * u1[1]); w.w = cvt_pk_bf16(silu_f(g1[2]) * u1[2], silu_f(g1[3]) * u1[3]);
                *(u32x4*)rowp = w; }
    }
};
__device__ __forceinline__ float lg2gamma(int h) {
    const double x = 1.0 / (double)(32 << h); double p = x, s = 0.0;
    const double inv[8] = {1.0, 0.5, 1.0 / 3.0, 0.25, 0.2, 1.0 / 6.0, 1.0 / 7.0, 0.125};
#pragma unroll
    for (int k = 0; k < 8; ++k) { s -= p * inv[k]; p *= x; }
    return (float)(s * 1.4426950408889634);
}
struct EpiQKVG {
    static constexpr bool PERM = true, AFTER_DRAIN = false;
    bf16_t *QH, *KH, *VB, *GS; const float* ropec; const float* ropes;
    __device__ __forceinline__ void operator()(const f32x4 (&acc)[2][2][4][2], const Unit& u, int wr, int wc, int fr, int fq) const {
        const int row0 = u.pm * BM + wr * 64 + fr, cw = wc * 32 + 8 * fq;
        if (u.pn < 16) {
            const bool isq = u.pn < 8; const int head = u.pn & 7; bf16_t* O = (isq ? QH : KH) + head * 256 + cw;
            const float lg = lg2gamma(head) * (isq ? 1.f : -1.f), sc0 = isq ? 0.0625f : 1.f;
#pragma unroll
            for (int ai = 0; ai < 2; ++ai)
#pragma unroll
                for (int m = 0; m < 4; ++m) { const int row = row0 + ai * HALF + m * 16;
                    const int pidx = row < MP ? (row & 2047) : 2048 + ((row - MP) & 31), ib = row < MP ? (row & 63) : ((row - MP) & 31);
                    const float sc = sc0 * __builtin_amdgcn_exp2f(lg * (float)ib);
                    const f32x4 c0 = *(const f32x4*)(ropec + pidx * 128 + cw), c1 = *(const f32x4*)(ropec + pidx * 128 + cw + 4);
                    const f32x4 s0 = *(const f32x4*)(ropes + pidx * 128 + cw), s1 = *(const f32x4*)(ropes + pidx * 128 + cw + 4);
                    const f32x4 a0 = acc[ai][0][m][0], a1 = acc[ai][0][m][1], b0 = acc[ai][1][m][0], b1 = acc[ai][1][m][1];
                    const f32x4 o0 = (a0 * c0 - b0 * s0) * sc, o1 = (a1 * c1 - b1 * s1) * sc, p0 = (a0 * s0 + b0 * c0) * sc, p1 = (a1 * s1 + b1 * c1) * sc;
                    u32x4 w; w.x = cvt_pk_bf16(o0[0], o0[1]); w.y = cvt_pk_bf16(o0[2], o0[3]); w.z = cvt_pk_bf16(o1[0], o1[1]); w.w = cvt_pk_bf16(o1[2], o1[3]);
                    *(u32x4*)(O + (size_t)row * 2048) = w;
                    w.x = cvt_pk_bf16(p0[0], p0[1]); w.y = cvt_pk_bf16(p0[2], p0[3]); w.z = cvt_pk_bf16(p1[0], p1[1]); w.w = cvt_pk_bf16(p1[2], p1[3]);
                    *(u32x4*)(O + (size_t)row * 2048 + HALF) = w; }
        } else {
            const bool isg = u.pn >= 32; bf16_t* O = (isg ? GS : VB) + ((u.pn - 16) & 15) * BM + cw;
#pragma unroll
            for (int ai = 0; ai < 2; ++ai)
#pragma unroll
                for (int m = 0; m < 4; ++m) { bf16_t* rowp = O + (size_t)(row0 + ai * HALF + m * 16) * 4096;
#pragma unroll
                    for (int bj = 0; bj < 2; ++bj) { f32x4 v0 = acc[ai][bj][m][0], v1 = acc[ai][bj][m][1];
                        if (isg) { v0 = (f32x4){silu_f(v0[0]), silu_f(v0[1]), silu_f(v0[2]), silu_f(v0[3])}; v1 = (f32x4){silu_f(v1[0]), silu_f(v1[1]), silu_f(v1[2]), silu_f(v1[3])}; }
                        u32x4 w; w.x = cvt_pk_bf16(v0[0], v0[1]); w.y = cvt_pk_bf16(v0[2], v0[3]); w.z = cvt_pk_bf16(v1[0], v1[1]); w.w = cvt_pk_bf16(v1[2], v1[3]);
                        *(u32x4*)(rowp + bj * HALF) = w; } }
        }
    }
};
template <class Epi, class Sched, bool ALIGN_EPI = false, bool SP2 = false>
__device__ __forceinline__ void gemm_phase(PG8_LAS unsigned char* lds, const Gemm g, const Sched& S, const Epi& E) {
    int tid_ = threadIdx.x; asm volatile("" : "+v"(tid_));
    const int tid = tid_, wid = __builtin_amdgcn_readfirstlane(tid >> 6), lane = tid & 63, wr = wid >> 2, wc = wid & 3, fr = lane & 15, fq = lane >> 4;
    const int K = g.ld;
    unsigned voffA[2], voffB[2];
#pragma unroll
    for (int i = 0; i < 2; ++i) { int R, C; stage_rc(tid * 16 + i * 8192, R, C); const int Rb = Epi::PERM ? ((R & ~31) + perm32(R & 31)) : R;
        voffA[i] = (unsigned)(R * K + C) * 2u; voffB[i] = (unsigned)(Rb * K + C) * 2u; }
    const size_t kstep = (size_t)(BK * 2);
    const size_t hstep = (size_t)HALF * K * 2;
    const size_t tstep = 2 * hstep;
    const unsigned ldsw = (unsigned)wid * 1024u;
    const int aoff = lds_byte(wr * 64 + fr, fq * 8), boff = lds_byte(wc * 32 + fr, fq * 8);
#define PG8_SA(b, h) (((b) * 2 + (h)) * HTB)
#define PG8_SB(b, h) ((4 + (b) * 2 + (h)) * HTB)
#define PG8_STAGE(bufoff, gbase, voff) do { _Pragma("unroll") for (int _i = 0; _i < 2; ++_i) \
        __builtin_amdgcn_global_load_lds((const unsigned*)((const char*)(gbase) + (voff)[_i]), (PG8_LAS unsigned*)(lds + (bufoff) + ldsw + _i * 8192), 16, 0, 0); } while (0)
#define PG8_LDA(dst, b, h) do { _Pragma("unroll") for (int m = 0; m < 4; ++m) _Pragma("unroll") for (int k = 0; k < 2; ++k) dst[m][k] = *(const PG8_LAS bf16x8*)(lds + PG8_SA(b, h) + aoff + m * 2048 + k * 1024); } while (0)
#define PG8_LDB(dst, b, h) do { _Pragma("unroll") for (int n = 0; n < 2; ++n) _Pragma("unroll") for (int k = 0; k < 2; ++k) dst[n][k] = *(const PG8_LAS bf16x8*)(lds + PG8_SB(b, h) + boff + n * 2048 + k * 1024); } while (0)
#define PG8_MMA(ai, bj, At, Bt) do { __builtin_amdgcn_s_setprio(1); _Pragma("unroll") for (int m = 0; m < 4; ++m) _Pragma("unroll") for (int n = 0; n < 2; ++n) _Pragma("unroll") for (int k = 0; k < 2; ++k) \
        acc[ai][bj][m][n] = __builtin_amdgcn_mfma_f32_16x16x32_bf16(Bt[n][k], At[m][k], acc[ai][bj][m][n], 0, 0, 0); __builtin_amdgcn_s_setprio(0); } while (0)
#define PG8_WAIT_V(n) asm volatile("s_waitcnt vmcnt(" #n ")" ::: "memory")
#define PG8_WAIT_L(n) asm volatile("s_waitcnt lgkmcnt(" #n ")" ::: "memory")
#define PG8_BAR __builtin_amdgcn_s_barrier()
#define PG8_SCHED __builtin_amdgcn_sched_barrier(0)
    Unit cur, nxt; int ui = 0;
    if (!S.next(0, cur)) return;
    f32x4 acc[2][2][4][2];
#pragma unroll
    for (int a = 0; a < 2; ++a)
#pragma unroll
        for (int b = 0; b < 2; ++b)
#pragma unroll
            for (int m = 0; m < 4; ++m)
#pragma unroll
                for (int n = 0; n < 2; ++n) acc[a][b][m][n] = (f32x4){0.f, 0.f, 0.f, 0.f};
    bf16x8 At[4][2], B0[2][2], B1[2][2];
    const char* cA = (const char*)g.A + (size_t)cur.pm * tstep + (size_t)cur.k0 * 2; const char* cB = (const char*)g.Bt + (size_t)cur.pn * tstep + (size_t)cur.k0 * 2; int nt = cur.nt;
    S.a_ready(cur);
    if constexpr (SP2) {
        PG8_STAGE(PG8_SB(0, 0), cB, voffB); PG8_STAGE(PG8_SB(0, 1), cB + hstep, voffB); PG8_STAGE(PG8_SA(0, 0), cA, voffA); PG8_STAGE(PG8_SA(0, 1), cA + hstep, voffA);
        if (wr == 1) PG8_BAR;
        PG8_WAIT_V(2); PG8_BAR;
        PG8_STAGE(PG8_SB(1, 0), cB + kstep, voffB); PG8_STAGE(PG8_SA(1, 0), cA + kstep, voffA); PG8_STAGE(PG8_SB(1, 1), cB + hstep + kstep, voffB);
        PG8_WAIT_V(6); PG8_BAR;
    } else {
        PG8_STAGE(PG8_SB(0, 0), cB, voffB); PG8_STAGE(PG8_SA(0, 0), cA, voffA); PG8_STAGE(PG8_SB(0, 1), cB + hstep, voffB); PG8_STAGE(PG8_SA(0, 1), cA + hstep, voffA);
        if (wr == 1) PG8_BAR;
        PG8_WAIT_V(4); PG8_BAR;
        PG8_STAGE(PG8_SB(1, 0), cB + kstep, voffB); PG8_STAGE(PG8_SA(1, 0), cA + kstep, voffA); PG8_STAGE(PG8_SB(1, 1), cB + hstep + kstep, voffB);
        PG8_WAIT_V(6); PG8_BAR;
    }
    for (;;) {
        const bool has_next = S.next(ui + 1, nxt);
        const char* nA = has_next ? (const char*)g.A + (size_t)nxt.pm * tstep + (size_t)nxt.k0 * 2 : cA; const char* nB = has_next ? (const char*)g.Bt + (size_t)nxt.pn * tstep + (size_t)nxt.k0 * 2 : cB;
        for (int t = 0; t < nt; t += 2) {
            const bool last = (t == nt - 2);
            const char* a1 = cA + (size_t)(t + 1) * kstep;
            const char* a2 = last ? nA : cA + (size_t)(t + 2) * kstep; const char* b2 = last ? nB : cB + (size_t)(t + 2) * kstep;
            const char* a3 = a2 + kstep; const char* b3 = b2 + kstep;
            if (last && has_next) S.a_ready(nxt);
            if constexpr (SP2) {
            PG8_LDB(B0, 0, 0); PG8_LDB(B1, 0, 1); PG8_SCHED; PG8_LDA(At, 0, 0); PG8_STAGE(PG8_SA(1, 1), a1 + hstep, voffA);
            PG8_WAIT_V(8); PG8_WAIT_L(0); PG8_BAR; PG8_MMA(0, 0, At, B0); PG8_MMA(0, 1, At, B1); PG8_BAR; PG8_SCHED;
            PG8_LDA(At, 0, 1); PG8_STAGE(PG8_SB(0, 0), b2, voffB); PG8_STAGE(PG8_SB(0, 1), b2 + hstep, voffB); PG8_STAGE(PG8_SA(0, 0), a2, voffA);
            PG8_WAIT_V(8); PG8_WAIT_L(0); PG8_BAR; PG8_MMA(1, 0, At, B0); PG8_MMA(1, 1, At, B1); PG8_BAR; PG8_SCHED;
            PG8_LDB(B0, 1, 0); PG8_LDB(B1, 1, 1); PG8_SCHED; PG8_LDA(At, 1, 0); PG8_STAGE(PG8_SA(0, 1), a2 + hstep, voffA);
            PG8_WAIT_V(8); PG8_WAIT_L(0); PG8_BAR; PG8_MMA(0, 0, At, B0); PG8_MMA(0, 1, At, B1); PG8_BAR; PG8_SCHED;
            PG8_LDA(At, 1, 1); PG8_STAGE(PG8_SB(1, 0), b3, voffB); PG8_STAGE(PG8_SB(1, 1), b3 + hstep, voffB); PG8_STAGE(PG8_SA(1, 0), a3, voffA);
            PG8_WAIT_V(8); PG8_WAIT_L(0); PG8_BAR; PG8_MMA(1, 0, At, B0); PG8_MMA(1, 1, At, B1); PG8_BAR; PG8_SCHED;
            } else {
            PG8_LDB(B0, 0, 0); PG8_SCHED; PG8_LDA(At, 0, 0); PG8_STAGE(PG8_SA(1, 1), a1 + hstep, voffA);
            PG8_WAIT_L(8); PG8_BAR; PG8_WAIT_L(0); PG8_MMA(0, 0, At, B0); PG8_BAR; PG8_SCHED;
            PG8_LDB(B1, 0, 1); PG8_STAGE(PG8_SB(0, 0), b2, voffB);
            PG8_BAR; PG8_WAIT_L(0); PG8_MMA(0, 1, At, B1); PG8_BAR;
            PG8_LDA(At, 0, 1); PG8_STAGE(PG8_SA(0, 0), a2, voffA);
            PG8_BAR; PG8_WAIT_L(0); PG8_MMA(1, 0, At, B0); PG8_BAR; PG8_SCHED;
            PG8_STAGE(PG8_SB(0, 1), b2 + hstep, voffB);
            PG8_WAIT_V(6); PG8_BAR; PG8_MMA(1, 1, At, B1); PG8_BAR;
            PG8_LDB(B0, 1, 0); PG8_SCHED; PG8_LDA(At, 1, 0); PG8_STAGE(PG8_SA(0, 1), a2 + hstep, voffA);
            PG8_WAIT_L(8); PG8_BAR; PG8_WAIT_L(0); PG8_MMA(0, 0, At, B0); PG8_BAR; PG8_SCHED;
            PG8_LDB(B1, 1, 1); PG8_STAGE(PG8_SB(1, 0), b3, voffB);
            PG8_BAR; PG8_WAIT_L(0); PG8_MMA(0, 1, At, B1); PG8_BAR;
            PG8_LDA(At, 1, 1); PG8_STAGE(PG8_SA(1, 0), a3, voffA);
            PG8_BAR; PG8_WAIT_L(0); PG8_MMA(1, 0, At, B0); PG8_BAR; PG8_SCHED;
            PG8_STAGE(PG8_SB(1, 1), b3 + hstep, voffB);
            PG8_WAIT_V(6); PG8_BAR; PG8_MMA(1, 1, At, B1); PG8_BAR;
            }
        }
        if constexpr (ALIGN_EPI) { if (wr == 0) PG8_BAR; }
        if constexpr (!Epi::AFTER_DRAIN) { E(acc, cur, wr, wc, fr, fq); S.done(cur); }
        if (!has_next) break;
#pragma unroll
        for (int a = 0; a < 2; ++a)
#pragma unroll
            for (int b = 0; b < 2; ++b)
#pragma unroll
                for (int m = 0; m < 4; ++m)
#pragma unroll
                    for (int n = 0; n < 2; ++n) acc[a][b][m][n] = (f32x4){0.f, 0.f, 0.f, 0.f};
        cur = nxt; cA = nA; cB = nB; nt = cur.nt; ++ui;
        if constexpr (ALIGN_EPI) { if (wr == 1) PG8_BAR; }
    }
    PG8_WAIT_V(0);
    if constexpr (!ALIGN_EPI) { if (wr == 0) PG8_BAR; }
    PG8_BAR;
    if constexpr (Epi::AFTER_DRAIN) { E.fused(acc, cur, wr, wc, fr, fq, lds, wid, lane); S.done(cur); }
#undef PG8_SA
#undef PG8_SB
#undef PG8_STAGE
#undef PG8_LDA
#undef PG8_LDB
#undef PG8_MMA
#undef PG8_WAIT_V
#undef PG8_WAIT_L
#undef PG8_BAR
#undef PG8_SCHED
}
}
constexpr size_t MiB = 1u << 20;
constexpr size_t WS_WAIN = 0, WS_WAOUT = 16 * MiB, WS_WBIN = 24 * MiB, WS_WBOUT = 72 * MiB, WS_WFIN = 88 * MiB, WS_WFOUT = 176 * MiB;
constexpr size_t WS_XB = 220 * MiB;
constexpr size_t WS_STAT = 256 * MiB;
constexpr size_t WS_ROPE = 259 * MiB;
constexpr size_t WS_YP = 262 * MiB;
constexpr size_t WS_XF = 390 * MiB;
constexpr size_t WS_R1 = 462 * MiB;
constexpr size_t WS_CTL = 678 * MiB, CTL_BYTES = 16384;
constexpr size_t WS_END = 679 * MiB;
constexpr int MISC_OFF = 131072 + 320;
constexpr int LDS_BYTES = 147456;
constexpr int NW = 8;

#define LAS __attribute__((address_space(3)))
typedef unsigned short bf16;
typedef unsigned u32x4 __attribute__((ext_vector_type(4)));
typedef unsigned u32x2 __attribute__((ext_vector_type(2)));
typedef float f32x4 __attribute__((ext_vector_type(4)));
typedef float f32x2 __attribute__((ext_vector_type(2)));
typedef short bf16x8 __attribute__((ext_vector_type(8)));
typedef short s16x4 __attribute__((ext_vector_type(4)));
#define LDS_WAIT() asm volatile("s_waitcnt lgkmcnt(0)" ::: "memory")
__device__ __forceinline__ unsigned pk2(float lo, float hi) { return pg8::cvt_pk_bf16(lo, hi); }
__device__ __forceinline__ float bf_lo(unsigned w) { return __uint_as_float(w << 16); }
__device__ __forceinline__ float bf_hi(unsigned w) { return __uint_as_float(w & 0xffff0000u); }
__device__ __forceinline__ float wave_sum(float v) {
#pragma unroll
    for (int o = 1; o < 64; o <<= 1) v += __shfl_xor(v, o);
    return v;
}

struct Args { const float* in[17]; float* out; unsigned char* ws; };

template <int MAPMODE>
__device__ __forceinline__ void p0_transpose_item(const float* W, int K, int N, bf16* WT, LAS float* scr, int item, int lane) {
    const int nblk = N / 32, kb = item / nblk, nb = item % nblk, k0 = 64 * kb, n0 = 32 * nb;
#pragma unroll 8
    for (int i = 0; i < 32; ++i) { const int kk = 2 * i + (lane >> 5); scr[kk * 33 + (lane & 31)] = __builtin_nontemporal_load(W + (size_t)(k0 + kk) * N + n0 + (lane & 31)); }
    LDS_WAIT(); asm volatile("" ::: "memory");
    int r0 = n0;
    if (MAPMODE == 1) { const int up = n0 >= FF ? 1 : 0, c = n0 - up * FF; r0 = 256 * (c >> 7) + (c & 127) + 128 * up; }
    const int c8 = lane & 7;
#pragma unroll
    for (int j = 0; j < 4; ++j) { const int n = (lane >> 3) + 8 * j; const LAS float* s = scr + (8 * c8) * 33 + n;
        u32x4 o; o.x = pk2(s[0 * 33], s[1 * 33]); o.y = pk2(s[2 * 33], s[3 * 33]); o.z = pk2(s[4 * 33], s[5 * 33]); o.w = pk2(s[6 * 33], s[7 * 33]);
        *(u32x4*)(WT + (size_t)(r0 + n) * K + k0 + 8 * c8) = o; }
    LDS_WAIT(); asm volatile("" ::: "memory");
}
__device__ __forceinline__ void convert_list(const Args& a, LAS unsigned char* lds, int list, int w, int nw, int wave, int lane) {
    LAS float* scr = (LAS float*)(lds + wave * 16384);
    unsigned char* ws = a.ws;
    constexpr int I0 = 32 * 128, I1 = 32 * 64, I2 = 32 * 384, I3 = 64 * 64, I4 = 32 * 352, I5 = 88 * 64;
    if (list == 0) {
        for (int r = w; r < I0; r += nw) p0_transpose_item<0>(a.in[3], 2048, 4096, (bf16*)(ws + WS_WAIN), scr, r, lane);
    } else if (list == 1) {
        for (int it = w; it < I1 + I4 + I5; it += nw) { int r = it;
            if (r < I1) { p0_transpose_item<0>(a.in[8], 2048, 2048, (bf16*)(ws + WS_WAOUT), scr, r, lane); continue; } r -= I1;
            if (r < I4) { p0_transpose_item<1>(a.in[11], 2048, 11264, (bf16*)(ws + WS_WFIN), scr, r, lane); continue; } r -= I4;
            p0_transpose_item<0>(a.in[12], 5632, 2048, (bf16*)(ws + WS_WFOUT), scr, r, lane); }
    } else if (list == 2) {
        for (int it = w; it < I2 + I4; it += nw) { int r = it;
            if (r < I2) { p0_transpose_item<0>(a.in[9], 2048, 12288, (bf16*)(ws + WS_WBIN), scr, r, lane); continue; } r -= I2;
            p0_transpose_item<1>(a.in[11] + (size_t)2048 * 11264, 2048, 11264, (bf16*)(ws + WS_WFIN + 44 * MiB), scr, r, lane); }
    } else if (list == 3) {
        for (int r = w; r < I3; r += nw) p0_transpose_item<0>(a.in[10], 4096, 2048, (bf16*)(ws + WS_WBOUT), scr, r, lane);
    } else {
        for (int r = w; r < I5; r += nw) p0_transpose_item<0>(a.in[12] + (size_t)5632 * 2048, 5632, 2048, (bf16*)(ws + WS_WFOUT + 22 * MiB), scr, r, lane);
    }
}
__device__ __forceinline__ void p0_prologue(const Args& a, LAS unsigned char* lds, int gw, int NGW, int wave, int lane) {
    unsigned char* ws = a.ws;
    convert_list(a, lds, 0, gw, NGW, wave, lane);
    bf16* XB = (bf16*)(ws + WS_XB);
    for (int m = gw; m < MT; m += NGW) {
        const f32x4* xr = (const f32x4*)(m < MP ? a.in[0] + (size_t)m * DM : a.in[1] + (size_t)(m - MP) * DM) + lane;
        u32x2* o = (u32x2*)(XB + (size_t)m * DM) + lane;
#pragma unroll
        for (int j = 0; j < 8; ++j) { const f32x4 v = xr[64 * j]; u32x2 w; w.x = pk2(v[0], v[1]); w.y = pk2(v[2], v[3]); o[64 * j] = w; }
    }
    float* rc = (float*)(ws + WS_ROPE); float* rs = rc + 2080 * 128;
    for (int e = gw * 64 + lane; e < 2080 * 128; e += NGW * 64) {
        const int p = e >> 7, d = e & 127; const float pos = (float)(p < 2048 ? p : 4096 + (p - 2048));
        const float inv = __builtin_amdgcn_exp2f(-(float)d * (13.287712379549449f / 128.0f));
        const double rev = (double)(pos * inv) * 0.15915494309189535; const float fr = (float)(rev - __builtin_floor(rev));
        rc[e] = __builtin_amdgcn_cosf(fr); rs[e] = __builtin_amdgcn_sinf(fr);
    }
}

struct LnIO { const float* xres_p; const float* xres_s; const bf16* xb; const float* YP; const float* g; const float* b; float* outf; bf16* outb; };
__device__ __forceinline__ void ln_load(const LnIO& io, f32x4 (&v)[8], int row, int lane) {
    if (io.xres_p) { const f32x4* xr = (const f32x4*)(row < MP ? io.xres_p + (size_t)row * DM : io.xres_s + (size_t)(row - MP) * DM) + lane;
#pragma unroll
        for (int j = 0; j < 8; ++j) v[j] = xr[64 * j] * ALPHA;
    } else { const u32x2* xr = (const u32x2*)(io.xb + (size_t)row * DM) + lane;
#pragma unroll
        for (int j = 0; j < 8; ++j) { const u32x2 w = xr[64 * j]; v[j] = (f32x4){bf_lo(w.x), bf_hi(w.x), bf_lo(w.y), bf_hi(w.y)} * ALPHA; } }
    if (row < MP) { const u32x2* y = (const u32x2*)((const bf16*)io.YP + (size_t)row * DM) + lane;
#pragma unroll
        for (int j = 0; j < 8; ++j) { const u32x2 w = y[64 * j]; v[j] += (f32x4){bf_lo(w.x), bf_hi(w.x), bf_lo(w.y), bf_hi(w.y)}; }
    } else {
#pragma unroll 2
        for (int ks = 0; ks < 8; ++ks) { const u32x2* y = (const u32x2*)((const bf16*)io.YP + (size_t)(MP + ks * MS + (row - MP)) * DM) + lane;
#pragma unroll
            for (int j = 0; j < 8; ++j) { const u32x2 w = y[64 * j]; v[j] += (f32x4){bf_lo(w.x), bf_hi(w.x), bf_lo(w.y), bf_hi(w.y)}; } }
    }
}
__device__ __forceinline__ void ln_finish(const LnIO& io, f32x4 (&v)[8], int row, int lane) {
    float s = 0.f;
#pragma unroll
    for (int j = 0; j < 8; ++j) s += (v[j][0] + v[j][1]) + (v[j][2] + v[j][3]);
    const float mean = wave_sum(s) * (1.f / DM); float q = 0.f;
#pragma unroll
    for (int j = 0; j < 8; ++j) { v[j] = v[j] - mean; q += (v[j][0] * v[j][0] + v[j][1] * v[j][1]) + (v[j][2] * v[j][2] + v[j][3] * v[j][3]); }
    const float rstd = 1.0f / sqrtf(wave_sum(q) * (1.f / DM) + LN_EPS);
#pragma unroll
    for (int j = 0; j < 8; ++j) { const f32x4 gg = ((const f32x4*)io.g)[lane + 64 * j], bb = ((const f32x4*)io.b)[lane + 64 * j]; const f32x4 o = v[j] * rstd * gg + bb;
        if (io.outf) __builtin_nontemporal_store(o, (f32x4*)(io.outf + (size_t)row * DM) + lane + 64 * j);
        if (io.outb) { u32x2 w; w.x = pk2(o[0], o[1]); w.y = pk2(o[2], o[3]); ((u32x2*)(io.outb + (size_t)row * DM) + lane)[64 * j] = w; } }
}
__device__ __forceinline__ void ln_pair(const LnIO& io, int r0, int r1, int lane) { f32x4 va[8], vb[8]; ln_load(io, va, r0, lane); ln_load(io, vb, r1, lane); ln_finish(io, va, r0, lane); ln_finish(io, vb, r1, lane); }
__device__ __forceinline__ void ln_one(const LnIO& io, int r0, int lane) { f32x4 va[8]; ln_load(io, va, r0, lane); ln_finish(io, va, r0, lane); }
__device__ __forceinline__ void ln_pass(const float* xres_p, const float* xres_s, const bf16* xb, const float* YP, const float* g, const float* b, float* outf, bf16* outb, int gw, int NGW, int lane) {
    const LnIO io{xres_p, xres_s, xb, YP, g, b, outf, outb};
    if (NGW == 2048) {
        if (gw < 1024) { ln_one(io, MP + gw, lane); ln_pair(io, gw, gw + 1024, lane); }
        else { const int r = 2048 + (gw - 1024); ln_pair(io, r, r + 1024, lane); ln_pair(io, r + 2048, r + 3072, lane); ln_pair(io, r + 4096, r + 5120, lane); }
    } else {
        for (int row = gw; row < MT; row += NGW) ln_one(io, row, lane);
    }
}

__device__ __forceinline__ bf16x8 frag_plain(const LAS bf16* X, int ld, int r0, int k0, int lane) { return *(const LAS bf16x8*)(X + (r0 + (lane & 15)) * ld + k0 + 8 * (lane >> 4)); }
typedef short v4i16_t __attribute__((ext_vector_type(4)));
__device__ __forceinline__ bf16x8 frag_tr(const LAS bf16* Y, int ld, int kr0, int c0, int lane) {
    const int i = lane & 15, g4 = lane >> 4; const LAS bf16* p = Y + (kr0 + 8 * g4 + (i >> 2)) * ld + c0 + 4 * (i & 3);
    const v4i16_t lo = __builtin_amdgcn_ds_read_tr16_b64_v4i16((LAS v4i16_t*)p), hi = __builtin_amdgcn_ds_read_tr16_b64_v4i16((LAS v4i16_t*)(p + 4 * ld));
    return (bf16x8){lo[0], lo[1], lo[2], lo[3], hi[0], hi[1], hi[2], hi[3]};
}
#define MFMA16(a, b, c) __builtin_amdgcn_mfma_f32_16x16x32_bf16((a), (b), (c), 0, 0, 0)

template <int Q>
__device__ __forceinline__ void mix_item(const Args& a, LAS unsigned char* lds, int rb, int g, int cq, int wave, int lane) {
    constexpr int NCT = 16 / Q, NV = 8 / Q;
    const int tid = threadIdx.x;
    LAS bf16* Wm = (LAS bf16*)lds;
    LAS bf16* vn = (LAS bf16*)(lds + 34816);
    LAS f32x2* mr = (LAS f32x2*)(lds + 34816 + 67584);
    const bf16* U = (const bf16*)(a.ws + WS_R1); const bf16* V = U + (size_t)MT * DM; bf16* SB = (bf16*)(a.ws + WS_R1 + 72 * MiB);
    const f32x2* stat = (const f32x2*)(a.ws + WS_STAT);
    const float* lng = a.in[4]; const float* lnb = a.in[5]; const float* aws = a.in[6]; const float* abs_ = a.in[7];
    float* gv = a.out + (size_t)MT * DM + (size_t)(4 + 32) * 8 * 256 * 512;
    const int row0 = rb * 128, cbase = g * 256 + cq * (256 / Q); const bool smp = rb >= 64;
    const int wt = tid >> 2, ws0 = (tid & 3) * 32, wtw = smp ? (wt & 31) : wt;
    f32x4 wreg[8];
#pragma unroll
    for (int k = 0; k < 4; ++k) { const int sw = smp ? ((ws0 + 8 * k) & 31) : (ws0 + 8 * k); const float* wp = aws + ((size_t)g * 128 + wtw) * 128 + sw; wreg[2 * k] = *(const f32x4*)wp; wreg[2 * k + 1] = *(const f32x4*)(wp + 4); }
    const int vs_ = tid >> 2, vcb = (tid & 3) * (64 / Q); const bf16* vp = V + (size_t)(row0 + vs_) * DM + cbase + vcb;
    u32x4 vreg[NV];
#pragma unroll
    for (int k = 0; k < NV; ++k) vreg[k] = *(const u32x4*)(vp + 8 * k);
    const int t0 = 16 * wave, i = lane & 15, g4 = lane >> 4, t = t0 + i, row = row0 + t;
    u32x2 ureg[NCT];
#pragma unroll
    for (int ct = 0; ct < NCT; ++ct) ureg[ct] = *(const u32x2*)(U + (size_t)row * DM + cbase + 16 * ct + 4 * g4);
    const float bias = abs_[g * 128 + (smp ? (t & 31) : t)];
    if (tid < 128) { const f32x4* sp = (const f32x4*)(stat + (size_t)(row0 + tid) * 32); float s_ = 0.f, q_ = 0.f;
#pragma unroll
        for (int k = 0; k < 16; ++k) { const f32x4 v = sp[k]; s_ += v[0] + v[2]; q_ += v[1] + v[3]; }
        const float mean = s_ * (1.f / 2048.f), var = q_ * (1.f / 2048.f) - mean * mean; mr[tid] = (f32x2){mean, 1.0f / sqrtf(var + LN_EPS)}; }
#pragma unroll
    for (int k = 0; k < 4; ++k) { const int s0 = ws0 + 8 * k; const f32x4 w0 = wreg[2 * k], w1 = wreg[2 * k + 1];
        float w[8] = {w0[0], w0[1], w0[2], w0[3], w1[0], w1[1], w1[2], w1[3]};
#pragma unroll
        for (int e = 0; e < 8; ++e) { const int ss = s0 + e; const bool ok = smp ? ((ss >> 5) == (wt >> 5) && (ss & 31) <= (wt & 31)) : (ss <= wt); w[e] = ok ? w[e] : 0.f; }
        u32x4 o; o.x = pk2(w[0], w[1]); o.y = pk2(w[2], w[3]); o.z = pk2(w[4], w[5]); o.w = pk2(w[6], w[7]);
        *(LAS u32x4*)(Wm + wt * 136 + s0) = o; }
    __syncthreads();
    { const f32x2 m = mr[vs_];
#pragma unroll
        for (int k = 0; k < NV; ++k) { const u32x4 w = vreg[k]; const int c = cbase + vcb + 8 * k;
            const f32x4 g0 = *(const f32x4*)(lng + c), g1 = *(const f32x4*)(lng + c + 4), b0 = *(const f32x4*)(lnb + c), b1 = *(const f32x4*)(lnb + c + 4);
            f32x4 x0 = (f32x4){bf_lo(w.x), bf_hi(w.x), bf_lo(w.y), bf_hi(w.y)}, x1 = (f32x4){bf_lo(w.z), bf_hi(w.z), bf_lo(w.w), bf_hi(w.w)};
            x0 = (x0 - m.x) * m.y * g0 + b0; x1 = (x1 - m.x) * m.y * g1 + b1;
            u32x4 o; o.x = pk2(x0[0], x0[1]); o.y = pk2(x0[2], x0[3]); o.z = pk2(x1[0], x1[1]); o.w = pk2(x1[2], x1[3]);
            *(LAS u32x4*)(vn + vs_ * 264 + vcb + 8 * k) = o;
            if (smp) { float* op = gv + (size_t)(row0 + vs_ - MP) * DM + c; __builtin_nontemporal_store(x0, (f32x4*)op); __builtin_nontemporal_store(x1, (f32x4*)(op + 4)); } } }
    __syncthreads();
    {
        f32x4 acc[NCT];
#pragma unroll
        for (int ct = 0; ct < NCT; ++ct) acc[ct] = (f32x4){0.f, 0.f, 0.f, 0.f};
        const int kmax = (t0 + 15) >> 5;
        for (int kk = 0; kk <= kmax; ++kk) { const bf16x8 bw = frag_plain(Wm, 136, t0, 32 * kk, lane);
#pragma unroll
            for (int ct = 0; ct < NCT; ++ct) { const bf16x8 av = frag_tr(vn, 264, 32 * kk, 16 * ct, lane); acc[ct] = MFMA16(av, bw, acc[ct]); } }
#pragma unroll
        for (int ct = 0; ct < NCT; ++ct) { const size_t off = (size_t)row * DM + cbase + 16 * ct + 4 * g4; const u32x2 uu = ureg[ct];
            u32x2 o; o.x = pk2(bf_lo(uu.x) * (acc[ct][0] + bias), bf_hi(uu.x) * (acc[ct][1] + bias)); o.y = pk2(bf_lo(uu.y) * (acc[ct][2] + bias), bf_hi(uu.y) * (acc[ct][3] + bias));
            *(u32x2*)(SB + off) = o; }
    }
    __syncthreads();
}
__device__ __forceinline__ void mix_phase(const Args& a, LAS unsigned char* lds, int wave, int lane) {
    for (int item = blockIdx.x; item < 64 * 8; item += gridDim.x) mix_item<1>(a, lds, item >> 3, item & 7, 0, wave, lane);
    for (int item = blockIdx.x; item < 8 * 8 * 4; item += gridDim.x) mix_item<4>(a, lds, 64 + (item >> 5), (item >> 2) & 7, item & 3, wave, lane);
}
constexpr int R_QS = 0, R_KS = 33792, R_VS = 67584, R_PS = 76800, R_RT = 86016, R_OS = 119808;
template <int L>
__device__ __forceinline__ void ret_run(LAS unsigned char* lds, const bf16* QH, const bf16* KH, const bf16* VB, bf16* OB, int grow0, int nblk, int h, int slice, const float* S0, float* Sout, int wave, int lane) {
    const int tid = threadIdx.x, i = lane & 15, g4 = lane >> 4;
    LAS bf16* qs = (LAS bf16*)(lds + R_QS); LAS bf16* ks = (LAS bf16*)(lds + R_KS); LAS bf16* vs = (LAS bf16*)(lds + R_VS);
    LAS bf16* ps = (LAS bf16*)(lds + R_PS); LAS bf16* rts = (LAS bf16*)(lds + R_RT); LAS bf16* os = (LAS bf16*)(lds + R_OS);
    const float lg = pg8::lg2gamma(h);
    const float gL = __builtin_amdgcn_exp2f(lg * (float)L), gLm1 = __builtin_amdgcn_exp2f(lg * (float)(L - 1)), gLm1i = __builtin_amdgcn_exp2f(-lg * (float)(L - 1));
    constexpr int NQ = L / 16, NT = L / 32, NKK = L / 32;
    const bool vthr = (L == 64) || tid < 256;
    u32x4 pq[NQ], pk[NQ], pv;
#define RET_GLOAD(blk) do { const int r0_ = grow0 + (blk) * L; _Pragma("unroll") for (int k_ = 0; k_ < NQ; ++k_) { const int e_ = tid + 512 * k_, row_ = e_ >> 5, ch_ = e_ & 31; \
        pq[k_] = *(const u32x4*)(QH + (size_t)(r0_ + row_) * 2048 + h * 256 + ch_ * 8); pk[k_] = *(const u32x4*)(KH + (size_t)(r0_ + row_) * 2048 + h * 256 + ch_ * 8); } \
        if (vthr) pv = *(const u32x4*)(VB + (size_t)(r0_ + (tid >> 3)) * 4096 + h * 512 + slice * 64 + (tid & 7) * 8); } while (0)
#define RET_LSTORE() do { _Pragma("unroll") for (int k_ = 0; k_ < NQ; ++k_) { const int e_ = tid + 512 * k_, row_ = e_ >> 5, ch_ = e_ & 31; \
        *(LAS u32x4*)(qs + row_ * 264 + ch_ * 8) = pq[k_]; *(LAS u32x4*)(ks + row_ * 264 + ch_ * 8) = pk[k_]; } \
        if (vthr) *(LAS u32x4*)(vs + (tid >> 3) * 72 + (tid & 7) * 8) = pv; } while (0)
    f32x4 R[2][4];
    RET_GLOAD(0);
#pragma unroll
    for (int a2 = 0; a2 < 2; ++a2)
#pragma unroll
        for (int d = 0; d < 4; ++d) {
            if (S0) {
#pragma unroll
                for (int e = 0; e < 4; ++e) R[a2][d][e] = S0[(size_t)(32 * wave + 16 * a2 + 4 * g4 + e) * 512 + slice * 64 + 16 * d + i] * gLm1i;
            } else R[a2][d] = (f32x4){0.f, 0.f, 0.f, 0.f};
            u32x2 w; w.x = pk2(R[a2][d][0], R[a2][d][1]); w.y = pk2(R[a2][d][2], R[a2][d][3]);
            *(LAS u32x2*)(rts + (16 * d + i) * 264 + 32 * wave + 16 * a2 + 4 * g4) = w; }
    RET_LSTORE();
    __syncthreads();
    const int it = (L == 64) ? (wave >> 1) : (wave >> 2);
    for (int n = 0; n < nblk; ++n) {
        if (n + 1 < nblk) RET_GLOAD(n + 1);
        bf16x8 qf[8];
#pragma unroll
        for (int kk = 0; kk < 8; ++kk) qf[kk] = frag_plain(qs, 264, 16 * it, 32 * kk, lane);
        if (L == 64 || wave < 4) {
#pragma unroll
            for (int tp = 0; tp < NT; ++tp) { const int i0 = 16 * (wave >> 1), j0 = (L == 64) ? 16 * (2 * (wave & 1) + tp) : 16 * (wave & 1);
                f32x4 acc = (f32x4){0.f, 0.f, 0.f, 0.f};
#pragma unroll
                for (int kk = 0; kk < 8; ++kk) acc = MFMA16(frag_plain(ks, 264, j0, 32 * kk, lane), (L == 64) ? qf[kk] : frag_plain(qs, 264, i0, 32 * kk, lane), acc);
#pragma unroll
                for (int e = 0; e < 4; ++e) acc[e] = (j0 + 4 * g4 + e <= i0 + i) ? acc[e] : 0.f;
                u32x2 w; w.x = pk2(acc[0], acc[1]); w.y = pk2(acc[2], acc[3]); *(LAS u32x2*)(ps + (i0 + i) * 72 + j0 + 4 * g4) = w; }
        }
        f32x4 oacc[NT];
#pragma unroll
        for (int tp = 0; tp < NT; ++tp) { const int dv0 = (L == 64) ? 16 * (2 * (wave & 1) + tp) : 16 * (wave & 3);
            f32x4 acc = (f32x4){0.f, 0.f, 0.f, 0.f};
#pragma unroll
            for (int kk = 0; kk < 8; ++kk) acc = MFMA16(frag_plain(rts, 264, dv0, 32 * kk, lane), qf[kk], acc);
            oacc[tp] = acc * gL; }
        __syncthreads();
#pragma unroll
        for (int tp = 0; tp < NT; ++tp) { const int dv0 = (L == 64) ? 16 * (2 * (wave & 1) + tp) : 16 * (wave & 3);
#pragma unroll
            for (int kk = 0; kk < NKK; ++kk) oacc[tp] = MFMA16(frag_tr(vs, 72, 32 * kk, dv0, lane), frag_plain(ps, 72, 16 * it, 32 * kk, lane), oacc[tp]);
            u32x2 w; w.x = pk2(oacc[tp][0], oacc[tp][1]); w.y = pk2(oacc[tp][2], oacc[tp][3]); *(LAS u32x2*)(os + (16 * it + i) * 72 + dv0 + 4 * g4) = w; }
#pragma unroll
        for (int a2 = 0; a2 < 2; ++a2)
#pragma unroll
            for (int d = 0; d < 4; ++d) R[a2][d] = R[a2][d] * gL;
#pragma unroll
        for (int kk = 0; kk < NKK; ++kk) { bf16x8 bv[4];
#pragma unroll
            for (int d = 0; d < 4; ++d) bv[d] = frag_tr(vs, 72, 32 * kk, 16 * d, lane);
#pragma unroll
            for (int a2 = 0; a2 < 2; ++a2) { const bf16x8 av = frag_tr(ks, 264, 32 * kk, 32 * wave + 16 * a2, lane);
#pragma unroll
                for (int d = 0; d < 4; ++d) R[a2][d] = MFMA16(av, bv[d], R[a2][d]); } }
        __syncthreads();
#pragma unroll
        for (int a2 = 0; a2 < 2; ++a2)
#pragma unroll
            for (int d = 0; d < 4; ++d) { u32x2 w; w.x = pk2(R[a2][d][0], R[a2][d][1]); w.y = pk2(R[a2][d][2], R[a2][d][3]);
                *(LAS u32x2*)(rts + (16 * d + i) * 264 + 32 * wave + 16 * a2 + 4 * g4) = w; }
        if (vthr) *(u32x4*)(OB + (size_t)(grow0 + n * L + (tid >> 3)) * 4096 + h * 512 + slice * 64 + (tid & 7) * 8) = *(const LAS u32x4*)(os + (tid >> 3) * 72 + (tid & 7) * 8);
        if (n + 1 < nblk) RET_LSTORE();
        __syncthreads();
    }
#pragma unroll
    for (int a2 = 0; a2 < 2; ++a2)
#pragma unroll
        for (int d = 0; d < 4; ++d)
#pragma unroll
            for (int e = 0; e < 4; ++e) __builtin_nontemporal_store(R[a2][d][e] * gLm1, Sout + (size_t)(32 * wave + 16 * a2 + 4 * g4 + e) * 512 + slice * 64 + 16 * d + i);
#undef RET_GLOAD
#undef RET_LSTORE
}

constexpr int S_QS = 0, S_KS = 16896, S_PS = 33792, S_RT = 38400, S_VS = 105984, S_OS = 115200;
__device__ __forceinline__ void ret_sample(LAS unsigned char* lds, const bf16* QH, const bf16* KH, const bf16* VB, bf16* OB, int grow0, int h, const float* S0, float* Sout, int wave, int lane) {
    const int tid = threadIdx.x, i = lane & 15, g4 = lane >> 4;
    LAS bf16* qs = (LAS bf16*)(lds + S_QS); LAS bf16* ks = (LAS bf16*)(lds + S_KS); LAS bf16* ps = (LAS bf16*)(lds + S_PS);
    const float lg = pg8::lg2gamma(h);
    const float gL = __builtin_amdgcn_exp2f(lg * 32.f), gLm1 = __builtin_amdgcn_exp2f(lg * 31.f), gLm1i = __builtin_amdgcn_exp2f(-lg * 31.f);
    const bool vthr = tid < 256;
#pragma unroll
    for (int k = 0; k < 2; ++k) { const int e = tid + 512 * k, row = e >> 5, ch = e & 31;
        *(LAS u32x4*)(qs + row * 264 + ch * 8) = *(const u32x4*)(QH + (size_t)(grow0 + row) * 2048 + h * 256 + ch * 8);
        *(LAS u32x4*)(ks + row * 264 + ch * 8) = *(const u32x4*)(KH + (size_t)(grow0 + row) * 2048 + h * 256 + ch * 8); }
    f32x4 Rn[2][4]; u32x4 vn = (u32x4){0u, 0u, 0u, 0u};
#define SMP_PREFETCH(sl) do { _Pragma("unroll") for (int a2 = 0; a2 < 2; ++a2) _Pragma("unroll") for (int d = 0; d < 4; ++d) _Pragma("unroll") for (int e = 0; e < 4; ++e) \
        Rn[a2][d][e] = __builtin_nontemporal_load(S0 + (size_t)(32 * wave + 16 * a2 + 4 * g4 + e) * 512 + (sl) * 64 + 16 * d + i); \
        if (vthr) vn = *(const u32x4*)(VB + (size_t)(grow0 + (tid >> 3)) * 4096 + h * 512 + (sl) * 64 + (tid & 7) * 8); } while (0)
    SMP_PREFETCH(0);
    __syncthreads();
    if (wave < 4) {
        const int i0 = 16 * (wave >> 1), j0 = 16 * (wave & 1); f32x4 acc = (f32x4){0.f, 0.f, 0.f, 0.f};
#pragma unroll
        for (int kk = 0; kk < 8; ++kk) acc = MFMA16(frag_plain(ks, 264, j0, 32 * kk, lane), frag_plain(qs, 264, i0, 32 * kk, lane), acc);
#pragma unroll
        for (int e = 0; e < 4; ++e) acc[e] = (j0 + 4 * g4 + e <= i0 + i) ? acc[e] : 0.f;
        u32x2 w; w.x = pk2(acc[0], acc[1]); w.y = pk2(acc[2], acc[3]); *(LAS u32x2*)(ps + (i0 + i) * 72 + j0 + 4 * g4) = w;
    }
    const int it = wave >> 2, dv0 = 16 * (wave & 3);
    bf16x8 qf[8], av[2];
#pragma unroll
    for (int kk = 0; kk < 8; ++kk) qf[kk] = frag_plain(qs, 264, 16 * it, 32 * kk, lane);
#pragma unroll
    for (int a2 = 0; a2 < 2; ++a2) av[a2] = frag_tr(ks, 264, 0, 32 * wave + 16 * a2, lane);
    __syncthreads();
    const bf16x8 pf = frag_plain(ps, 72, 16 * it, 0, lane);
    for (int sl = 0; sl < 8; ++sl) {
        LAS bf16* rts = (LAS bf16*)(lds + S_RT + (sl & 1) * 33792); LAS bf16* vs = (LAS bf16*)(lds + S_VS + (sl & 1) * 4608); LAS bf16* os = (LAS bf16*)(lds + S_OS + (sl & 1) * 4608);
        f32x4 R[2][4];
#pragma unroll
        for (int a2 = 0; a2 < 2; ++a2)
#pragma unroll
            for (int d = 0; d < 4; ++d) { R[a2][d] = Rn[a2][d] * gLm1i; u32x2 w; w.x = pk2(R[a2][d][0], R[a2][d][1]); w.y = pk2(R[a2][d][2], R[a2][d][3]);
                *(LAS u32x2*)(rts + (16 * d + i) * 264 + 32 * wave + 16 * a2 + 4 * g4) = w; }
        if (vthr) *(LAS u32x4*)(vs + (tid >> 3) * 72 + (tid & 7) * 8) = vn;
        if (sl + 1 < 8) SMP_PREFETCH(sl + 1);
        __syncthreads();
        if (sl > 0 && vthr) *(u32x4*)(OB + (size_t)(grow0 + (tid >> 3)) * 4096 + h * 512 + (sl - 1) * 64 + (tid & 7) * 8) = *(const LAS u32x4*)((LAS bf16*)(lds + S_OS + ((sl - 1) & 1) * 4608) + (tid >> 3) * 72 + (tid & 7) * 8);
        f32x4 acc = (f32x4){0.f, 0.f, 0.f, 0.f};
#pragma unroll
        for (int kk = 0; kk < 8; ++kk) acc = MFMA16(frag_plain(rts, 264, dv0, 32 * kk, lane), qf[kk], acc);
        acc = acc * gL;
        acc = MFMA16(frag_tr(vs, 72, 0, dv0, lane), pf, acc);
        { u32x2 w; w.x = pk2(acc[0], acc[1]); w.y = pk2(acc[2], acc[3]); *(LAS u32x2*)(os + (16 * it + i) * 72 + dv0 + 4 * g4) = w; }
        bf16x8 bv[4];
#pragma unroll
        for (int d = 0; d < 4; ++d) bv[d] = frag_tr(vs, 72, 0, 16 * d, lane);
#pragma unroll
        for (int a2 = 0; a2 < 2; ++a2)
#pragma unroll
            for (int d = 0; d < 4; ++d) { R[a2][d] = MFMA16(av[a2], bv[d], R[a2][d] * gL);
#pragma unroll
                for (int e = 0; e < 4; ++e) __builtin_nontemporal_store(R[a2][d][e] * gLm1, Sout + (size_t)(32 * wave + 16 * a2 + 4 * g4 + e) * 512 + sl * 64 + 16 * d + i); }
    }
    __syncthreads();
    if (vthr) *(u32x4*)(OB + (size_t)(grow0 + (tid >> 3)) * 4096 + h * 512 + 7 * 64 + (tid & 7) * 8) = *(const LAS u32x4*)((LAS bf16*)(lds + S_OS + 4608) + (tid >> 3) * 72 + (tid & 7) * 8);
    __syncthreads();
#undef SMP_PREFETCH
}
__device__ __forceinline__ void ret_phase(const Args& a, LAS unsigned char* lds, int wave, int lane) {
    const bf16* QH = (const bf16*)(a.ws + WS_R1); const bf16* KH = QH + (size_t)MT * DM; const bf16* VB = (const bf16*)(a.ws + WS_R1 + 72 * MiB); bf16* OB = (bf16*)(a.ws + WS_YP);
    float* sp = a.out + (size_t)MT * DM; float* ss = sp + (size_t)4 * 8 * 256 * 512;
    for (int item = blockIdx.x; item < 256; item += gridDim.x) {
        const int x = item & 7, j = item >> 3, bh = x * 4 + (j >> 3), slice = j & 7, b = bh >> 3, h = bh & 7;
        ret_run<64>(lds, QH, KH, VB, OB, b * 2048, 32, h, slice, nullptr, sp + (size_t)bh * 256 * 512, wave, lane);
    }
    for (int pair = blockIdx.x; pair < 256; pair += gridDim.x) {
        const int b = pair >> 3, h = pair & 7;
        ret_sample(lds, QH, KH, VB, OB, MP + b * 32, h, a.in[2] + (size_t)pair * 256 * 512, ss + (size_t)pair * 256 * 512, wave, lane);
    }
}
__device__ __forceinline__ void gn_gate(const Args& a, int gw, int NGW, int lane) {
    const bf16* O = (const bf16*)(a.ws + WS_YP); bf16* GS = (bf16*)(a.ws + WS_R1 + 144 * MiB);
    for (int row = gw; row < MT; row += NGW) {
        const size_t off = (size_t)row * 4096 + 8 * lane;
        u32x4 ow[8], gv[8];
#pragma unroll
        for (int h = 0; h < 8; ++h) { ow[h] = *(const u32x4*)(O + off + h * 512); gv[h] = *(const u32x4*)(GS + off + h * 512); }
#pragma unroll
        for (int h = 0; h < 8; ++h) {
            float o[8] = {bf_lo(ow[h].x), bf_hi(ow[h].x), bf_lo(ow[h].y), bf_hi(ow[h].y), bf_lo(ow[h].z), bf_hi(ow[h].z), bf_lo(ow[h].w), bf_hi(ow[h].w)};
            const float g[8] = {bf_lo(gv[h].x), bf_hi(gv[h].x), bf_lo(gv[h].y), bf_hi(gv[h].y), bf_lo(gv[h].z), bf_hi(gv[h].z), bf_lo(gv[h].w), bf_hi(gv[h].w)};
            float s = 0.f;
#pragma unroll
            for (int e = 0; e < 8; ++e) s += o[e];
            const float mean = wave_sum(s) * (1.f / 512.f); float q = 0.f;
#pragma unroll
            for (int e = 0; e < 8; ++e) { o[e] -= mean; q += o[e] * o[e]; }
            const float rstd = 1.0f / sqrtf(wave_sum(q) * (1.f / 512.f) + GN_EPS);
            u32x4 w; w.x = pk2(g[0] * o[0] * rstd, g[1] * o[1] * rstd); w.y = pk2(g[2] * o[2] * rstd, g[3] * o[3] * rstd); w.z = pk2(g[4] * o[4] * rstd, g[5] * o[5] * rstd); w.w = pk2(g[6] * o[6] * rstd, g[7] * o[7] * rstd);
            *(u32x4*)(GS + off + h * 512) = w;
        }
    }
}

#ifndef DBG_STOP
#define DBG_STOP 0
#endif
__device__ __forceinline__ void dbg_dump(const Args& a, const bf16* src, size_t n_el) {
    const size_t T = (size_t)gridDim.x * 512, t = (size_t)blockIdx.x * 512 + threadIdx.x, total = 58720256;
    for (size_t i = t; i < total; i += T) { float v = 0.f; if (i < n_el / 2) { const unsigned w = ((const unsigned*)src)[i]; v = bf_lo(w) + bf_hi(w); } a.out[i] = v; }
}
__device__ __forceinline__ void dbg_dump_f32(const Args& a, const float* src, size_t n_el) {
    const size_t T = (size_t)gridDim.x * 512, t = (size_t)blockIdx.x * 512 + threadIdx.x, total = 58720256;
    for (size_t i = t; i < total; i += T) a.out[i] = i < n_el ? src[i] : 0.f;
}
#define XB_TMO      128
#define XB_XCNT(j)  (256  + 64 * (j))
#define XB_XSUB(j)  (1280 + 64 * (j))
#define XB_XGEN(j)  (2304 + 64 * (j))
#define XB_TOP      3328
#define XB_TOPGEN   3392
#define XCD_BAR_WORDS 3456
#define XB_SPIN_CAP (1u << 18)

__device__ __forceinline__ unsigned xb_ld(unsigned* p)              { return __hip_atomic_load(p, __ATOMIC_RELAXED, __HIP_MEMORY_SCOPE_AGENT); }
__device__ __forceinline__ unsigned xb_add(unsigned* p, unsigned v) { return __hip_atomic_fetch_add(p, v, __ATOMIC_RELAXED, __HIP_MEMORY_SCOPE_AGENT); }
__device__ __forceinline__ unsigned xb_xcc_id() { return (unsigned)__builtin_amdgcn_s_getreg((3 << 11) | 20) & 0xFu; }
#define XB_SPIN(cond, bar) do { unsigned _sp = 0; while (cond) { __builtin_amdgcn_s_sleep(1); \
    if ((++_sp & 255u) == 0u) { if (xb_ld(&(bar)[XB_TMO])) break; if (_sp > XB_SPIN_CAP) { atomicAdd(&(bar)[XB_TMO], 1u); break; } } } } while (0)

struct XcdBarrier {
    unsigned* bar; unsigned x;
    volatile LAS unsigned* st;
};

__device__ __forceinline__ XcdBarrier xcd_barrier_post(unsigned* bar, volatile LAS unsigned* st) {
    XcdBarrier b; b.bar = bar; b.x = xb_xcc_id(); b.st = st;
    if (threadIdx.x == 0) (void)xb_add(&bar[XB_XCNT(b.x)], 1u);
    return b;
}
__device__ __forceinline__ void xcd_barrier_complete(unsigned* bar, unsigned x, unsigned& nloc, unsigned& nx) {
    const unsigned G = gridDim.x * gridDim.y * gridDim.z;
    unsigned sum, cnt, mine, sp = 0u;
    for (;;) {
        sum = 0u; cnt = 0u; mine = 0u;
#pragma unroll
        for (unsigned j = 0; j < 16; ++j) { const unsigned c = xb_ld(&bar[XB_XCNT(j)]); sum += c; cnt += (c > 0u) ? 1u : 0u; mine = (j == x) ? c : mine; }
        if (sum == G) break;
        __builtin_amdgcn_s_sleep(1);
        if ((++sp & 255u) == 0u) { if (xb_ld(&bar[XB_TMO])) break; if (sp > XB_SPIN_CAP) { atomicAdd(&bar[XB_TMO], 1u); break; } }
    }
    nloc = mine > 0u ? mine : 1u; nx = cnt > 0u ? cnt : 1u;
}

__device__ __forceinline__ void xcd_barrier(const XcdBarrier& b) {
    asm volatile("s_waitcnt vmcnt(0)" ::: "memory");
    __syncthreads();
    if (threadIdx.x == 0) {
        unsigned* bar = b.bar;
        __builtin_amdgcn_s_waitcnt(0);
        unsigned nloc = b.st[0], nx = b.st[1];
        if (nloc == 0u) { xcd_barrier_complete(bar, b.x, nloc, nx); b.st[0] = nloc; b.st[1] = nx; }
        const unsigned old = xb_add(&bar[XB_XSUB(b.x)], 1u);
        const unsigned gen = old / nloc;
        if (old + 1u == (gen + 1u) * nloc) {
            __builtin_amdgcn_fence(__ATOMIC_RELEASE, "agent");
            asm volatile("s_waitcnt vmcnt(0)" ::: "memory");
            const unsigned og = xb_add(&bar[XB_TOP], 1u);
            const unsigned tg = og / nx;
            if (og + 1u == (tg + 1u) * nx) xb_add(&bar[XB_TOPGEN], 1u);
            else XB_SPIN(xb_ld(&bar[XB_TOPGEN]) == tg, bar);
            __builtin_amdgcn_fence(__ATOMIC_ACQUIRE, "agent");
            xb_add(&bar[XB_XGEN(b.x)], 1u);
            asm volatile("s_waitcnt vmcnt(0)" ::: "memory");
        } else {
            XB_SPIN(xb_ld(&bar[XB_XGEN(b.x)]) == gen, bar);
            __builtin_amdgcn_fence(__ATOMIC_ACQUIRE, "agent");
            asm volatile("s_waitcnt vmcnt(0)" ::: "memory");
        }
    }
    __syncthreads();
}

__global__ void __launch_bounds__(512, 2) fwd(Args a) {
    extern __shared__ __attribute__((aligned(16))) unsigned char lds_raw[];
    cg::grid_group grid = cg::this_grid();
    LAS unsigned char* lds = (LAS unsigned char*)lds_raw;
    const int tid = threadIdx.x, lane = tid & 63, wave = __builtin_amdgcn_readfirstlane(tid >> 6);
    const int G = gridDim.x, c = blockIdx.x, vcu = (G % 8 == 0) ? (c % 8) * (G / 8) + c / 8 : c, gw = vcu * NW + wave, NGW = G * NW;
    unsigned char* ws = a.ws;
    { volatile LAS unsigned* misc = (volatile LAS unsigned*)(lds + MISC_OFF); if (tid < 32) misc[tid] = 0u; }
    __syncthreads();
    XcdBarrier bar = xcd_barrier_post((unsigned*)(ws + WS_CTL), (volatile LAS unsigned*)(lds + MISC_OFF) + 8);
    bf16* XB = (bf16*)(ws + WS_XB); float* YP = (float*)(ws + WS_YP);
    bf16* R1 = (bf16*)(ws + WS_R1);
#define GEMM(EPI, E, Ap, Bp, LD, M1, N, K, SPLIT, CLIST) do { pg8::Gemm g_{(const pg8::bf16_t*)(Ap), (const pg8::bf16_t*)(Bp), (LD)}; pg8::Order S_; S_.init((M1), (N), (K), (SPLIT), G, c); \
        pg8::gemm_phase<EPI, pg8::Order, true, true>(lds, g_, S_, E); if (DBL_GEMM) pg8::gemm_phase<EPI, pg8::Order, true, true>(lds, g_, S_, E); \
        if ((CLIST) > 0) { const int nbusy_ = S_.so.nwg % G;   \
            if (nbusy_ == 0) convert_list(a, lds, (CLIST), gw, NGW, wave, lane); else if (c >= nbusy_) convert_list(a, lds, (CLIST), (c - nbusy_) * NW + wave, (G - nbusy_) * NW, wave, lane); } } while (0)

#define GRID_SYNC() do { asm volatile("s_waitcnt vmcnt(0) lgkmcnt(0)" ::: "memory"); grid.sync(); } while (0)
#define XCD_SYNC() xcd_barrier(bar)

#define DBG_DUMP_1 dbg_dump(a, XB, (size_t)MT * DM)
#define DBG_DUMP_2 dbg_dump(a, R1, (size_t)2 * MT * DM)
#define DBG_DUMP_3 dbg_dump(a, R1 + (size_t)2 * MT * DM, (size_t)MT * DM)
#define DBG_DUMP_4 dbg_dump(a, (const bf16*)YP, (size_t)MP * DM)
#define DBG_DUMP_5 dbg_dump(a, XB, (size_t)MT * DM)
#define DBG_DUMP_6 dbg_dump(a, R1, (size_t)MT * FF)
#define DBG_DUMP_7 dbg_dump(a, (const bf16*)YP, (size_t)MP * DM)
#define DBG_DUMP_8 dbg_dump(a, XB, (size_t)MT * DM)
#define DBG_DUMP_9 dbg_dump(a, R1, (size_t)6 * MT * DM)
#define DBG_DUMP_10 dbg_dump(a, (const bf16*)YP, (size_t)2 * MT * DM)
#define DBG_DUMP_11 dbg_dump(a, R1 + (size_t)4 * MT * DM, (size_t)2 * MT * DM)
#define DBG_DUMP_12 dbg_dump(a, (const bf16*)YP, (size_t)MP * DM)
#define DBG_DUMP_13 dbg_dump(a, XB, (size_t)MT * DM)
#define DBG_DUMP_14 dbg_dump(a, R1, (size_t)MT * FF)
#define DBG_DUMP_15 dbg_dump(a, (const bf16*)YP, (size_t)MP * DM)
    p0_prologue(a, lds, gw, NGW, wave, lane);
    if (a.out == nullptr) GRID_SYNC();
    XCD_SYNC();
    if (DBG_STOP == 1) { DBG_DUMP_1; return; }
    { pg8::EpiGeluUV E{R1, R1 + (size_t)MT * DM, (pg8::f32x2*)(ws + WS_STAT)}; GEMM(pg8::EpiGeluUV, E, XB, ws + WS_WAIN, 2048, MT, 4096, 2048, 0, 1); }
    XCD_SYNC();
    if (DBG_STOP == 2) { DBG_DUMP_2; return; }
    mix_phase(a, lds, wave, lane);
    XCD_SYNC();
    if (DBG_STOP == 3) { DBG_DUMP_3; return; }
    { pg8::EpiPart E{(pg8::bf16_t*)YP}; GEMM(pg8::EpiPart, E, ws + WS_R1 + 72 * MiB, ws + WS_WAOUT, 2048, MP, 2048, 2048, 1, 0); }
    XCD_SYNC();
    if (DBG_STOP == 4) { DBG_DUMP_4; return; }
    ln_pass(nullptr, nullptr, XB, YP, a.in[13], a.in[14], nullptr, XB, gw, NGW, lane);
    XCD_SYNC();
    if (DBG_STOP == 5) { DBG_DUMP_5; return; }
    { pg8::EpiSwiglu E{R1}; GEMM(pg8::EpiSwiglu, E, XB, ws + WS_WFIN, 2048, MT, 11264, 2048, 0, 2); }
    XCD_SYNC();
    if (DBG_STOP == 6) { DBG_DUMP_6; return; }
    { pg8::EpiPart E{(pg8::bf16_t*)YP}; GEMM(pg8::EpiPart, E, R1, ws + WS_WFOUT, 5632, MP, 2048, 5632, 1, 0); }
    XCD_SYNC();
    if (DBG_STOP == 7) { DBG_DUMP_7; return; }
    ln_pass(nullptr, nullptr, XB, YP, a.in[15], a.in[16], nullptr, XB, gw, NGW, lane);
    XCD_SYNC();
    if (DBG_STOP == 8) { DBG_DUMP_8; return; }
    { pg8::EpiQKVG E{R1, R1 + (size_t)MT * DM, (pg8::bf16_t*)(ws + WS_R1 + 72 * MiB), (pg8::bf16_t*)(ws + WS_R1 + 144 * MiB), (const float*)(ws + WS_ROPE), (const float*)(ws + WS_ROPE) + 2080 * 128};
      GEMM(pg8::EpiQKVG, E, XB, ws + WS_WBIN, 2048, MT, 12288, 2048, 0, 3); }
    XCD_SYNC();
    if (DBG_STOP == 9) { DBG_DUMP_9; return; }
    ret_phase(a, lds, wave, lane);
    XCD_SYNC();
    if (DBG_STOP == 10) { DBG_DUMP_10; return; }
    gn_gate(a, gw, NGW, lane);
    XCD_SYNC();
    if (DBG_STOP == 11) { DBG_DUMP_11; return; }
    { pg8::EpiPart E{(pg8::bf16_t*)YP}; GEMM(pg8::EpiPart, E, ws + WS_R1 + 144 * MiB, ws + WS_WBOUT, 4096, MP, 2048, 4096, 1, 0); }
    XCD_SYNC();
    if (DBG_STOP == 12) { DBG_DUMP_12; return; }
    ln_pass(nullptr, nullptr, XB, YP, a.in[13] + DM, a.in[14] + DM, nullptr, XB, gw, NGW, lane);
    XCD_SYNC();
    if (DBG_STOP == 13) { DBG_DUMP_13; return; }
    { pg8::EpiSwiglu E{R1}; GEMM(pg8::EpiSwiglu, E, XB, ws + WS_WFIN + 44 * MiB, 2048, MT, 11264, 2048, 0, 4); }
    XCD_SYNC();
    if (DBG_STOP == 14) { DBG_DUMP_14; return; }
    { pg8::EpiPart E{(pg8::bf16_t*)YP}; GEMM(pg8::EpiPart, E, R1, ws + WS_WFOUT + 22 * MiB, 5632, MP, 2048, 5632, 1, 0); }
    XCD_SYNC();
    if (DBG_STOP == 15) { DBG_DUMP_15; return; }
    ln_pass(nullptr, nullptr, XB, YP, a.in[15] + DM, a.in[16] + DM, a.out, nullptr, gw, NGW, lane);
#undef GEMM
}

extern "C" void kernel_launch(void* const* d_in, const int* in_sizes, int n_in, void* d_out, int out_size, void* d_ws, size_t ws_size, hipStream_t stream) {
    static int grid = 0;
    if (grid == 0) {
        if (n_in != 17 || ws_size < WS_END) { fprintf(stderr, "kernel_launch: needs 17 inputs and >= %zu bytes of workspace (got %d, %zu)\n", (size_t)WS_END, n_in, ws_size); grid = -1; return; }
        int dev = 0, cus = 0, per_cu = 0;
        if (hipGetDevice(&dev) != hipSuccess || hipDeviceGetAttribute(&cus, hipDeviceAttributeMultiprocessorCount, dev) != hipSuccess) { grid = -1; return; }
        if (hipFuncSetAttribute((const void*)fwd, hipFuncAttributeMaxDynamicSharedMemorySize, LDS_BYTES) != hipSuccess) { fprintf(stderr, "kernel_launch: hipFuncSetAttribute failed\n"); grid = -1; return; }
        if (hipOccupancyMaxActiveBlocksPerMultiprocessor(&per_cu, (const void*)fwd, NW * 64, LDS_BYTES) != hipSuccess || per_cu < 1) { fprintf(stderr, "kernel_launch: occupancy query reports %d workgroups per CU\n", per_cu); grid = -1; return; }
        grid = cus;
    }
    if (grid < 0) return;
    if (hipMemsetAsync((char*)d_ws + WS_CTL, 0, CTL_BYTES, stream) != hipSuccess) { fprintf(stderr, "kernel_launch: hipMemsetAsync failed\n"); return; }
    Args a{};
    for (int i = 0; i < 17; ++i) a.in[i] = (const float*)d_in[i];
    a.out = (float*)d_out; a.ws = (unsigned char*)d_ws;
    void* args[] = {&a};
    const hipError_t e = hipLaunchCooperativeKernel((const void*)fwd, dim3(grid), dim3(NW * 64), args, LDS_BYTES, stream);
    if (e != hipSuccess) fprintf(stderr, "kernel_launch: cooperative launch failed: %s (grid %d)\n", hipGetErrorString(e), grid);
}
```

```cpp
#ifndef DBL_GEMM
#define DBL_GEMM 0
#endif
#include <hip/hip_runtime.h>
#include <hip/hip_cooperative_groups.h>
#include <cstdio>
#include <cstdint>
namespace cg = cooperative_groups;

constexpr int DM = 2048, MP = 8192, MS = 1024, MT = MP + MS, FF = 5632, NQKVG = 12288, RV = 4096;
constexpr float ALPHA = 1.41421356237309515f;
constexpr float LN_EPS = 1e-5f, GN_EPS = 1e-6f;

namespace pg8 {
#define PG8_LAS __attribute__((address_space(3)))
typedef unsigned short bf16_t;
typedef short bf16x8 __attribute__((ext_vector_type(8)));
typedef float f32x4 __attribute__((ext_vector_type(4)));
typedef unsigned u32x4 __attribute__((ext_vector_type(4)));
constexpr int BM = 256, BK = 64, HALF = 128, HTB = HALF * BK * 2  , STAGE_BYTES = 8 * HTB, NXCD = 8, WGM = 4;

__host__ __device__ __forceinline__ int lds_byte(int r, int c) { const int st = (r >> 4) * 2 + (c >> 5), rr = r & 15, cc = c & 31, ob = rr * 64 + cc * 2; return st * 1024 + (ob ^ (((ob >> 9) & 1) << 5)); }
__host__ __device__ __forceinline__ void stage_rc(int b, int& R, int& C) { const int st = b / 1024, sb = b % 1024, swz = sb ^ (((sb >> 9) & 1) << 5); R = (st >> 1) * 16 + swz / 64; C = (st & 1) * 32 + (swz % 64) / 2; }
__host__ __device__ __forceinline__ int perm32(int rho) { const int n = rho >> 4, i = rho & 15; return 8 * (i >> 2) + 4 * n + (i & 3); }

struct Unit { int pm, pn, k0, nt, ks; };
struct Gemm { const bf16_t* A; const bf16_t* Bt; int ld; };

struct StaticOrder {
    int nM, nN, nwg, G, c;
    __host__ __device__ void init(int M, int N, int G_, int c_) { nM = M / BM; nN = N / BM; nwg = nM * nN; G = G_; c = c_; }
    __host__ __device__ __forceinline__ void tile(int L, int& pm_, int& pn_) const {
        int wgid = L; { const int q = nwg / NXCD, r = nwg % NXCD, xcd = wgid % NXCD, off = wgid / NXCD; wgid = (xcd < r ? xcd * (q + 1) : r * (q + 1) + (xcd - r) * q) + off; }
        const int nig = WGM * nN, gid = wgid / nig, fm = gid * WGM, gsz = (nM - fm) < WGM ? (nM - fm) : WGM;
        pm_ = fm + ((wgid % nig) % gsz); pn_ = (wgid % nig) / gsz;
    }
    __device__ __forceinline__ void a_ready(const Unit&) const {}
    __device__ __forceinline__ void done(const Unit&) const {}
};

typedef float f32x2_cv __attribute__((ext_vector_type(2))); typedef __bf16 bf16x2_cv __attribute__((ext_vector_type(2)));
__device__ __forceinline__ unsigned cvt_pk_bf16(float lo, float hi) { const f32x2_cv v = {lo, hi}; const bf16x2_cv b = __builtin_convertvector(v, bf16x2_cv); return __builtin_bit_cast(unsigned, b); }
typedef float f32x2 __attribute__((ext_vector_type(2)));
__device__ __forceinline__ f32x2 gelu_pk(f32x2 v) {
    const f32x2 av = __builtin_elementwise_abs(v), d = av * 0.2316418882f + 1.0f;
    f32x2 t; t.x = __builtin_amdgcn_rcpf(d.x); t.y = __builtin_amdgcn_rcpf(d.y);
    f32x2 q = t * 0.5307027145f + (-0.7265760135f); q = q * t + 0.7107068705f; q = q * t + (-0.142248368f); q = q * t + 0.127414796f; q = q * t;
    const f32x2 s = (v * v) * (-0.72134752044f);
    f32x2 e; e.x = __builtin_amdgcn_exp2f(s.x); e.y = __builtin_amdgcn_exp2f(s.y);
    const f32x2 m = v * (q * e), r = v - m;
    f32x2 o; o.x = v.x < 0.f ? m.x : r.x; o.y = v.y < 0.f ? m.y : r.y; return o;
}
struct Order {
    StaticOrder so; int G, c, n1c, ntk, split;
    __device__ __forceinline__ void init(int M1, int N, int K, int split_, int G_, int c_) { so.init(M1, N, G_, c_); G = G_; c = c_; ntk = K / BK; split = split_; n1c = (c < so.nwg) ? (so.nwg - c + G - 1) / G : 0; }
    __device__ __forceinline__ bool next(int i, Unit& u) const {
        const bool p1 = i < n1c; int pm1, pn1; so.tile(p1 ? i * G + c : 0, pm1, pn1);
        const int j = (i - n1c) * G + c; const bool p2 = !p1 && split != 0 && j < 256;
        const int ks = j & 7, jj = (j >> 3) & 31, b = (ntk >> 3) & ~1, rem2 = (ntk - 8 * b) >> 1;
        Unit r; r.pm = p1 ? pm1 : so.nM + (jj & 3); r.pn = p1 ? pn1 : (jj >> 2); r.k0 = p1 ? 0 : (ks * b + 2 * (ks < rem2 ? ks : rem2)) * BK; r.nt = p1 ? ntk : b + (ks < rem2 ? 2 : 0); r.ks = p1 ? -1 : ks;
        u = r; return p1 || p2;
    }
    __device__ __forceinline__ void a_ready(const Unit&) const {}
    __device__ __forceinline__ void done(const Unit&) const {}
};

__device__ __forceinline__ float silu_f(float x) { return x * __builtin_amdgcn_rcpf(1.0f + __builtin_amdgcn_exp2f(-1.4426950408889634f * x)); }

struct EpiPart {
    static constexpr bool PERM = true, AFTER_DRAIN = false;
    bf16_t* Yb;
    __device__ __forceinline__ void operator()(const f32x4 (&acc)[2][2][4][2], const Unit& u, int wr, int wc, int fr, int fq) const {
        const int row0 = u.pm * BM + wr * 64 + fr + (u.ks > 0 ? u.ks * 1024 : 0), col0 = u.pn * BM + wc * 32 + 8 * fq;
#pragma unroll
        for (int ai = 0; ai < 2; ++ai)
#pragma unroll
            for (int m = 0; m < 4; ++m) { bf16_t* rowp = Yb + (size_t)(row0 + ai * HALF + m * 16) * 2048 + col0;
#pragma unroll
                for (int bj = 0; bj < 2; ++bj) { const f32x4 v0 = acc[ai][bj][m][0], v1 = acc[ai][bj][m][1];
                    u32x4 w; w.x = cvt_pk_bf16(v0[0], v0[1]); w.y = cvt_pk_bf16(v0[2], v0[3]); w.z = cvt_pk_bf16(v1[0], v1[1]); w.w = cvt_pk_bf16(v1[2], v1[3]);
                    *(u32x4*)(rowp + bj * HALF) = w; } }
    }
};
struct EpiGeluUV {
    static constexpr bool PERM = true, AFTER_DRAIN = false;
    bf16_t* U; bf16_t* V; f32x2* stat;
    __device__ __forceinline__ void operator()(const f32x4 (&acc)[2][2][4][2], const Unit& u, int wr, int wc, int fr, int fq) const {
        const bool isv = u.pn >= 8; bf16_t* O = isv ? V : U;
        const int row0 = u.pm * BM + wr * 64 + fr, col0 = (u.pn & 7) * BM + wc * 32 + 8 * fq;
#pragma unroll
        for (int ai = 0; ai < 2; ++ai)
#pragma unroll
            for (int m = 0; m < 4; ++m) { const int row = row0 + ai * HALF + m * 16; bf16_t* rowp = O + (size_t)row * 2048 + col0; float s = 0.f, q = 0.f;
#pragma unroll
                for (int bj = 0; bj < 2; ++bj) { const f32x4 v0 = acc[ai][bj][m][0], v1 = acc[ai][bj][m][1];
                    const f32x2 a = gelu_pk((f32x2){v0[0], v0[1]}), b = gelu_pk((f32x2){v0[2], v0[3]}), c = gelu_pk((f32x2){v1[0], v1[1]}), d = gelu_pk((f32x2){v1[2], v1[3]});
                    s += ((a.x + a.y) + (b.x + b.y)) + ((c.x + c.y) + (d.x + d.y));
                    q += ((a.x * a.x + a.y * a.y) + (b.x * b.x + b.y * b.y)) + ((c.x * c.x + c.y * c.y) + (d.x * d.x + d.y * d.y));
                    u32x4 w; w.x = cvt_pk_bf16(a.x, a.y); w.y = cvt_pk_bf16(b.x, b.y); w.z = cvt_pk_bf16(c.x, c.y); w.w = cvt_pk_bf16(d.x, d.y);
                    *(u32x4*)(rowp + bj * HALF) = w; }
                if (isv) { s += __shfl_xor(s, 16); s += __shfl_xor(s, 32); q += __shfl_xor(q, 16); q += __shfl_xor(q, 32);
                    if (fq == 0) stat[(size_t)row * 32 + (u.pn - 8) * 4 + wc] = (f32x2){s, q}; } }
    }
};
struct EpiSwiglu {
    static constexpr bool PERM = true, AFTER_DRAIN = false;
    bf16_t* H;
    __device__ __forceinline__ void operator()(const f32x4 (&acc)[2][2][4][2], const Unit& u, int wr, int wc, int fr, int fq) const {
        const int row0 = u.pm * BM + wr * 64 + fr, col0 = u.pn * HALF + wc * 32 + 8 * fq;
#pragma unroll
        for (int ai = 0; ai < 2; ++ai)
#pragma unroll
            for (int m = 0; m < 4; ++m) { bf16_t* rowp = H + (size_t)(row0 + ai * HALF + m * 16) * 5632 + col0;
                const f32x4 g0 = acc[ai][0][m][0], g1 = acc[ai][0][m][1], u0 = acc[ai][1][m][0], u1 = acc[ai][1][m][1];
                u32x4 w; w.x = cvt_pk_bf16(silu_f(g0[0]) * u0[0], silu_f(g0[1]) * u0[1]); w.y = cvt_pk_bf16(silu_f(g0[2]) * u0[2], silu_f(g0[3]) * u0[3]);
                w.z = cvt_pk_bf16(silu_f(g1[0]) * u1[0], silu_f(g1[1]) * u1[1]); w.w = cvt_pk_bf16(silu_f(g1[2]) * u1[2], silu_f(g1[3]) * u1[3]);
                *(u32x4*)rowp = w; }
    }
};
__device__ __forceinline__ float lg2gamma(int h) {
    const double x = 1.0 / (double)(32 << h); double p = x, s = 0.0;
    const double inv[8] = {1.0, 0.5, 1.0 / 3.0, 0.25, 0.2, 1.0 / 6.0, 1.0 / 7.0, 0.125};
#pragma unroll
    for (int k = 0; k < 8; ++k) { s -= p * inv[k]; p *= x; }
    return (float)(s * 1.4426950408889634);
}
struct EpiQKVG {
    static constexpr bool PERM = true, AFTER_DRAIN = false;
    bf16_t *QH, *KH, *VB, *GS; const float* ropec; const float* ropes;
    __device__ __forceinline__ void operator()(const f32x4 (&acc)[2][2][4][2], const Unit& u, int wr, int wc, int fr, int fq) const {
        const int row0 = u.pm * BM + wr * 64 + fr, cw = wc * 32 + 8 * fq;
        if (u.pn < 16) {
            const bool isq = u.pn < 8; const int head = u.pn & 7; bf16_t* O = (isq ? QH : KH) + head * 256 + cw;
            const float lg = lg2gamma(head) * (isq ? 1.f : -1.f), sc0 = isq ? 0.0625f : 1.f;
            float invr[8];
#pragma unroll
            for (int e = 0; e < 8; ++e) invr[e] = __builtin_amdgcn_exp2f(-(float)(cw + e) * (13.287712379549449f / 128.0f)) * 0.15915494309189535f;
#pragma unroll
            for (int ai = 0; ai < 2; ++ai)
#pragma unroll
                for (int m = 0; m < 4; ++m) { const int row = row0 + ai * HALF + m * 16;
                    const int ib = row < MP ? (row & 63) : ((row - MP) & 31); const float pos = (float)(row < MP ? (row & 2047) : 4096 + ((row - MP) & 31));
                    const float sc = sc0 * __builtin_amdgcn_exp2f(lg * (float)ib);
                    f32x4 c0, c1, s0, s1;
#pragma unroll
                    for (int e = 0; e < 4; ++e) { const float r0 = __builtin_amdgcn_fractf(pos * invr[e]), r1 = __builtin_amdgcn_fractf(pos * invr[4 + e]);
                        c0[e] = __builtin_amdgcn_cosf(r0); s0[e] = __builtin_amdgcn_sinf(r0); c1[e] = __builtin_amdgcn_cosf(r1); s1[e] = __builtin_amdgcn_sinf(r1); }
                    const f32x4 a0 = acc[ai][0][m][0], a1 = acc[ai][0][m][1], b0 = acc[ai][1][m][0], b1 = acc[ai][1][m][1];
                    const f32x4 o0 = (a0 * c0 - b0 * s0) * sc, o1 = (a1 * c1 - b1 * s1) * sc, p0 = (a0 * s0 + b0 * c0) * sc, p1 = (a1 * s1 + b1 * c1) * sc;
                    u32x4 w; w.x = cvt_pk_bf16(o0[0], o0[1]); w.y = cvt_pk_bf16(o0[2], o0[3]); w.z = cvt_pk_bf16(o1[0], o1[1]); w.w = cvt_pk_bf16(o1[2], o1[3]);
                    *(u32x4*)(O + (size_t)row * 2048) = w;
                    w.x = cvt_pk_bf16(p0[0], p0[1]); w.y = cvt_pk_bf16(p0[2], p0[3]); w.z = cvt_pk_bf16(p1[0], p1[1]); w.w = cvt_pk_bf16(p1[2], p1[3]);
                    *(u32x4*)(O + (size_t)row * 2048 + HALF) = w; }
        } else {
            const bool isg = u.pn >= 32; bf16_t* O = (isg ? GS : VB) + ((u.pn - 16) & 15) * BM + cw;
#pragma unroll
            for (int ai = 0; ai < 2; ++ai)
#pragma unroll
                for (int m = 0; m < 4; ++m) { bf16_t* rowp = O + (size_t)(row0 + ai * HALF + m * 16) * 4096;
#pragma unroll
                    for (int bj = 0; bj < 2; ++bj) { f32x4 v0 = acc[ai][bj][m][0], v1 = acc[ai][bj][m][1];
                        if (isg) { v0 = (f32x4){silu_f(v0[0]), silu_f(v0[1]), silu_f(v0[2]), silu_f(v0[3])}; v1 = (f32x4){silu_f(v1[0]), silu_f(v1[1]), silu_f(v1[2]), silu_f(v1[3])}; }
                        u32x4 w; w.x = cvt_pk_bf16(v0[0], v0[1]); w.y = cvt_pk_bf16(v0[2], v0[3]); w.z = cvt_pk_bf16(v1[0], v1[1]); w.w = cvt_pk_bf16(v1[2], v1[3]);
                        *(u32x4*)(rowp + bj * HALF) = w; } }
        }
    }
};
template <class Epi, class Sched, bool ALIGN_EPI = false, bool SP2 = false>
__device__ __forceinline__ void gemm_phase(PG8_LAS unsigned char* lds, const Gemm g, const Sched& S, const Epi& E) {
    int tid_ = threadIdx.x; asm volatile("" : "+v"(tid_));
    const int tid = tid_, wid = __builtin_amdgcn_readfirstlane(tid >> 6), lane = tid & 63, wr = wid >> 2, wc = wid & 3, fr = lane & 15, fq = lane >> 4;
    const int K = g.ld;
    unsigned voffA[2], voffB[2];
#pragma unroll
    for (int i = 0; i < 2; ++i) { int R, C; stage_rc(tid * 16 + i * 8192, R, C); const int Rb = Epi::PERM ? ((R & ~31) + perm32(R & 31)) : R;
        voffA[i] = (unsigned)(R * K + C) * 2u; voffB[i] = (unsigned)(Rb * K + C) * 2u; }
    const size_t kstep = (size_t)(BK * 2);
    const size_t hstep = (size_t)HALF * K * 2;
    const size_t tstep = 2 * hstep;
    const unsigned ldsw = (unsigned)wid * 1024u;
    const int aoff = lds_byte(wr * 64 + fr, fq * 8), boff = lds_byte(wc * 32 + fr, fq * 8);
#define PG8_SA(b, h) (((b) * 2 + (h)) * HTB)
#define PG8_SB(b, h) ((4 + (b) * 2 + (h)) * HTB)
#define PG8_STAGE(bufoff, gbase, voff) do { _Pragma("unroll") for (int _i = 0; _i < 2; ++_i) \
        __builtin_amdgcn_global_load_lds((const unsigned*)((const char*)(gbase) + (voff)[_i]), (PG8_LAS unsigned*)(lds + (bufoff) + ldsw + _i * 8192), 16, 0, 0); } while (0)
#define PG8_LDA(dst, b, h) do { _Pragma("unroll") for (int m = 0; m < 4; ++m) _Pragma("unroll") for (int k = 0; k < 2; ++k) dst[m][k] = *(const PG8_LAS bf16x8*)(lds + PG8_SA(b, h) + aoff + m * 2048 + k * 1024); } while (0)
#define PG8_LDB(dst, b, h) do { _Pragma("unroll") for (int n = 0; n < 2; ++n) _Pragma("unroll") for (int k = 0; k < 2; ++k) dst[n][k] = *(const PG8_LAS bf16x8*)(lds + PG8_SB(b, h) + boff + n * 2048 + k * 1024); } while (0)
#define PG8_MMA(ai, bj, At, Bt) do { __builtin_amdgcn_s_setprio(1); _Pragma("unroll") for (int m = 0; m < 4; ++m) _Pragma("unroll") for (int n = 0; n < 2; ++n) _Pragma("unroll") for (int k = 0; k < 2; ++k) \
        acc[ai][bj][m][n] = __builtin_amdgcn_mfma_f32_16x16x32_bf16(Bt[n][k], At[m][k], acc[ai][bj][m][n], 0, 0, 0); __builtin_amdgcn_s_setprio(0); } while (0)
#define PG8_WAIT_V(n) asm volatile("s_waitcnt vmcnt(" #n ")" ::: "memory")
#define PG8_WAIT_L(n) asm volatile("s_waitcnt lgkmcnt(" #n ")" ::: "memory")
#define PG8_BAR __builtin_amdgcn_s_barrier()
#define PG8_SCHED __builtin_amdgcn_sched_barrier(0)
    Unit cur, nxt; int ui = 0;
    if (!S.next(0, cur)) return;
    f32x4 acc[2][2][4][2];
#pragma unroll
    for (int a = 0; a < 2; ++a)
#pragma unroll
        for (int b = 0; b < 2; ++b)
#pragma unroll
            for (int m = 0; m < 4; ++m)
#pragma unroll
                for (int n = 0; n < 2; ++n) acc[a][b][m][n] = (f32x4){0.f, 0.f, 0.f, 0.f};
    bf16x8 At[4][2], B0[2][2], B1[2][2];
    const char* cA = (const char*)g.A + (size_t)cur.pm * tstep + (size_t)cur.k0 * 2; const char* cB = (const char*)g.Bt + (size_t)cur.pn * tstep + (size_t)cur.k0 * 2; int nt = cur.nt;
    S.a_ready(cur);
    if constexpr (SP2) {
        PG8_STAGE(PG8_SB(0, 0), cB, voffB); PG8_STAGE(PG8_SB(0, 1), cB + hstep, voffB); PG8_STAGE(PG8_SA(0, 0), cA, voffA); PG8_STAGE(PG8_SA(0, 1), cA + hstep, voffA);
        if (wr == 1) PG8_BAR;
        PG8_WAIT_V(2); PG8_BAR;
        PG8_STAGE(PG8_SB(1, 0), cB + kstep, voffB); PG8_STAGE(PG8_SA(1, 0), cA + kstep, voffA); PG8_STAGE(PG8_SB(1, 1), cB + hstep + kstep, voffB);
        PG8_WAIT_V(6); PG8_BAR;
    } else {
        PG8_STAGE(PG8_SB(0, 0), cB, voffB); PG8_STAGE(PG8_SA(0, 0), cA, voffA); PG8_STAGE(PG8_SB(0, 1), cB + hstep, voffB); PG8_STAGE(PG8_SA(0, 1), cA + hstep, voffA);
        if (wr == 1) PG8_BAR;
        PG8_WAIT_V(4); PG8_BAR;
        PG8_STAGE(PG8_SB(1, 0), cB + kstep, voffB); PG8_STAGE(PG8_SA(1, 0), cA + kstep, voffA); PG8_STAGE(PG8_SB(1, 1), cB + hstep + kstep, voffB);
        PG8_WAIT_V(6); PG8_BAR;
    }
    for (;;) {
        const bool has_next = S.next(ui + 1, nxt);
        const char* nA = has_next ? (const char*)g.A + (size_t)nxt.pm * tstep + (size_t)nxt.k0 * 2 : cA; const char* nB = has_next ? (const char*)g.Bt + (size_t)nxt.pn * tstep + (size_t)nxt.k0 * 2 : cB;
        for (int t = 0; t < nt; t += 2) {
            const bool last = (t == nt - 2);
            const char* a1 = cA + (size_t)(t + 1) * kstep;
            const char* a2 = last ? nA : cA + (size_t)(t + 2) * kstep; const char* b2 = last ? nB : cB + (size_t)(t + 2) * kstep;
            const char* a3 = a2 + kstep; const char* b3 = b2 + kstep;
            if (last && has_next) S.a_ready(nxt);
            if constexpr (SP2) {
            PG8_LDB(B0, 0, 0); PG8_LDB(B1, 0, 1); PG8_SCHED; PG8_LDA(At, 0, 0); PG8_STAGE(PG8_SA(1, 1), a1 + hstep, voffA);
            PG8_WAIT_V(8); PG8_WAIT_L(0); PG8_BAR; PG8_MMA(0, 0, At, B0); PG8_MMA(0, 1, At, B1); PG8_BAR; PG8_SCHED;
            PG8_LDA(At, 0, 1); PG8_STAGE(PG8_SB(0, 0), b2, voffB); PG8_STAGE(PG8_SB(0, 1), b2 + hstep, voffB); PG8_STAGE(PG8_SA(0, 0), a2, voffA);
            PG8_WAIT_V(8); PG8_WAIT_L(0); PG8_BAR; PG8_MMA(1, 0, At, B0); PG8_MMA(1, 1, At, B1); PG8_BAR; PG8_SCHED;
            PG8_LDB(B0, 1, 0); PG8_LDB(B1, 1, 1); PG8_SCHED; PG8_LDA(At, 1, 0); PG8_STAGE(PG8_SA(0, 1), a2 + hstep, voffA);
            PG8_WAIT_V(8); PG8_WAIT_L(0); PG8_BAR; PG8_MMA(0, 0, At, B0); PG8_MMA(0, 1, At, B1); PG8_BAR; PG8_SCHED;
            PG8_LDA(At, 1, 1); PG8_STAGE(PG8_SB(1, 0), b3, voffB); PG8_STAGE(PG8_SB(1, 1), b3 + hstep, voffB); PG8_STAGE(PG8_SA(1, 0), a3, voffA);
            PG8_WAIT_V(8); PG8_WAIT_L(0); PG8_BAR; PG8_MMA(1, 0, At, B0); PG8_MMA(1, 1, At, B1); PG8_BAR; PG8_SCHED;
            } else {
            PG8_LDB(B0, 0, 0); PG8_SCHED; PG8_LDA(At, 0, 0); PG8_STAGE(PG8_SA(1, 1), a1 + hstep, voffA);
            PG8_WAIT_L(8); PG8_BAR; PG8_WAIT_L(0); PG8_MMA(0, 0, At, B0); PG8_BAR; PG8_SCHED;
            PG8_LDB(B1, 0, 1); PG8_STAGE(PG8_SB(0, 0), b2, voffB);
            PG8_BAR; PG8_WAIT_L(0); PG8_MMA(0, 1, At, B1); PG8_BAR;
            PG8_LDA(At, 0, 1); PG8_STAGE(PG8_SA(0, 0), a2, voffA);
            PG8_BAR; PG8_WAIT_L(0); PG8_MMA(1, 0, At, B0); PG8_BAR; PG8_SCHED;
            PG8_STAGE(PG8_SB(0, 1), b2 + hstep, voffB);
            PG8_WAIT_V(6); PG8_BAR; PG8_MMA(1, 1, At, B1); PG8_BAR;
            PG8_LDB(B0, 1, 0); PG8_SCHED; PG8_LDA(At, 1, 0); PG8_STAGE(PG8_SA(0, 1), a2 + hstep, voffA);
            PG8_WAIT_L(8); PG8_BAR; PG8_WAIT_L(0); PG8_MMA(0, 0, At, B0); PG8_BAR; PG8_SCHED;
            PG8_LDB(B1, 1, 1); PG8_STAGE(PG8_SB(1, 0), b3, voffB);
            PG8_BAR; PG8_WAIT_L(0); PG8_MMA(0, 1, At, B1); PG8_BAR;
            PG8_LDA(At, 1, 1); PG8_STAGE(PG8_SA(1, 0), a3, voffA);
            PG8_BAR; PG8_WAIT_L(0); PG8_MMA(1, 0, At, B0); PG8_BAR; PG8_SCHED;
            PG8_STAGE(PG8_SB(1, 1), b3 + hstep, voffB);
            PG8_WAIT_V(6); PG8_BAR; PG8_MMA(1, 1, At, B1); PG8_BAR;
            }
        }
        if constexpr (ALIGN_EPI) { if (wr == 0) PG8_BAR; }
        if constexpr (!Epi::AFTER_DRAIN) { E(acc, cur, wr, wc, fr, fq); S.done(cur); }
        if (!has_next) break;
#pragma unroll
        for (int a = 0; a < 2; ++a)
#pragma unroll
            for (int b = 0; b < 2; ++b)
#pragma unroll
                for (int m = 0; m < 4; ++m)
#pragma unroll
                    for (int n = 0; n < 2; ++n) acc[a][b][m][n] = (f32x4){0.f, 0.f, 0.f, 0.f};
        cur = nxt; cA = nA; cB = nB; nt = cur.nt; ++ui;
        if constexpr (ALIGN_EPI) { if (wr == 1) PG8_BAR; }
    }
    PG8_WAIT_V(0);
    if constexpr (!ALIGN_EPI) { if (wr == 0) PG8_BAR; }
    PG8_BAR;
    if constexpr (Epi::AFTER_DRAIN) { E.fused(acc, cur, wr, wc, fr, fq, lds, wid, lane); S.done(cur); }
#undef PG8_SA
#undef PG8_SB
#undef PG8_STAGE
#undef PG8_LDA
#undef PG8_LDB
#undef PG8_MMA
#undef PG8_WAIT_V
#undef PG8_WAIT_L
#undef PG8_BAR
#undef PG8_SCHED
}
}
constexpr size_t MiB = 1u << 20;
constexpr size_t WS_WAIN = 0, WS_WAOUT = 16 * MiB, WS_WBIN = 24 * MiB, WS_WBOUT = 72 * MiB, WS_WFIN = 88 * MiB, WS_WFOUT = 176 * MiB;
constexpr size_t WS_XB = 220 * MiB;
constexpr size_t WS_STAT = 256 * MiB;
constexpr size_t WS_ROPE = 259 * MiB;
constexpr size_t WS_YP = 262 * MiB;
constexpr size_t WS_XF = 390 * MiB;
constexpr size_t WS_R1 = 462 * MiB;
constexpr size_t WS_CTL = 678 * MiB, CTL_BYTES = 16384;
constexpr size_t WS_END = 679 * MiB;
constexpr int MISC_OFF = 131072 + 320;
constexpr int LDS_BYTES = 147456;
constexpr int NW = 8;

#define LAS __attribute__((address_space(3)))
typedef unsigned short bf16;
typedef unsigned u32x4 __attribute__((ext_vector_type(4)));
typedef unsigned u32x2 __attribute__((ext_vector_type(2)));
typedef float f32x4 __attribute__((ext_vector_type(4)));
typedef float f32x2 __attribute__((ext_vector_type(2)));
typedef short bf16x8 __attribute__((ext_vector_type(8)));
typedef short s16x4 __attribute__((ext_vector_type(4)));
#define LDS_WAIT() asm volatile("s_waitcnt lgkmcnt(0)" ::: "memory")
__device__ __forceinline__ unsigned pk2(float lo, float hi) { return pg8::cvt_pk_bf16(lo, hi); }
__device__ __forceinline__ float bf_lo(unsigned w) { return __uint_as_float(w << 16); }
__device__ __forceinline__ float bf_hi(unsigned w) { return __uint_as_float(w & 0xffff0000u); }
__device__ __forceinline__ float wave_sum(float v) {
#pragma unroll
    for (int o = 1; o < 64; o <<= 1) v += __shfl_xor(v, o);
    return v;
}

struct Args { const float* in[17]; float* out; unsigned char* ws; };

template <int MAPMODE>
__device__ __forceinline__ void p0_transpose_item(const float* W, int K, int N, bf16* WT, LAS float* scr, int item, int lane) {
    const int nblk = N / 32, kb = item / nblk, nb = item % nblk, k0 = 64 * kb, n0 = 32 * nb;
#pragma unroll 8
    for (int i = 0; i < 32; ++i) { const int kk = 2 * i + (lane >> 5); scr[kk * 33 + (lane & 31)] = __builtin_nontemporal_load(W + (size_t)(k0 + kk) * N + n0 + (lane & 31)); }
    LDS_WAIT(); asm volatile("" ::: "memory");
    int r0 = n0;
    if (MAPMODE == 1) { const int up = n0 >= FF ? 1 : 0, c = n0 - up * FF; r0 = 256 * (c >> 7) + (c & 127) + 128 * up; }
    const int c8 = lane & 7;
#pragma unroll
    for (int j = 0; j < 4; ++j) { const int n = (lane >> 3) + 8 * j; const LAS float* s = scr + (8 * c8) * 33 + n;
        u32x4 o; o.x = pk2(s[0 * 33], s[1 * 33]); o.y = pk2(s[2 * 33], s[3 * 33]); o.z = pk2(s[4 * 33], s[5 * 33]); o.w = pk2(s[6 * 33], s[7 * 33]);
        *(u32x4*)(WT + (size_t)(r0 + n) * K + k0 + 8 * c8) = o; }
    LDS_WAIT(); asm volatile("" ::: "memory");
}
__device__ __forceinline__ void convert_list(const Args& a, LAS unsigned char* lds, int list, int w, int nw, int wave, int lane) {
    LAS float* scr = (LAS float*)(lds + wave * 16384);
    unsigned char* ws = a.ws;
    constexpr int I0 = 32 * 128, I1 = 32 * 64, I2 = 32 * 384, I3 = 64 * 64, I4 = 32 * 352, I5 = 88 * 64;
    if (list == 0) {
        for (int r = w; r < I0; r += nw) p0_transpose_item<0>(a.in[3], 2048, 4096, (bf16*)(ws + WS_WAIN), scr, r, lane);
    } else if (list == 1) {
        for (int it = w; it < I1 + I4 + I5; it += nw) { int r = it;
            if (r < I1) { p0_transpose_item<0>(a.in[8], 2048, 2048, (bf16*)(ws + WS_WAOUT), scr, r, lane); continue; } r -= I1;
            if (r < I4) { p0_transpose_item<1>(a.in[11], 2048, 11264, (bf16*)(ws + WS_WFIN), scr, r, lane); continue; } r -= I4;
            p0_transpose_item<0>(a.in[12], 5632, 2048, (bf16*)(ws + WS_WFOUT), scr, r, lane); }
    } else if (list == 2) {
        for (int it = w; it < I2 + I4; it += nw) { int r = it;
            if (r < I2) { p0_transpose_item<0>(a.in[9], 2048, 12288, (bf16*)(ws + WS_WBIN), scr, r, lane); continue; } r -= I2;
            p0_transpose_item<1>(a.in[11] + (size_t)2048 * 11264, 2048, 11264, (bf16*)(ws + WS_WFIN + 44 * MiB), scr, r, lane); }
    } else if (list == 3) {
        for (int r = w; r < I3; r += nw) p0_transpose_item<0>(a.in[10], 4096, 2048, (bf16*)(ws + WS_WBOUT), scr, r, lane);
    } else {
        for (int r = w; r < I5; r += nw) p0_transpose_item<0>(a.in[12] + (size_t)5632 * 2048, 5632, 2048, (bf16*)(ws + WS_WFOUT + 22 * MiB), scr, r, lane);
    }
}
__device__ __forceinline__ void p0_prologue(const Args& a, LAS unsigned char* lds, int gw, int NGW, int wave, int lane) {
    unsigned char* ws = a.ws;
    convert_list(a, lds, 0, gw, NGW, wave, lane);
    bf16* XB = (bf16*)(ws + WS_XB);
    for (int m = gw; m < MT; m += NGW) {
        const f32x4* xr = (const f32x4*)(m < MP ? a.in[0] + (size_t)m * DM : a.in[1] + (size_t)(m - MP) * DM) + lane;
        u32x2* o = (u32x2*)(XB + (size_t)m * DM) + lane;
#pragma unroll
        for (int j = 0; j < 8; ++j) { const f32x4 v = xr[64 * j]; u32x2 w; w.x = pk2(v[0], v[1]); w.y = pk2(v[2], v[3]); o[64 * j] = w; }
    }
}

struct LnIO { const float* xres_p; const float* xres_s; const bf16* xb; const float* YP; const float* g; const float* b; float* outf; bf16* outb; };
__device__ __forceinline__ void ln_load(const LnIO& io, f32x4 (&v)[8], int row, int lane) {
    if (io.xres_p) { const f32x4* xr = (const f32x4*)(row < MP ? io.xres_p + (size_t)row * DM : io.xres_s + (size_t)(row - MP) * DM) + lane;
#pragma unroll
        for (int j = 0; j < 8; ++j) v[j] = xr[64 * j] * ALPHA;
    } else { const u32x2* xr = (const u32x2*)(io.xb + (size_t)row * DM) + lane;
#pragma unroll
        for (int j = 0; j < 8; ++j) { const u32x2 w = xr[64 * j]; v[j] = (f32x4){bf_lo(w.x), bf_hi(w.x), bf_lo(w.y), bf_hi(w.y)} * ALPHA; } }
    if (row < MP) { const u32x2* y = (const u32x2*)((const bf16*)io.YP + (size_t)row * DM) + lane;
#pragma unroll
        for (int j = 0; j < 8; ++j) { const u32x2 w = y[64 * j]; v[j] += (f32x4){bf_lo(w.x), bf_hi(w.x), bf_lo(w.y), bf_hi(w.y)}; }
    } else {
#pragma unroll 2
        for (int ks = 0; ks < 8; ++ks) { const u32x2* y = (const u32x2*)((const bf16*)io.YP + (size_t)(MP + ks * MS + (row - MP)) * DM) + lane;
#pragma unroll
            for (int j = 0; j < 8; ++j) { const u32x2 w = y[64 * j]; v[j] += (f32x4){bf_lo(w.x), bf_hi(w.x), bf_lo(w.y), bf_hi(w.y)}; } }
    }
}
__device__ __forceinline__ void ln_finish(const LnIO& io, f32x4 (&v)[8], int row, int lane) {
    float s = 0.f;
#pragma unroll
    for (int j = 0; j < 8; ++j) s += (v[j][0] + v[j][1]) + (v[j][2] + v[j][3]);
    const float mean = wave_sum(s) * (1.f / DM); float q = 0.f;
#pragma unroll
    for (int j = 0; j < 8; ++j) { v[j] = v[j] - mean; q += (v[j][0] * v[j][0] + v[j][1] * v[j][1]) + (v[j][2] * v[j][2] + v[j][3] * v[j][3]); }
    const float rstd = 1.0f / sqrtf(wave_sum(q) * (1.f / DM) + LN_EPS);
#pragma unroll
    for (int j = 0; j < 8; ++j) { const f32x4 gg = ((const f32x4*)io.g)[lane + 64 * j], bb = ((const f32x4*)io.b)[lane + 64 * j]; const f32x4 o = v[j] * rstd * gg + bb;
        if (io.outf) __builtin_nontemporal_store(o, (f32x4*)(io.outf + (size_t)row * DM) + lane + 64 * j);
        if (io.outb) { u32x2 w; w.x = pk2(o[0], o[1]); w.y = pk2(o[2], o[3]); ((u32x2*)(io.outb + (size_t)row * DM) + lane)[64 * j] = w; } }
}
__device__ __forceinline__ void ln_pair(const LnIO& io, int r0, int r1, int lane) { f32x4 va[8], vb[8]; ln_load(io, va, r0, lane); ln_load(io, vb, r1, lane); ln_finish(io, va, r0, lane); ln_finish(io, vb, r1, lane); }
__device__ __forceinline__ void ln_one(const LnIO& io, int r0, int lane) { f32x4 va[8]; ln_load(io, va, r0, lane); ln_finish(io, va, r0, lane); }
__device__ __forceinline__ void ln_pass(const float* xres_p, const float* xres_s, const bf16* xb, const float* YP, const float* g, const float* b, float* outf, bf16* outb, int gw, int NGW, int lane) {
    const LnIO io{xres_p, xres_s, xb, YP, g, b, outf, outb};
    if (NGW == 2048) {
        if (gw < 1024) { ln_one(io, MP + gw, lane); ln_pair(io, gw, gw + 1024, lane); }
        else { const int r = 2048 + (gw - 1024); ln_pair(io, r, r + 1024, lane); ln_pair(io, r + 2048, r + 3072, lane); ln_pair(io, r + 4096, r + 5120, lane); }
    } else {
        for (int row = gw; row < MT; row += NGW) ln_one(io, row, lane);
    }
}

__device__ __forceinline__ bf16x8 frag_plain(const LAS bf16* X, int ld, int r0, int k0, int lane) { return *(const LAS bf16x8*)(X + (r0 + (lane & 15)) * ld + k0 + 8 * (lane >> 4)); }
typedef short v4i16_t __attribute__((ext_vector_type(4)));
__device__ __forceinline__ bf16x8 frag_tr(const LAS bf16* Y, int ld, int kr0, int c0, int lane) {
    const int i = lane & 15, g4 = lane >> 4; const LAS bf16* p = Y + (kr0 + 8 * g4 + (i >> 2)) * ld + c0 + 4 * (i & 3);
    const v4i16_t lo = __builtin_amdgcn_ds_read_tr16_b64_v4i16((LAS v4i16_t*)p), hi = __builtin_amdgcn_ds_read_tr16_b64_v4i16((LAS v4i16_t*)(p + 4 * ld));
    return (bf16x8){lo[0], lo[1], lo[2], lo[3], hi[0], hi[1], hi[2], hi[3]};
}
#define MFMA16(a, b, c) __builtin_amdgcn_mfma_f32_16x16x32_bf16((a), (b), (c), 0, 0, 0)

template <int Q>
__device__ __forceinline__ void mix_item(const Args& a, LAS unsigned char* lds, int rb, int g, int cq, int wave, int lane) {
    constexpr int NCT = 16 / Q, NV = 8 / Q;
    const int tid = threadIdx.x;
    LAS bf16* Wm = (LAS bf16*)lds;
    LAS bf16* vn = (LAS bf16*)(lds + 34816);
    LAS f32x2* mr = (LAS f32x2*)(lds + 34816 + 67584);
    const bf16* U = (const bf16*)(a.ws + WS_R1); const bf16* V = U + (size_t)MT * DM; bf16* SB = (bf16*)(a.ws + WS_R1 + 72 * MiB);
    const f32x2* stat = (const f32x2*)(a.ws + WS_STAT);
    const float* lng = a.in[4]; const float* lnb = a.in[5]; const float* aws = a.in[6]; const float* abs_ = a.in[7];
    float* gv = a.out + (size_t)MT * DM + (size_t)(4 + 32) * 8 * 256 * 512;
    const int row0 = rb * 128, cbase = g * 256 + cq * (256 / Q); const bool smp = rb >= 64;
    const int wt = tid >> 2, ws0 = (tid & 3) * 32, wtw = smp ? (wt & 31) : wt;
    f32x4 wreg[8];
#pragma unroll
    for (int k = 0; k < 4; ++k) { const int sw = smp ? ((ws0 + 8 * k) & 31) : (ws0 + 8 * k); const float* wp = aws + ((size_t)g * 128 + wtw) * 128 + sw; wreg[2 * k] = *(const f32x4*)wp; wreg[2 * k + 1] = *(const f32x4*)(wp + 4); }
    const int vs_ = tid >> 2, vcb = (tid & 3) * (64 / Q); const bf16* vp = V + (size_t)(row0 + vs_) * DM + cbase + vcb;
    u32x4 vreg[NV];
#pragma unroll
    for (int k = 0; k < NV; ++k) vreg[k] = *(const u32x4*)(vp + 8 * k);
    const int t0 = 16 * wave, i = lane & 15, g4 = lane >> 4, t = t0 + i, row = row0 + t;
    u32x2 ureg[NCT];
#pragma unroll
    for (int ct = 0; ct < NCT; ++ct) ureg[ct] = *(const u32x2*)(U + (size_t)row * DM + cbase + 16 * ct + 4 * g4);
    const float bias = abs_[g * 128 + (smp ? (t & 31) : t)];
    if (tid < 128) { const f32x4* sp = (const f32x4*)(stat + (size_t)(row0 + tid) * 32); float s_ = 0.f, q_ = 0.f;
#pragma unroll
        for (int k = 0; k < 16; ++k) { const f32x4 v = sp[k]; s_ += v[0] + v[2]; q_ += v[1] + v[3]; }
        const float mean = s_ * (1.f / 2048.f), var = q_ * (1.f / 2048.f) - mean * mean; mr[tid] = (f32x2){mean, 1.0f / sqrtf(var + LN_EPS)}; }
#pragma unroll
    for (int k = 0; k < 4; ++k) { const int s0 = ws0 + 8 * k; const f32x4 w0 = wreg[2 * k], w1 = wreg[2 * k + 1];
        float w[8] = {w0[0], w0[1], w0[2], w0[3], w1[0], w1[1], w1[2], w1[3]};
#pragma unroll
        for (int e = 0; e < 8; ++e) { const int ss = s0 + e; const bool ok = smp ? ((ss >> 5) == (wt >> 5) && (ss & 31) <= (wt & 31)) : (ss <= wt); w[e] = ok ? w[e] : 0.f; }
        u32x4 o; o.x = pk2(w[0], w[1]); o.y = pk2(w[2], w[3]); o.z = pk2(w[4], w[5]); o.w = pk2(w[6], w[7]);
        *(LAS u32x4*)(Wm + wt * 136 + s0) = o; }
    __syncthreads();
    { const f32x2 m = mr[vs_];
#pragma unroll
        for (int k = 0; k < NV; ++k) { const u32x4 w = vreg[k]; const int c = cbase + vcb + 8 * k;
            const f32x4 g0 = *(const f32x4*)(lng + c), g1 = *(const f32x4*)(lng + c + 4), b0 = *(const f32x4*)(lnb + c), b1 = *(const f32x4*)(lnb + c + 4);
            f32x4 x0 = (f32x4){bf_lo(w.x), bf_hi(w.x), bf_lo(w.y), bf_hi(w.y)}, x1 = (f32x4){bf_lo(w.z), bf_hi(w.z), bf_lo(w.w), bf_hi(w.w)};
            x0 = (x0 - m.x) * m.y * g0 + b0; x1 = (x1 - m.x) * m.y * g1 + b1;
            u32x4 o; o.x = pk2(x0[0], x0[1]); o.y = pk2(x0[2], x0[3]); o.z = pk2(x1[0], x1[1]); o.w = pk2(x1[2], x1[3]);
            *(LAS u32x4*)(vn + vs_ * 264 + vcb + 8 * k) = o;
            if (smp) { float* op = gv + (size_t)(row0 + vs_ - MP) * DM + c; __builtin_nontemporal_store(x0, (f32x4*)op); __builtin_nontemporal_store(x1, (f32x4*)(op + 4)); } } }
    __syncthreads();
    {
        f32x4 acc[NCT];
#pragma unroll
        for (int ct = 0; ct < NCT; ++ct) acc[ct] = (f32x4){0.f, 0.f, 0.f, 0.f};
        const int kmax = (t0 + 15) >> 5;
        for (int kk = 0; kk <= kmax; ++kk) { const bf16x8 bw = frag_plain(Wm, 136, t0, 32 * kk, lane);
#pragma unroll
            for (int ct = 0; ct < NCT; ++ct) { const bf16x8 av = frag_tr(vn, 264, 32 * kk, 16 * ct, lane); acc[ct] = MFMA16(av, bw, acc[ct]); } }
#pragma unroll
        for (int ct = 0; ct < NCT; ++ct) { const size_t off = (size_t)row * DM + cbase + 16 * ct + 4 * g4; const u32x2 uu = ureg[ct];
            u32x2 o; o.x = pk2(bf_lo(uu.x) * (acc[ct][0] + bias), bf_hi(uu.x) * (acc[ct][1] + bias)); o.y = pk2(bf_lo(uu.y) * (acc[ct][2] + bias), bf_hi(uu.y) * (acc[ct][3] + bias));
            *(u32x2*)(SB + off) = o; }
    }
    __syncthreads();
}
__device__ __forceinline__ void mix_phase(const Args& a, LAS unsigned char* lds, int wave, int lane) {
    for (int item = blockIdx.x; item < 64 * 8; item += gridDim.x) mix_item<1>(a, lds, item >> 3, item & 7, 0, wave, lane);
    for (int item = blockIdx.x; item < 8 * 8 * 4; item += gridDim.x) mix_item<4>(a, lds, 64 + (item >> 5), (item >> 2) & 7, item & 3, wave, lane);
}
constexpr int R_QS = 0, R_KS = 33792, R_VS = 67584, R_PS = 76800, R_RT = 86016, R_OS = 119808;
template <int L>
__device__ __forceinline__ void ret_run(LAS unsigned char* lds, const bf16* QH, const bf16* KH, const bf16* VB, bf16* OB, int grow0, int nblk, int h, int slice, const float* S0, float* Sout, int wave, int lane) {
    const int tid = threadIdx.x, i = lane & 15, g4 = lane >> 4;
    LAS bf16* qs = (LAS bf16*)(lds + R_QS); LAS bf16* ks = (LAS bf16*)(lds + R_KS); LAS bf16* vs = (LAS bf16*)(lds + R_VS);
    LAS bf16* ps = (LAS bf16*)(lds + R_PS); LAS bf16* rts = (LAS bf16*)(lds + R_RT); LAS bf16* os = (LAS bf16*)(lds + R_OS);
    const float lg = pg8::lg2gamma(h);
    const float gL = __builtin_amdgcn_exp2f(lg * (float)L), gLm1 = __builtin_amdgcn_exp2f(lg * (float)(L - 1)), gLm1i = __builtin_amdgcn_exp2f(-lg * (float)(L - 1));
    constexpr int NQ = L / 16, NT = L / 32, NKK = L / 32;
    const bool vthr = (L == 64) || tid < 256;
    u32x4 pq[NQ], pk[NQ], pv;
#define RET_GLOAD(blk) do { const int r0_ = grow0 + (blk) * L; _Pragma("unroll") for (int k_ = 0; k_ < NQ; ++k_) { const int e_ = tid + 512 * k_, row_ = e_ >> 5, ch_ = e_ & 31; \
        pq[k_] = *(const u32x4*)(QH + (size_t)(r0_ + row_) * 2048 + h * 256 + ch_ * 8); pk[k_] = *(const u32x4*)(KH + (size_t)(r0_ + row_) * 2048 + h * 256 + ch_ * 8); } \
        if (vthr) pv = *(const u32x4*)(VB + (size_t)(r0_ + (tid >> 3)) * 4096 + h * 512 + slice * 64 + (tid & 7) * 8); } while (0)
#define RET_LSTORE() do { _Pragma("unroll") for (int k_ = 0; k_ < NQ; ++k_) { const int e_ = tid + 512 * k_, row_ = e_ >> 5, ch_ = e_ & 31; \
        *(LAS u32x4*)(qs + row_ * 264 + ch_ * 8) = pq[k_]; *(LAS u32x4*)(ks + row_ * 264 + ch_ * 8) = pk[k_]; } \
        if (vthr) *(LAS u32x4*)(vs + (tid >> 3) * 72 + (tid & 7) * 8) = pv; } while (0)
    f32x4 R[2][4];
    RET_GLOAD(0);
#pragma unroll
    for (int a2 = 0; a2 < 2; ++a2)
#pragma unroll
        for (int d = 0; d < 4; ++d) {
            if (S0) {
#pragma unroll
                for (int e = 0; e < 4; ++e) R[a2][d][e] = S0[(size_t)(32 * wave + 16 * a2 + 4 * g4 + e) * 512 + slice * 64 + 16 * d + i] * gLm1i;
            } else R[a2][d] = (f32x4){0.f, 0.f, 0.f, 0.f};
            u32x2 w; w.x = pk2(R[a2][d][0], R[a2][d][1]); w.y = pk2(R[a2][d][2], R[a2][d][3]);
            *(LAS u32x2*)(rts + (16 * d + i) * 264 + 32 * wave + 16 * a2 + 4 * g4) = w; }
    RET_LSTORE();
    __syncthreads();
    const int it = (L == 64) ? (wave >> 1) : (wave >> 2);
    for (int n = 0; n < nblk; ++n) {
        if (n + 1 < nblk) RET_GLOAD(n + 1);
        bf16x8 qf[8];
#pragma unroll
        for (int kk = 0; kk < 8; ++kk) qf[kk] = frag_plain(qs, 264, 16 * it, 32 * kk, lane);
        if (L == 64 || wave < 4) {
#pragma unroll
            for (int tp = 0; tp < NT; ++tp) { const int i0 = 16 * (wave >> 1), j0 = (L == 64) ? 16 * (2 * (wave & 1) + tp) : 16 * (wave & 1);
                f32x4 acc = (f32x4){0.f, 0.f, 0.f, 0.f};
#pragma unroll
                for (int kk = 0; kk < 8; ++kk) acc = MFMA16(frag_plain(ks, 264, j0, 32 * kk, lane), (L == 64) ? qf[kk] : frag_plain(qs, 264, i0, 32 * kk, lane), acc);
#pragma unroll
                for (int e = 0; e < 4; ++e) acc[e] = (j0 + 4 * g4 + e <= i0 + i) ? acc[e] : 0.f;
                u32x2 w; w.x = pk2(acc[0], acc[1]); w.y = pk2(acc[2], acc[3]); *(LAS u32x2*)(ps + (i0 + i) * 72 + j0 + 4 * g4) = w; }
        }
        f32x4 oacc[NT];
#pragma unroll
        for (int tp = 0; tp < NT; ++tp) { const int dv0 = (L == 64) ? 16 * (2 * (wave & 1) + tp) : 16 * (wave & 3);
            f32x4 acc = (f32x4){0.f, 0.f, 0.f, 0.f};
#pragma unroll
            for (int kk = 0; kk < 8; ++kk) acc = MFMA16(frag_plain(rts, 264, dv0, 32 * kk, lane), qf[kk], acc);
            oacc[tp] = acc * gL; }
        __syncthreads();
#pragma unroll
        for (int tp = 0; tp < NT; ++tp) { const int dv0 = (L == 64) ? 16 * (2 * (wave & 1) + tp) : 16 * (wave & 3);
#pragma unroll
            for (int kk = 0; kk < NKK; ++kk) oacc[tp] = MFMA16(frag_tr(vs, 72, 32 * kk, dv0, lane), frag_plain(ps, 72, 16 * it, 32 * kk, lane), oacc[tp]);
            u32x2 w; w.x = pk2(oacc[tp][0], oacc[tp][1]); w.y = pk2(oacc[tp][2], oacc[tp][3]); *(LAS u32x2*)(os + (16 * it + i) * 72 + dv0 + 4 * g4) = w; }
#pragma unroll
        for (int a2 = 0; a2 < 2; ++a2)
#pragma unroll
            for (int d = 0; d < 4; ++d) R[a2][d] = R[a2][d] * gL;
#pragma unroll
        for (int kk = 0; kk < NKK; ++kk) { bf16x8 bv[4];
#pragma unroll
            for (int d = 0; d < 4; ++d) bv[d] = frag_tr(vs, 72, 32 * kk, 16 * d, lane);
#pragma unroll
            for (int a2 = 0; a2 < 2; ++a2) { const bf16x8 av = frag_tr(ks, 264, 32 * kk, 32 * wave + 16 * a2, lane);
#pragma unroll
                for (int d = 0; d < 4; ++d) R[a2][d] = MFMA16(av, bv[d], R[a2][d]); } }
        __syncthreads();
#pragma unroll
        for (int a2 = 0; a2 < 2; ++a2)
#pragma unroll
            for (int d = 0; d < 4; ++d) { u32x2 w; w.x = pk2(R[a2][d][0], R[a2][d][1]); w.y = pk2(R[a2][d][2], R[a2][d][3]);
                *(LAS u32x2*)(rts + (16 * d + i) * 264 + 32 * wave + 16 * a2 + 4 * g4) = w; }
        if (vthr) *(u32x4*)(OB + (size_t)(grow0 + n * L + (tid >> 3)) * 4096 + h * 512 + slice * 64 + (tid & 7) * 8) = *(const LAS u32x4*)(os + (tid >> 3) * 72 + (tid & 7) * 8);
        if (n + 1 < nblk) RET_LSTORE();
        __syncthreads();
    }
#pragma unroll
    for (int a2 = 0; a2 < 2; ++a2)
#pragma unroll
        for (int d = 0; d < 4; ++d)
#pragma unroll
            for (int e = 0; e < 4; ++e) __builtin_nontemporal_store(R[a2][d][e] * gLm1, Sout + (size_t)(32 * wave + 16 * a2 + 4 * g4 + e) * 512 + slice * 64 + 16 * d + i);
#undef RET_GLOAD
#undef RET_LSTORE
}

constexpr int S_QS = 0, S_KS = 16896, S_PS = 33792, S_RT = 38400, S_VS = 105984, S_OS = 115200;
__device__ __forceinline__ void ret_sample(LAS unsigned char* lds, const bf16* QH, const bf16* KH, const bf16* VB, bf16* OB, int grow0, int h, const float* S0, float* Sout, int wave, int lane) {
    const int tid = threadIdx.x, i = lane & 15, g4 = lane >> 4;
    LAS bf16* qs = (LAS bf16*)(lds + S_QS); LAS bf16* ks = (LAS bf16*)(lds + S_KS); LAS bf16* ps = (LAS bf16*)(lds + S_PS);
    const float lg = pg8::lg2gamma(h);
    const float gL = __builtin_amdgcn_exp2f(lg * 32.f), gLm1 = __builtin_amdgcn_exp2f(lg * 31.f), gLm1i = __builtin_amdgcn_exp2f(-lg * 31.f);
    const bool vthr = tid < 256;
#pragma unroll
    for (int k = 0; k < 2; ++k) { const int e = tid + 512 * k, row = e >> 5, ch = e & 31;
        *(LAS u32x4*)(qs + row * 264 + ch * 8) = *(const u32x4*)(QH + (size_t)(grow0 + row) * 2048 + h * 256 + ch * 8);
        *(LAS u32x4*)(ks + row * 264 + ch * 8) = *(const u32x4*)(KH + (size_t)(grow0 + row) * 2048 + h * 256 + ch * 8); }
    f32x4 Rn[2][4]; u32x4 vn = (u32x4){0u, 0u, 0u, 0u};
#define SMP_PREFETCH(sl) do { _Pragma("unroll") for (int a2 = 0; a2 < 2; ++a2) _Pragma("unroll") for (int d = 0; d < 4; ++d) _Pragma("unroll") for (int e = 0; e < 4; ++e) \
        Rn[a2][d][e] = __builtin_nontemporal_load(S0 + (size_t)(32 * wave + 16 * a2 + 4 * g4 + e) * 512 + (sl) * 64 + 16 * d + i); \
        if (vthr) vn = *(const u32x4*)(VB + (size_t)(grow0 + (tid >> 3)) * 4096 + h * 512 + (sl) * 64 + (tid & 7) * 8); } while (0)
    SMP_PREFETCH(0);
    __syncthreads();
    if (wave < 4) {
        const int i0 = 16 * (wave >> 1), j0 = 16 * (wave & 1); f32x4 acc = (f32x4){0.f, 0.f, 0.f, 0.f};
#pragma unroll
        for (int kk = 0; kk < 8; ++kk) acc = MFMA16(frag_plain(ks, 264, j0, 32 * kk, lane), frag_plain(qs, 264, i0, 32 * kk, lane), acc);
#pragma unroll
        for (int e = 0; e < 4; ++e) acc[e] = (j0 + 4 * g4 + e <= i0 + i) ? acc[e] : 0.f;
        u32x2 w; w.x = pk2(acc[0], acc[1]); w.y = pk2(acc[2], acc[3]); *(LAS u32x2*)(ps + (i0 + i) * 72 + j0 + 4 * g4) = w;
    }
    const int it = wave >> 2, dv0 = 16 * (wave & 3);
    bf16x8 qf[8], av[2];
#pragma unroll
    for (int kk = 0; kk < 8; ++kk) qf[kk] = frag_plain(qs, 264, 16 * it, 32 * kk, lane);
#pragma unroll
    for (int a2 = 0; a2 < 2; ++a2) av[a2] = frag_tr(ks, 264, 0, 32 * wave + 16 * a2, lane);
    __syncthreads();
    const bf16x8 pf = frag_plain(ps, 72, 16 * it, 0, lane);
    for (int sl = 0; sl < 8; ++sl) {
        LAS bf16* rts = (LAS bf16*)(lds + S_RT + (sl & 1) * 33792); LAS bf16* vs = (LAS bf16*)(lds + S_VS + (sl & 1) * 4608); LAS bf16* os = (LAS bf16*)(lds + S_OS + (sl & 1) * 4608);
        f32x4 R[2][4];
#pragma unroll
        for (int a2 = 0; a2 < 2; ++a2)
#pragma unroll
            for (int d = 0; d < 4; ++d) { R[a2][d] = Rn[a2][d] * gLm1i; u32x2 w; w.x = pk2(R[a2][d][0], R[a2][d][1]); w.y = pk2(R[a2][d][2], R[a2][d][3]);
                *(LAS u32x2*)(rts + (16 * d + i) * 264 + 32 * wave + 16 * a2 + 4 * g4) = w; }
        if (vthr) *(LAS u32x4*)(vs + (tid >> 3) * 72 + (tid & 7) * 8) = vn;
        if (sl + 1 < 8) SMP_PREFETCH(sl + 1);
        __syncthreads();
        if (sl > 0 && vthr) *(u32x4*)(OB + (size_t)(grow0 + (tid >> 3)) * 4096 + h * 512 + (sl - 1) * 64 + (tid & 7) * 8) = *(const LAS u32x4*)((LAS bf16*)(lds + S_OS + ((sl - 1) & 1) * 4608) + (tid >> 3) * 72 + (tid & 7) * 8);
        f32x4 acc = (f32x4){0.f, 0.f, 0.f, 0.f};
#pragma unroll
        for (int kk = 0; kk < 8; ++kk) acc = MFMA16(frag_plain(rts, 264, dv0, 32 * kk, lane), qf[kk], acc);
        acc = acc * gL;
        acc = MFMA16(frag_tr(vs, 72, 0, dv0, lane), pf, acc);
        { u32x2 w; w.x = pk2(acc[0], acc[1]); w.y = pk2(acc[2], acc[3]); *(LAS u32x2*)(os + (16 * it + i) * 72 + dv0 + 4 * g4) = w; }
        bf16x8 bv[4];
#pragma unroll
        for (int d = 0; d < 4; ++d) bv[d] = frag_tr(vs, 72, 0, 16 * d, lane);
#pragma unroll
        for (int a2 = 0; a2 < 2; ++a2)
#pragma unroll
            for (int d = 0; d < 4; ++d) { R[a2][d] = MFMA16(av[a2], bv[d], R[a2][d] * gL);
#pragma unroll
                for (int e = 0; e < 4; ++e) __builtin_nontemporal_store(R[a2][d][e] * gLm1, Sout + (size_t)(32 * wave + 16 * a2 + 4 * g4 + e) * 512 + sl * 64 + 16 * d + i); }
    }
    __syncthreads();
    if (vthr) *(u32x4*)(OB + (size_t)(grow0 + (tid >> 3)) * 4096 + h * 512 + 7 * 64 + (tid & 7) * 8) = *(const LAS u32x4*)((LAS bf16*)(lds + S_OS + 4608) + (tid >> 3) * 72 + (tid & 7) * 8);
    __syncthreads();
#undef SMP_PREFETCH
}
__device__ __forceinline__ void ret_phase(const Args& a, LAS unsigned char* lds, int wave, int lane) {
    const bf16* QH = (const bf16*)(a.ws + WS_R1); const bf16* KH = QH + (size_t)MT * DM; const bf16* VB = (const bf16*)(a.ws + WS_R1 + 72 * MiB); bf16* OB = (bf16*)(a.ws + WS_YP);
    float* sp = a.out + (size_t)MT * DM; float* ss = sp + (size_t)4 * 8 * 256 * 512;
    for (int item = blockIdx.x; item < 256; item += gridDim.x) {
        const int x = item & 7, j = item >> 3, bh = x * 4 + (j >> 3), slice = j & 7, b = bh >> 3, h = bh & 7;
        ret_run<64>(lds, QH, KH, VB, OB, b * 2048, 32, h, slice, nullptr, sp + (size_t)bh * 256 * 512, wave, lane);
    }
    for (int pair = blockIdx.x; pair < 256; pair += gridDim.x) {
        const int b = pair >> 3, h = pair & 7;
        ret_sample(lds, QH, KH, VB, OB, MP + b * 32, h, a.in[2] + (size_t)pair * 256 * 512, ss + (size_t)pair * 256 * 512, wave, lane);
    }
}
__device__ __forceinline__ void gn_gate(const Args& a, int gw, int NGW, int lane) {
    const bf16* O = (const bf16*)(a.ws + WS_YP); bf16* GS = (bf16*)(a.ws + WS_R1 + 144 * MiB);
    for (int row = gw; row < MT; row += NGW) {
        const size_t off = (size_t)row * 4096 + 8 * lane;
        u32x4 ow[8], gv[8];
#pragma unroll
        for (int h = 0; h < 8; ++h) { ow[h] = *(const u32x4*)(O + off + h * 512); gv[h] = *(const u32x4*)(GS + off + h * 512); }
#pragma unroll
        for (int h = 0; h < 8; ++h) {
            float o[8] = {bf_lo(ow[h].x), bf_hi(ow[h].x), bf_lo(ow[h].y), bf_hi(ow[h].y), bf_lo(ow[h].z), bf_hi(ow[h].z), bf_lo(ow[h].w), bf_hi(ow[h].w)};
            const float g[8] = {bf_lo(gv[h].x), bf_hi(gv[h].x), bf_lo(gv[h].y), bf_hi(gv[h].y), bf_lo(gv[h].z), bf_hi(gv[h].z), bf_lo(gv[h].w), bf_hi(gv[h].w)};
            float s = 0.f;
#pragma unroll
            for (int e = 0; e < 8; ++e) s += o[e];
            const float mean = wave_sum(s) * (1.f / 512.f); float q = 0.f;
#pragma unroll
            for (int e = 0; e < 8; ++e) { o[e] -= mean; q += o[e] * o[e]; }
            const float rstd = 1.0f / sqrtf(wave_sum(q) * (1.f / 512.f) + GN_EPS);
            u32x4 w; w.x = pk2(g[0] * o[0] * rstd, g[1] * o[1] * rstd); w.y = pk2(g[2] * o[2] * rstd, g[3] * o[3] * rstd); w.z = pk2(g[4] * o[4] * rstd, g[5] * o[5] * rstd); w.w = pk2(g[6] * o[6] * rstd, g[7] * o[7] * rstd);
            *(u32x4*)(GS + off + h * 512) = w;
        }
    }
}

#ifndef DBG_STOP
#define DBG_STOP 0
#endif
__device__ __forceinline__ void dbg_dump(const Args& a, const bf16* src, size_t n_el) {
    const size_t T = (size_t)gridDim.x * 512, t = (size_t)blockIdx.x * 512 + threadIdx.x, total = 58720256;
    for (size_t i = t; i < total; i += T) { float v = 0.f; if (i < n_el / 2) { const unsigned w = ((const unsigned*)src)[i]; v = bf_lo(w) + bf_hi(w); } a.out[i] = v; }
}
__device__ __forceinline__ void dbg_dump_f32(const Args& a, const float* src, size_t n_el) {
    const size_t T = (size_t)gridDim.x * 512, t = (size_t)blockIdx.x * 512 + threadIdx.x, total = 58720256;
    for (size_t i = t; i < total; i += T) a.out[i] = i < n_el ? src[i] : 0.f;
}
#define XB_TMO      128
#define XB_XCNT(j)  (256  + 64 * (j))
#define XB_XSUB(j)  (1280 + 64 * (j))
#define XB_XGEN(j)  (2304 + 64 * (j))
#define XB_TOP      3328
#define XB_TOPGEN   3392
#define XCD_BAR_WORDS 3456
#define XB_SPIN_CAP (1u << 18)

__device__ __forceinline__ unsigned xb_ld(unsigned* p)              { return __hip_atomic_load(p, __ATOMIC_RELAXED, __HIP_MEMORY_SCOPE_AGENT); }
__device__ __forceinline__ unsigned xb_add(unsigned* p, unsigned v) { return __hip_atomic_fetch_add(p, v, __ATOMIC_RELAXED, __HIP_MEMORY_SCOPE_AGENT); }
__device__ __forceinline__ unsigned xb_xcc_id() { return (unsigned)__builtin_amdgcn_s_getreg((3 << 11) | 20) & 0xFu; }
#define XB_SPIN(cond, bar) do { unsigned _sp = 0; while (cond) { __builtin_amdgcn_s_sleep(1); \
    if ((++_sp & 255u) == 0u) { if (xb_ld(&(bar)[XB_TMO])) break; if (_sp > XB_SPIN_CAP) { atomicAdd(&(bar)[XB_TMO], 1u); break; } } } } while (0)

struct XcdBarrier {
    unsigned* bar; unsigned x;
    volatile LAS unsigned* st;
};

__device__ __forceinline__ XcdBarrier xcd_barrier_post(unsigned* bar, volatile LAS unsigned* st) {
    XcdBarrier b; b.bar = bar; b.x = xb_xcc_id(); b.st = st;
    if (threadIdx.x == 0) (void)xb_add(&bar[XB_XCNT(b.x)], 1u);
    return b;
}
__device__ __forceinline__ void xcd_barrier_complete(unsigned* bar, unsigned x, unsigned& nloc, unsigned& nx) {
    const unsigned G = gridDim.x * gridDim.y * gridDim.z;
    unsigned sum, cnt, mine, sp = 0u;
    for (;;) {
        sum = 0u; cnt = 0u; mine = 0u;
#pragma unroll
        for (unsigned j = 0; j < 16; ++j) { const unsigned c = xb_ld(&bar[XB_XCNT(j)]); sum += c; cnt += (c > 0u) ? 1u : 0u; mine = (j == x) ? c : mine; }
        if (sum == G) break;
        __builtin_amdgcn_s_sleep(1);
        if ((++sp & 255u) == 0u) { if (xb_ld(&bar[XB_TMO])) break; if (sp > XB_SPIN_CAP) { atomicAdd(&bar[XB_TMO], 1u); break; } }
    }
    nloc = mine > 0u ? mine : 1u; nx = cnt > 0u ? cnt : 1u;
}

__device__ __forceinline__ void xcd_barrier(const XcdBarrier& b) {
    asm volatile("s_waitcnt vmcnt(0)" ::: "memory");
    __syncthreads();
    if (threadIdx.x == 0) {
        unsigned* bar = b.bar;
        __builtin_amdgcn_s_waitcnt(0);
        unsigned nloc = b.st[0], nx = b.st[1];
        if (nloc == 0u) { xcd_barrier_complete(bar, b.x, nloc, nx); b.st[0] = nloc; b.st[1] = nx; }
        const unsigned old = xb_add(&bar[XB_XSUB(b.x)], 1u);
        const unsigned gen = old / nloc;
        if (old + 1u == (gen + 1u) * nloc) {
            __builtin_amdgcn_fence(__ATOMIC_RELEASE, "agent");
            asm volatile("s_waitcnt vmcnt(0)" ::: "memory");
            const unsigned og = xb_add(&bar[XB_TOP], 1u);
            const unsigned tg = og / nx;
            if (og + 1u == (tg + 1u) * nx) xb_add(&bar[XB_TOPGEN], 1u);
            else XB_SPIN(xb_ld(&bar[XB_TOPGEN]) == tg, bar);
            __builtin_amdgcn_fence(__ATOMIC_ACQUIRE, "agent");
            xb_add(&bar[XB_XGEN(b.x)], 1u);
            asm volatile("s_waitcnt vmcnt(0)" ::: "memory");
        } else {
            XB_SPIN(xb_ld(&bar[XB_XGEN(b.x)]) == gen, bar);
            __builtin_amdgcn_fence(__ATOMIC_ACQUIRE, "agent");
            asm volatile("s_waitcnt vmcnt(0)" ::: "memory");
        }
    }
    __syncthreads();
}

__global__ void __launch_bounds__(512, 2) fwd(Args a) {
    extern __shared__ __attribute__((aligned(16))) unsigned char lds_raw[];
    cg::grid_group grid = cg::this_grid();
    LAS unsigned char* lds = (LAS unsigned char*)lds_raw;
    const int tid = threadIdx.x, lane = tid & 63, wave = __builtin_amdgcn_readfirstlane(tid >> 6);
    const int G = gridDim.x, c = blockIdx.x, vcu = (G % 8 == 0) ? (c % 8) * (G / 8) + c / 8 : c, gw = vcu * NW + wave, NGW = G * NW;
    unsigned char* ws = a.ws;
    { volatile LAS unsigned* misc = (volatile LAS unsigned*)(lds + MISC_OFF); if (tid < 32) misc[tid] = 0u; }
    __syncthreads();
    XcdBarrier bar = xcd_barrier_post((unsigned*)(ws + WS_CTL), (volatile LAS unsigned*)(lds + MISC_OFF) + 8);
    bf16* XB = (bf16*)(ws + WS_XB); float* YP = (float*)(ws + WS_YP);
    bf16* R1 = (bf16*)(ws + WS_R1);
#define GEMM(EPI, E, Ap, Bp, LD, M1, N, K, SPLIT, CLIST) do { pg8::Gemm g_{(const pg8::bf16_t*)(Ap), (const pg8::bf16_t*)(Bp), (LD)}; pg8::Order S_; S_.init((M1), (N), (K), (SPLIT), G, c); \
        pg8::gemm_phase<EPI, pg8::Order, true, true>(lds, g_, S_, E); if (DBL_GEMM) pg8::gemm_phase<EPI, pg8::Order, true, true>(lds, g_, S_, E); \
        if ((CLIST) > 0) { const int nbusy_ = S_.so.nwg % G;   \
            if (nbusy_ == 0) convert_list(a, lds, (CLIST), gw, NGW, wave, lane); else if (c >= nbusy_) convert_list(a, lds, (CLIST), (c - nbusy_) * NW + wave, (G - nbusy_) * NW, wave, lane); } } while (0)

#define GRID_SYNC() do { asm volatile("s_waitcnt vmcnt(0) lgkmcnt(0)" ::: "memory"); grid.sync(); } while (0)
#define XCD_SYNC() xcd_barrier(bar)

#define DBG_DUMP_1 dbg_dump(a, XB, (size_t)MT * DM)
#define DBG_DUMP_2 dbg_dump(a, R1, (size_t)2 * MT * DM)
#define DBG_DUMP_3 dbg_dump(a, R1 + (size_t)2 * MT * DM, (size_t)MT * DM)
#define DBG_DUMP_4 dbg_dump(a, (const bf16*)YP, (size_t)MP * DM)
#define DBG_DUMP_5 dbg_dump(a, XB, (size_t)MT * DM)
#define DBG_DUMP_6 dbg_dump(a, R1, (size_t)MT * FF)
#define DBG_DUMP_7 dbg_dump(a, (const bf16*)YP, (size_t)MP * DM)
#define DBG_DUMP_8 dbg_dump(a, XB, (size_t)MT * DM)
#define DBG_DUMP_9 dbg_dump(a, R1, (size_t)6 * MT * DM)
#define DBG_DUMP_10 dbg_dump(a, (const bf16*)YP, (size_t)2 * MT * DM)
#define DBG_DUMP_11 dbg_dump(a, R1 + (size_t)4 * MT * DM, (size_t)2 * MT * DM)
#define DBG_DUMP_12 dbg_dump(a, (const bf16*)YP, (size_t)MP * DM)
#define DBG_DUMP_13 dbg_dump(a, XB, (size_t)MT * DM)
#define DBG_DUMP_14 dbg_dump(a, R1, (size_t)MT * FF)
#define DBG_DUMP_15 dbg_dump(a, (const bf16*)YP, (size_t)MP * DM)
    p0_prologue(a, lds, gw, NGW, wave, lane);
    if (a.out == nullptr) GRID_SYNC();
    XCD_SYNC();
    if (DBG_STOP == 1) { DBG_DUMP_1; return; }
    { pg8::EpiGeluUV E{R1, R1 + (size_t)MT * DM, (pg8::f32x2*)(ws + WS_STAT)}; GEMM(pg8::EpiGeluUV, E, XB, ws + WS_WAIN, 2048, MT, 4096, 2048, 0, 1); }
    XCD_SYNC();
    if (DBG_STOP == 2) { DBG_DUMP_2; return; }
    mix_phase(a, lds, wave, lane);
    XCD_SYNC();
    if (DBG_STOP == 3) { DBG_DUMP_3; return; }
    { pg8::EpiPart E{(pg8::bf16_t*)YP}; GEMM(pg8::EpiPart, E, ws + WS_R1 + 72 * MiB, ws + WS_WAOUT, 2048, MP, 2048, 2048, 1, 0); }
    XCD_SYNC();
    if (DBG_STOP == 4) { DBG_DUMP_4; return; }
    ln_pass(nullptr, nullptr, XB, YP, a.in[13], a.in[14], nullptr, XB, gw, NGW, lane);
    XCD_SYNC();
    if (DBG_STOP == 5) { DBG_DUMP_5; return; }
    { pg8::EpiSwiglu E{R1}; GEMM(pg8::EpiSwiglu, E, XB, ws + WS_WFIN, 2048, MT, 11264, 2048, 0, 2); }
    XCD_SYNC();
    if (DBG_STOP == 6) { DBG_DUMP_6; return; }
    { pg8::EpiPart E{(pg8::bf16_t*)YP}; GEMM(pg8::EpiPart, E, R1, ws + WS_WFOUT, 5632, MP, 2048, 5632, 1, 0); }
    XCD_SYNC();
    if (DBG_STOP == 7) { DBG_DUMP_7; return; }
    ln_pass(nullptr, nullptr, XB, YP, a.in[15], a.in[16], nullptr, XB, gw, NGW, lane);
    XCD_SYNC();
    if (DBG_STOP == 8) { DBG_DUMP_8; return; }
    { pg8::EpiQKVG E{R1, R1 + (size_t)MT * DM, (pg8::bf16_t*)(ws + WS_R1 + 72 * MiB), (pg8::bf16_t*)(ws + WS_R1 + 144 * MiB), (const float*)(ws + WS_ROPE), (const float*)(ws + WS_ROPE) + 2080 * 128};
      GEMM(pg8::EpiQKVG, E, XB, ws + WS_WBIN, 2048, MT, 12288, 2048, 0, 3); }
    XCD_SYNC();
    if (DBG_STOP == 9) { DBG_DUMP_9; return; }
    ret_phase(a, lds, wave, lane);
    XCD_SYNC();
    if (DBG_STOP == 10) { DBG_DUMP_10; return; }
    gn_gate(a, gw, NGW, lane);
    XCD_SYNC();
    if (DBG_STOP == 11) { DBG_DUMP_11; return; }
    { pg8::EpiPart E{(pg8::bf16_t*)YP}; GEMM(pg8::EpiPart, E, ws + WS_R1 + 144 * MiB, ws + WS_WBOUT, 4096, MP, 2048, 4096, 1, 0); }
    XCD_SYNC();
    if (DBG_STOP == 12) { DBG_DUMP_12; return; }
    ln_pass(nullptr, nullptr, XB, YP, a.in[13] + DM, a.in[14] + DM, nullptr, XB, gw, NGW, lane);
    XCD_SYNC();
    if (DBG_STOP == 13) { DBG_DUMP_13; return; }
    { pg8::EpiSwiglu E{R1}; GEMM(pg8::EpiSwiglu, E, XB, ws + WS_WFIN + 44 * MiB, 2048, MT, 11264, 2048, 0, 4); }
    XCD_SYNC();
    if (DBG_STOP == 14) { DBG_DUMP_14; return; }
    { pg8::EpiPart E{(pg8::bf16_t*)YP}; GEMM(pg8::EpiPart, E, R1, ws + WS_WFOUT + 22 * MiB, 5632, MP, 2048, 5632, 1, 0); }
    XCD_SYNC();
    if (DBG_STOP == 15) { DBG_DUMP_15; return; }
    ln_pass(nullptr, nullptr, XB, YP, a.in[15] + DM, a.in[16] + DM, a.out, nullptr, gw, NGW, lane);
#undef GEMM
}

extern "C" void kernel_launch(void* const* d_in, const int* in_sizes, int n_in, void* d_out, int out_size, void* d_ws, size_t ws_size, hipStream_t stream) {
    static int grid = 0;
    if (grid == 0) {
        if (n_in != 17 || ws_size < WS_END) { fprintf(stderr, "kernel_launch: needs 17 inputs and >= %zu bytes of workspace (got %d, %zu)\n", (size_t)WS_END, n_in, ws_size); grid = -1; return; }
        int dev = 0, cus = 0, per_cu = 0;
        if (hipGetDevice(&dev) != hipSuccess || hipDeviceGetAttribute(&cus, hipDeviceAttributeMultiprocessorCount, dev) != hipSuccess) { grid = -1; return; }
        if (hipFuncSetAttribute((const void*)fwd, hipFuncAttributeMaxDynamicSharedMemorySize, LDS_BYTES) != hipSuccess) { fprintf(stderr, "kernel_launch: hipFuncSetAttribute failed\n"); grid = -1; return; }
        if (hipOccupancyMaxActiveBlocksPerMultiprocessor(&per_cu, (const void*)fwd, NW * 64, LDS_BYTES) != hipSuccess || per_cu < 1) { fprintf(stderr, "kernel_launch: occupancy query reports %d workgroups per CU\n", per_cu); grid = -1; return; }
        grid = cus;
    }
    if (grid < 0) return;
    if (hipMemsetAsync((char*)d_ws + WS_CTL, 0, CTL_BYTES, stream) != hipSuccess) { fprintf(stderr, "kernel_launch: hipMemsetAsync failed\n"); return; }
    Args a{};
    for (int i = 0; i < 17; ++i) a.in[i] = (const float*)d_in[i];
    a.out = (float*)d_out; a.ws = (unsigned char*)d_ws;
    void* args[] = {&a};
    const hipError_t e = hipLaunchCooperativeKernel((const void*)fwd, dim3(grid), dim3(NW * 64), args, LDS_BYTES, stream);
    if (e != hipSuccess) fprintf(stderr, "kernel_launch: cooperative launch failed: %s (grid %d)\n", hipGetErrorString(e), grid);
}
```
